# Optimizing an MI355X kernel written in HIP

```python
import jax
import jax.numpy as jnp
from jax import lax
import numpy as np

D_MODEL = 2048
BATCH = 2
SEQ = 16384
DEPTH = 4

CTX_LEN = 256
GRID_W = 64
HEAD_SIZE = 64
RWKV_WIDTH = 1024
N_HEADS = RWKV_WIDTH // HEAD_SIZE
POOL_WIDTH = D_MODEL - RWKV_WIDTH
MIX_WIDTH = RWKV_WIDTH + POOL_WIDTH
POOL_WINDOWS = (2, 4, 8, 16)
POOL_GROUP = POOL_WIDTH // len(POOL_WINDOWS)
DECAY_LORA = 96
ICLR_LORA = 96
GATE_LORA = 256
CONV_WIDTH = 3
D_FF = -(-(8 * D_MODEL) // (3 * 256)) * 256
N_DIRS = 2
RMS_EPS = 1e-6
GN_EPS = 64e-5

OFF_R = 0
OFF_K = RWKV_WIDTH
OFF_V = 2 * RWKV_WIDTH
OFF_W = 3 * RWKV_WIDTH
OFF_A = OFF_W + DECAY_LORA
OFF_G = OFF_A + ICLR_LORA
OFF_POOL = OFF_G + GATE_LORA
IN_WIDTH = OFF_POOL + POOL_WIDTH

kernel_name = "hymba_rwkv7_poolformer_dit_trunk"


def rms_norm(x, g):
    xf = x.astype(jnp.float32)
    y = xf * lax.rsqrt(jnp.mean(xf * xf, axis=-1, keepdims=True) + RMS_EPS)
    return (y * g.astype(jnp.float32)).astype(x.dtype)


def modulated_norm(x, g, shift, scale):
    return rms_norm(x, g) * (1 + scale) + shift


def ada_modulation(cond, w, b):
    m = jax.nn.silu(cond) @ w + b
    return jnp.split(m, 6, axis=-1)


def swiglu(h, w_gate, w_up, w_down):
    return (jax.nn.silu(h @ w_gate) * (h @ w_up)) @ w_down


def short_conv(u, w):
    up = jnp.pad(u, ((0, 0), (1, 1), (0, 0)))
    return up[:, :-2] * w[0] + up[:, 1:-1] * w[1] + up[:, 2:] * w[2]


def wkv7_scan(r, w, k, v, a_vec, b_vec, s0, reverse):
    def step(s, inp):
        r_t, w_t, k_t, v_t, a_t, b_t = inp
        sa = jnp.einsum('bhvk,bhk->bhv', s, a_t)
        s = s * w_t[:, :, None, :] + sa[..., None] * b_t[:, :, None, :] + v_t[..., None] * k_t[:, :, None, :]
        y = jnp.einsum('bhvk,bhk->bhv', s, r_t)
        return s, y
    xs = tuple(jnp.swapaxes(z, 0, 1) for z in (r, w, k, v, a_vec, b_vec))
    s_fin, ys = lax.scan(step, s0, xs, reverse=reverse)
    return jnp.swapaxes(ys, 0, 1), s_fin


def rwkv_time_mix(u, conv_w, decay_bias, decay_up, iclr_bias, iclr_up, gate_up,
                  k_k, k_a, r_k, gn_w, gn_b, s0_fwd, s0_bwd, need_output):
    f32 = jnp.float32
    b, t, _ = u.shape
    heads = lambda z: z.reshape(b, t, N_HEADS, HEAD_SIZE)
    hvec = lambda p: p.astype(f32).reshape(N_HEADS, HEAD_SIZE)
    rkv = short_conv(u[..., :OFF_W], conv_w).astype(f32)
    r = heads(rkv[..., OFF_R:OFF_K])
    k = heads(rkv[..., OFF_K:OFF_V])
    v = heads(rkv[..., OFF_V:OFF_W])
    w_lo = jnp.tanh(u[..., OFF_W:OFF_A].astype(f32))
    a_lo = u[..., OFF_A:OFF_G].astype(f32)
    kk = k * hvec(k_k)
    kk = kk * lax.rsqrt(jnp.maximum(jnp.sum(kk * kk, axis=-1, keepdims=True), 1e-24))
    ys, ks, states = [], [], []
    for d, s0, rev in ((0, s0_fwd, False), (1, s0_bwd, True)):
        w_log = -jax.nn.softplus(-(decay_bias[d].astype(f32) + w_lo @ decay_up[d].astype(f32))) - 0.5
        decay = heads(jnp.exp(-jnp.exp(w_log)))
        a = heads(jax.nn.sigmoid(iclr_bias[d].astype(f32) + a_lo @ iclr_up[d].astype(f32)))
        k_d = k * (1 + (a - 1) * hvec(k_a))
        y_d, s_d = wkv7_scan(r, decay, k_d, v, -kk, kk * a, s0, rev)
        ys.append(y_d)
        ks.append(k_d)
        states.append(s_d)
    if not need_output:
        return None, states[0], states[1]
    y = ys[0] + ys[1]
    mu = jnp.mean(y, axis=-1, keepdims=True)
    var = jnp.mean(jnp.square(y - mu), axis=-1, keepdims=True)
    y = ((y - mu) * lax.rsqrt(var + GN_EPS)) * hvec(gn_w) + hvec(gn_b)
    bonus = jnp.sum(r * (ks[0] + ks[1]) * hvec(r_k), axis=-1, keepdims=True) * v
    g = jax.nn.sigmoid(u[..., OFF_G:OFF_POOL].astype(f32)) @ gate_up.astype(f32)
    out = (y + bonus).reshape(b, t, RWKV_WIDTH) * g
    return out.astype(u.dtype), states[0], states[1]


def window_bounds(n, window):
    i = jnp.arange(n)
    half = window // 2
    return jnp.clip(i - half, 0, n), jnp.clip(i + half, 0, n)


def box_mean_1d(x, window):
    t = x.shape[1]
    cs = jnp.pad(jnp.cumsum(x, axis=1), ((0, 0), (1, 0), (0, 0)))
    lo, hi = window_bounds(t, window)
    cnt = (hi - lo).astype(x.dtype)
    return (cs[:, hi] - cs[:, lo]) / cnt[None, :, None]


def box_mean_2d(x, window):
    rows, cols = x.shape[1], x.shape[2]
    sat = jnp.pad(jnp.cumsum(jnp.cumsum(x, axis=1), axis=2), ((0, 0), (1, 0), (1, 0), (0, 0)))
    r_lo, r_hi = window_bounds(rows, window)
    c_lo, c_hi = window_bounds(cols, window)
    top = sat[:, r_lo]
    bot = sat[:, r_hi]
    total = bot[:, :, c_hi] - bot[:, :, c_lo] - top[:, :, c_hi] + top[:, :, c_lo]
    cnt = ((r_hi - r_lo)[:, None] * (c_hi - c_lo)[None, :]).astype(x.dtype)
    return total / cnt[None, :, :, None]


def pool_mix(u, pool_w, pool_scale, on_grid):
    b, t, _ = u.shape
    uf = u.astype(jnp.float32)
    outs = []
    for gi, win in enumerate(POOL_WINDOWS):
        ug = uf[..., gi * POOL_GROUP:(gi + 1) * POOL_GROUP]
        if on_grid:
            rows = t // GRID_W
            m = box_mean_2d(ug.reshape(b, rows, GRID_W, POOL_GROUP), win).reshape(b, t, POOL_GROUP)
        else:
            m = box_mean_1d(ug, win)
        outs.append((m - ug) @ pool_w[gi].astype(jnp.float32))
    return (jnp.concatenate(outs, axis=-1) * pool_scale.astype(jnp.float32)).astype(u.dtype)


def setup_inputs(seed: int = 0) -> dict:
    key = jax.random.key(seed)
    ks = jax.random.split(key, 32)
    f32 = jnp.float32
    nrm = lambda k, shape, s: s * jax.random.normal(k, shape, f32)
    L, RW = DEPTH, RWKV_WIDTH
    conv_center = jnp.zeros((CONV_WIDTH, 1), f32).at[CONV_WIDTH // 2].set(1.0)
    return {
        'x': nrm(ks[0], (BATCH, SEQ, D_MODEL), 1.0),
        'c': nrm(ks[1], (BATCH, D_MODEL), 1.0),
        'ctx': nrm(ks[2], (BATCH, CTX_LEN, D_MODEL), 1.0),
        'c_ctx': nrm(ks[3], (D_MODEL,), 1.0),
        'ada_w': nrm(ks[4], (L, D_MODEL, 6 * D_MODEL), 0.5 * D_MODEL ** -0.5),
        'ada_b': nrm(ks[5], (L, 6 * D_MODEL), 0.02),
        'norm_mix': 1.0 + nrm(ks[6], (L, D_MODEL), 0.02),
        'norm_ffn': 1.0 + nrm(ks[7], (L, D_MODEL), 0.02),
        'w_in': nrm(ks[8], (L, D_MODEL, IN_WIDTH), D_MODEL ** -0.5),
        'conv_rkv': conv_center[None] + nrm(ks[9], (L, CONV_WIDTH, 3 * RW), 0.3),
        'decay_bias': jax.random.uniform(ks[10], (L, N_DIRS, RW), f32, -4.0, -0.5),
        'decay_up': nrm(ks[11], (L, N_DIRS, DECAY_LORA, RW), 0.1 * DECAY_LORA ** -0.5),
        'iclr_bias': nrm(ks[12], (L, N_DIRS, RW), 0.1),
        'iclr_up': nrm(ks[13], (L, N_DIRS, ICLR_LORA, RW), 0.3 * ICLR_LORA ** -0.5),
        'gate_up': nrm(ks[14], (L, GATE_LORA, RW), GATE_LORA ** -0.5),
        'k_k': 0.85 + nrm(ks[15], (L, RW), 0.05),
        'k_a': 1.0 + nrm(ks[16], (L, RW), 0.05),
        'r_k': nrm(ks[17], (L, RW), 0.1),
        'gn_w': 1.0 + nrm(ks[18], (L, RW), 0.05),
        'gn_b': nrm(ks[19], (L, RW), 0.02),
        'pool_w': nrm(ks[20], (L, len(POOL_WINDOWS), POOL_GROUP, POOL_GROUP), POOL_GROUP ** -0.5),
        'pool_scale': 1.0 + nrm(ks[21], (L, POOL_WIDTH), 0.1),
        'w_out': nrm(ks[22], (L, MIX_WIDTH, D_MODEL), MIX_WIDTH ** -0.5),
        'ffn_gate': nrm(ks[23], (L, D_MODEL, D_FF), D_MODEL ** -0.5),
        'ffn_up': nrm(ks[24], (L, D_MODEL, D_FF), D_MODEL ** -0.5),
        'ffn_down': nrm(ks[25], (L, D_FF, D_MODEL), D_FF ** -0.5),
        'final_norm': 1.0 + nrm(ks[26], (D_MODEL,), 0.02),
    }


def reference(x, c, ctx, c_ctx, ada_w, ada_b, norm_mix, norm_ffn, w_in, conv_rkv,
              decay_bias, decay_up, iclr_bias, iclr_up, gate_up, k_k, k_a, r_k,
              gn_w, gn_b, pool_w, pool_scale, w_out, ffn_gate, ffn_up, ffn_down, final_norm):
    zero_state = jnp.zeros((x.shape[0], N_HEADS, HEAD_SIZE, HEAD_SIZE), jnp.float32)
    ctx_h = ctx
    for l in range(DEPTH):
        last = l == DEPTH - 1
        rw = (conv_rkv[l], decay_bias[l], decay_up[l], iclr_bias[l], iclr_up[l], gate_up[l],
              k_k[l], k_a[l], r_k[l], gn_w[l], gn_b[l])
        sh1, sc1, gt1, sh2, sc2, gt2 = ada_modulation(c[:, None, :], ada_w[l], ada_b[l])
        csh1, csc1, cgt1, csh2, csc2, cgt2 = ada_modulation(c_ctx, ada_w[l], ada_b[l])

        u_ctx = modulated_norm(ctx_h, norm_mix[l], csh1, csc1) @ w_in[l]
        y_ctx, s_fwd, s_bwd = rwkv_time_mix(u_ctx[..., :OFF_POOL], *rw, zero_state, zero_state, not last)

        u = modulated_norm(x, norm_mix[l], sh1, sc1) @ w_in[l]
        y_lat, _, _ = rwkv_time_mix(u[..., :OFF_POOL], *rw, s_fwd, s_bwd, True)
        p_lat = pool_mix(u[..., OFF_POOL:], pool_w[l], pool_scale[l], True)
        x = x + gt1 * (jnp.concatenate([y_lat, p_lat], axis=-1) @ w_out[l])
        x = x + gt2 * swiglu(modulated_norm(x, norm_ffn[l], sh2, sc2), ffn_gate[l], ffn_up[l], ffn_down[l])

        if not last:
            p_ctx = pool_mix(u_ctx[..., OFF_POOL:], pool_w[l], pool_scale[l], False)
            ctx_h = ctx_h + cgt1 * (jnp.concatenate([y_ctx, p_ctx], axis=-1) @ w_out[l])
            ctx_h = ctx_h + cgt2 * swiglu(modulated_norm(ctx_h, norm_ffn[l], csh2, csc2),
                                          ffn_gate[l], ffn_up[l], ffn_down[l])
    return rms_norm(x, final_norm)
```

```cpp
#ifndef EMU
#include <hip/hip_runtime.h>
#endif
#include <cstdio>
#include <cstdint>
#include <cstddef>

#ifndef CFG_SEQ
#define CFG_SEQ 16384
#endif
#ifndef CFG_CTX
#define CFG_CTX 256
#endif
#ifndef CFG_DEPTH
#define CFG_DEPTH 4
#endif
#ifndef CFG_SEGLEN
#define CFG_SEGLEN 1024
#endif
#ifndef MK_ONE_LAUNCH
#define MK_ONE_LAUNCH 0
#endif
constexpr int D = 2048, NB = 2, SEQ = CFG_SEQ, DEPTH = CFG_DEPTH, CTX = CFG_CTX, GW = 64, HS = 64, RW = 1024, NH = 16, PWD = 1024;
constexpr int PG = 256, LORA = 96, GL = 256, DFF = 5632;
constexpr int OFF_R = 0, OFF_K = 1024, OFF_V = 2048, OFF_W = 3072, OFF_A = 3168, OFF_G = 3264, OFF_POOL = 3520, INW = 4544, INWP = 4608;
constexpr int ML = NB * SEQ, MC = NB * CTX, MR = ML + MC;
constexpr int SEGLEN = CFG_SEGLEN, NSEGL = SEQ / SEGLEN, NSEG = NSEGL + 1;
constexpr int GROWS = SEQ / GW;
constexpr float RMS_EPS = 1e-6f, GN_EPS = 64e-5f;
static_assert(ML % 256 == 0 && MR % 256 == 0 && SEQ % 256 == 0 && SEGLEN % 64 == 0 && CTX % 64 == 0 && SEQ % SEGLEN == 0, "shape");
constexpr int NPM = MR / 256, NPM_L = ML / 256;

typedef unsigned short bf16_t;
typedef short bf16x8 __attribute__((ext_vector_type(8)));
typedef float f32x4 __attribute__((ext_vector_type(4)));
typedef float f32x2 __attribute__((ext_vector_type(2)));
typedef unsigned u32x4 __attribute__((ext_vector_type(4)));
typedef unsigned u32x2 __attribute__((ext_vector_type(2)));
#define DI __device__ __forceinline__
#ifdef EMU
#define LAS
#define GAS
#define CAS
#define MFMA16(a, b, c) emu_mfma16((a), (b), (c))
#define RFL(x) (x)
#define LDS_WAIT() emu_wave_sync()
#define VM_WAIT() do {} while (0)
#define WG_BAR() __syncthreads()
#define CFENCE() do {} while (0)
#define OPAQUE_S(x) do {} while (0)
#define OPAQUE_V(x) do {} while (0)
#define LANE_ID() ((int)(threadIdx.x & 63))
static inline float fexp(float x) { return expf(x); }
static inline float frcp(float x) { return 1.0f / x; }
static inline float frsq(float x) { return 1.0f / sqrtf(x); }
#else
#define LAS __attribute__((address_space(3)))
#define GAS __attribute__((address_space(1)))
#define CAS __attribute__((address_space(4)))
#define MFMA16(a, b, c) __builtin_amdgcn_mfma_f32_16x16x32_bf16((a), (b), (c), 0, 0, 0)
#define RFL(x) __builtin_amdgcn_readfirstlane(x)
#define LDS_WAIT() asm volatile("s_waitcnt lgkmcnt(0)" ::: "memory")
#define VM_WAIT() asm volatile("s_waitcnt vmcnt(0)" ::: "memory")
#define WG_BAR() __syncthreads()
#define CFENCE() asm volatile("" ::: "memory")
#define OPAQUE_S(x) asm volatile("" : "+s"(x))
#define OPAQUE_V(x) asm volatile("" : "+v"(x))
DI int lane_id_volatile() { int l; asm volatile("v_mbcnt_lo_u32_b32 %0, -1, 0\n\tv_mbcnt_hi_u32_b32 %0, -1, %0" : "=v"(l)); return l; }
#define LANE_ID() lane_id_volatile()
DI float fexp(float x) { return __expf(x); }
DI float frcp(float x) { return __builtin_amdgcn_rcpf(x); }
DI float frsq(float x) { return __builtin_amdgcn_rsqf(x); }
#endif
DI unsigned f2bf(float f) { unsigned u = __builtin_bit_cast(unsigned, f); return (u + 0x7fffu + ((u >> 16) & 1u)) >> 16; }
DI unsigned pk2(float lo, float hi) { return f2bf(lo) | (f2bf(hi) << 16); }
DI float bf2f(unsigned h) { return __builtin_bit_cast(float, h << 16); }
DI float bflo(unsigned w) { return __builtin_bit_cast(float, w << 16); }
DI float bfhi(unsigned w) { return __builtin_bit_cast(float, w & 0xffff0000u); }
DI float fsigmoid(float x) { return frcp(1.0f + fexp(-x)); }
DI float ftanh(float x) { return 1.0f - 2.0f * frcp(fexp(2.0f * x) + 1.0f); }
DI float fsilu(float x) { return x * fsigmoid(x); }
DI void unpack8(const u32x4& w, float (&f)[8]) { f[0] = bflo(w.x); f[1] = bfhi(w.x); f[2] = bflo(w.y); f[3] = bfhi(w.y); f[4] = bflo(w.z); f[5] = bfhi(w.z); f[6] = bflo(w.w); f[7] = bfhi(w.w); }
DI u32x4 pack8(const float (&f)[8]) { u32x4 w; w.x = pk2(f[0], f[1]); w.y = pk2(f[2], f[3]); w.z = pk2(f[4], f[5]); w.w = pk2(f[6], f[7]); return w; }
DI void unpack4(const u32x2& w, float (&f)[4]) { f[0] = bflo(w.x); f[1] = bfhi(w.x); f[2] = bflo(w.y); f[3] = bfhi(w.y); }
DI u32x2 pack4(const float (&f)[4]) { u32x2 w; w.x = pk2(f[0], f[1]); w.y = pk2(f[2], f[3]); return w; }
DI float wave_sum(float v) {
#pragma unroll
    for (int o = 1; o < 64; o <<= 1) v += __shfl_xor(v, o);
    return v;
}

namespace pg8 {
constexpr int BM = 256, BK = 64, HALF = 128, HTB = HALF * BK * 2, STAGE_BYTES = 8 * HTB, NXCD = 8, WGM = 8;
__host__ __device__ __forceinline__ int lds_byte(int r, int c) { const int st = (r >> 4) * 2 + (c >> 5), rr = r & 15, cc = c & 31, ob = rr * 64 + cc * 2; return st * 1024 + (ob ^ (((ob >> 9) & 1) << 5)); }
__host__ __device__ __forceinline__ void stage_rc(int b, int& R, int& C) { const int st = b / 1024, sb = b % 1024, swz = sb ^ (((sb >> 9) & 1) << 5); R = (st >> 1) * 16 + swz / 64; C = (st & 1) * 32 + (swz % 64) / 2; }
__host__ __device__ __forceinline__ int perm32(int rho) { const int n = rho >> 4, i = rho & 15; return 8 * (i >> 2) + 4 * n + (i & 3); }
struct Unit { int pm, pn; };
struct Gemm { const bf16_t* A; const bf16_t* Bt; int lda, ldb, K, a_col_pn; };
struct StaticOrder {
    int nM, nN, nwg, G, c;
    __host__ __device__ void init(int nM_, int nN_, int G_, int c_) { nM = nM_; nN = nN_; nwg = nM * nN; G = G_; c = c_; }
    __host__ __device__ bool next(int i, Unit& u) const {
        const long L = (long)i * G + c; if (L >= nwg) return false;
        int wgid = (int)L; { const int q = nwg / NXCD, r = nwg % NXCD, xcd = wgid % NXCD, off = wgid / NXCD; wgid = (xcd < r ? xcd * (q + 1) : r * (q + 1) + (xcd - r) * q) + off; }
        const int nig = WGM * nN, gid = wgid / nig, fm = gid * WGM, gsz = (nM - fm) < WGM ? (nM - fm) : WGM;
        u.pm = fm + ((wgid % nig) % gsz); u.pn = (wgid % nig) / gsz; return true;
    }
};
#ifndef EMU
#define PG8_LAS __attribute__((address_space(3)))
template <class Epi, class Sched, bool ALIGN_EPI = false, bool SP2 = false>
__device__ __forceinline__ void gemm_phase(PG8_LAS unsigned char* lds, const Gemm g, const Sched& S, const Epi& E, const int tid_) {
    const int tid = tid_, wid = __builtin_amdgcn_readfirstlane(tid >> 6), lane = tid & 63, wr = wid >> 2, wc = wid & 3, fr = lane & 15, fq = lane >> 4;
    const int K = g.K, nt = K / BK;
    unsigned voffA[2], voffB[2];
#pragma unroll
    for (int i = 0; i < 2; ++i) { int R, C; stage_rc(tid * 16 + i * 8192, R, C); const int Rb = Epi::PERM ? ((R & ~31) + perm32(R & 31)) : R;
        voffA[i] = (unsigned)(R * g.lda + C) * 2u; voffB[i] = (unsigned)(Rb * g.ldb + C) * 2u; }
    const size_t kstep = (size_t)(BK * 2);
    const size_t hstepA = (size_t)HALF * g.lda * 2, hstepB = (size_t)HALF * g.ldb * 2;
    const unsigned ldsw = (unsigned)wid * 1024u;
    const int aoff = lds_byte(wr * 64 + fr, fq * 8), boff = lds_byte(wc * 32 + fr, fq * 8);
#define PG8_SA(b, h) (((b) * 2 + (h)) * HTB)
#define PG8_SB(b, h) ((4 + (b) * 2 + (h)) * HTB)
#define PG8_STAGE(bufoff, gbase, voff) do { _Pragma("unroll") for (int _i = 0; _i < 2; ++_i) \
        __builtin_amdgcn_global_load_lds((const unsigned*)((const char*)(gbase) + (voff)[_i]), (PG8_LAS unsigned*)(lds + (bufoff) + ldsw + _i * 8192), 16, 0, 0); } while (0)
#define PG8_LDA(dst, b, h) do { _Pragma("unroll") for (int m = 0; m < 4; ++m) _Pragma("unroll") for (int k = 0; k < 2; ++k) dst[m][k] = *(const PG8_LAS bf16x8*)(lds + PG8_SA(b, h) + aoff + m * 2048 + k * 1024); } while (0)
#define PG8_LDB(dst, b, h) do { _Pragma("unroll") for (int n = 0; n < 2; ++n) _Pragma("unroll") for (int k = 0; k < 2; ++k) dst[n][k] = *(const PG8_LAS bf16x8*)(lds + PG8_SB(b, h) + boff + n * 2048 + k * 1024); } while (0)
#define PG8_MMA(ai, bj, At, Bt) do { __builtin_amdgcn_s_setprio(1); _Pragma("unroll") for (int m = 0; m < 4; ++m) _Pragma("unroll") for (int n = 0; n < 2; ++n) _Pragma("unroll") for (int k = 0; k < 2; ++k) \
        acc[ai][bj][m][n] = __builtin_amdgcn_mfma_f32_16x16x32_bf16(Bt[n][k], At[m][k], acc[ai][bj][m][n], 0, 0, 0); __builtin_amdgcn_s_setprio(0); } while (0)
#define PG8_WAIT_V(n) asm volatile("s_waitcnt vmcnt(" #n ")" ::: "memory")
#define PG8_WAIT_L(n) asm volatile("s_waitcnt lgkmcnt(" #n ")" ::: "memory")
#define PG8_BAR __builtin_amdgcn_s_barrier()
#define PG8_SCHED __builtin_amdgcn_sched_barrier(0)
#define PG8_APTR(u) ((const char*)g.A + ((size_t)(u).pm * BM * g.lda + (size_t)(u).pn * g.a_col_pn) * 2)
#define PG8_BPTR(u) ((const char*)g.Bt + (size_t)(u).pn * BM * g.ldb * 2)
    Unit cur, nxt; int ui = 0;
    if (!S.next(0, cur)) return;
    f32x4 acc[2][2][4][2];
#pragma unroll
    for (int a = 0; a < 2; ++a)
#pragma unroll
        for (int b = 0; b < 2; ++b)
#pragma unroll
            for (int m = 0; m < 4; ++m)
#pragma unroll
                for (int n = 0; n < 2; ++n) acc[a][b][m][n] = (f32x4){0.f, 0.f, 0.f, 0.f};
    bf16x8 At[4][2], B0[2][2], B1[2][2];
    const char* cA = PG8_APTR(cur); const char* cB = PG8_BPTR(cur);
    if constexpr (SP2) {
        PG8_STAGE(PG8_SB(0, 0), cB, voffB); PG8_STAGE(PG8_SB(0, 1), cB + hstepB, voffB); PG8_STAGE(PG8_SA(0, 0), cA, voffA); PG8_STAGE(PG8_SA(0, 1), cA + hstepA, voffA);
        if (wr == 1) PG8_BAR;
        PG8_WAIT_V(2); PG8_BAR;
        PG8_STAGE(PG8_SB(1, 0), cB + kstep, voffB); PG8_STAGE(PG8_SA(1, 0), cA + kstep, voffA); PG8_STAGE(PG8_SB(1, 1), cB + hstepB + kstep, voffB);
        PG8_WAIT_V(6); PG8_BAR;
    } else {
        PG8_STAGE(PG8_SB(0, 0), cB, voffB); PG8_STAGE(PG8_SA(0, 0), cA, voffA); PG8_STAGE(PG8_SB(0, 1), cB + hstepB, voffB); PG8_STAGE(PG8_SA(0, 1), cA + hstepA, voffA);
        if (wr == 1) PG8_BAR;
        PG8_WAIT_V(4); PG8_BAR;
        PG8_STAGE(PG8_SB(1, 0), cB + kstep, voffB); PG8_STAGE(PG8_SA(1, 0), cA + kstep, voffA); PG8_STAGE(PG8_SB(1, 1), cB + hstepB + kstep, voffB);
        PG8_WAIT_V(6); PG8_BAR;
    }
    for (;;) {
        const bool has_next = S.next(ui + 1, nxt);
        const char* nA = has_next ? PG8_APTR(nxt) : cA; const char* nB = has_next ? PG8_BPTR(nxt) : cB;
#pragma unroll 1
        for (int t = 0; t < nt; t += 2) {
            const bool last = (t == nt - 2);
            const char* a1 = cA + (size_t)(t + 1) * kstep;
            const char* a2 = last ? nA : cA + (size_t)(t + 2) * kstep; const char* b2 = last ? nB : cB + (size_t)(t + 2) * kstep;
            const char* a3 = a2 + kstep; const char* b3 = b2 + kstep;
            if constexpr (SP2) {
            PG8_LDB(B0, 0, 0); PG8_LDB(B1, 0, 1); PG8_SCHED; PG8_LDA(At, 0, 0); PG8_STAGE(PG8_SA(1, 1), a1 + hstepA, voffA);
            PG8_WAIT_V(8); PG8_WAIT_L(0); PG8_BAR; PG8_MMA(0, 0, At, B0); PG8_MMA(0, 1, At, B1); PG8_BAR; PG8_SCHED;
            PG8_LDA(At, 0, 1); PG8_STAGE(PG8_SB(0, 0), b2, voffB); PG8_STAGE(PG8_SB(0, 1), b2 + hstepB, voffB); PG8_STAGE(PG8_SA(0, 0), a2, voffA);
            PG8_WAIT_V(8); PG8_WAIT_L(0); PG8_BAR; PG8_MMA(1, 0, At, B0); PG8_MMA(1, 1, At, B1); PG8_BAR; PG8_SCHED;
            PG8_LDB(B0, 1, 0); PG8_LDB(B1, 1, 1); PG8_SCHED; PG8_LDA(At, 1, 0); PG8_STAGE(PG8_SA(0, 1), a2 + hstepA, voffA);
            PG8_WAIT_V(8); PG8_WAIT_L(0); PG8_BAR; PG8_MMA(0, 0, At, B0); PG8_MMA(0, 1, At, B1); PG8_BAR; PG8_SCHED;
            PG8_LDA(At, 1, 1); PG8_STAGE(PG8_SB(1, 0), b3, voffB); PG8_STAGE(PG8_SB(1, 1), b3 + hstepB, voffB); PG8_STAGE(PG8_SA(1, 0), a3, voffA);
            PG8_WAIT_V(8); PG8_WAIT_L(0); PG8_BAR; PG8_MMA(1, 0, At, B0); PG8_MMA(1, 1, At, B1); PG8_BAR; PG8_SCHED;
            } else {
            PG8_LDB(B0, 0, 0); PG8_SCHED; PG8_LDA(At, 0, 0); PG8_STAGE(PG8_SA(1, 1), a1 + hstepA, voffA);
            PG8_WAIT_L(8); PG8_BAR; PG8_WAIT_L(0); PG8_MMA(0, 0, At, B0); PG8_BAR; PG8_SCHED;
            PG8_LDB(B1, 0, 1); PG8_STAGE(PG8_SB(0, 0), b2, voffB);
            PG8_BAR; PG8_WAIT_L(0); PG8_MMA(0, 1, At, B1); PG8_BAR;
            PG8_LDA(At, 0, 1); PG8_STAGE(PG8_SA(0, 0), a2, voffA);
            PG8_BAR; PG8_WAIT_L(0); PG8_MMA(1, 0, At, B0); PG8_BAR; PG8_SCHED;
            PG8_STAGE(PG8_SB(0, 1), b2 + hstepB, voffB);
            PG8_WAIT_V(6); PG8_BAR; PG8_MMA(1, 1, At, B1); PG8_BAR;
            PG8_LDB(B0, 1, 0); PG8_SCHED; PG8_LDA(At, 1, 0); PG8_STAGE(PG8_SA(0, 1), a2 + hstepA, voffA);
            PG8_WAIT_L(8); PG8_BAR; PG8_WAIT_L(0); PG8_MMA(0, 0, At, B0); PG8_BAR; PG8_SCHED;
            PG8_LDB(B1, 1, 1); PG8_STAGE(PG8_SB(1, 0), b3, voffB);
            PG8_BAR; PG8_WAIT_L(0); PG8_MMA(0, 1, At, B1); PG8_BAR;
            PG8_LDA(At, 1, 1); PG8_STAGE(PG8_SA(1, 0), a3, voffA);
            PG8_BAR; PG8_WAIT_L(0); PG8_MMA(1, 0, At, B0); PG8_BAR; PG8_SCHED;
            PG8_STAGE(PG8_SB(1, 1), b3 + hstepB, voffB);
            PG8_WAIT_V(6); PG8_BAR; PG8_MMA(1, 1, At, B1); PG8_BAR;
            }
        }
        if constexpr (ALIGN_EPI) { if (wr == 0) PG8_BAR; }
        E(acc, cur, wr, wc, fr, fq);
        if (!has_next) break;
#pragma unroll
        for (int a = 0; a < 2; ++a)
#pragma unroll
            for (int b = 0; b < 2; ++b)
#pragma unroll
                for (int m = 0; m < 4; ++m)
#pragma unroll
                    for (int n = 0; n < 2; ++n) acc[a][b][m][n] = (f32x4){0.f, 0.f, 0.f, 0.f};
        cur = nxt; cA = nA; cB = nB; ++ui;
        if constexpr (ALIGN_EPI) { if (wr == 1) PG8_BAR; }
    }
    PG8_WAIT_V(0);
    if constexpr (!ALIGN_EPI) { if (wr == 0) PG8_BAR; }
    PG8_BAR;
#undef PG8_SA
#undef PG8_SB
#undef PG8_STAGE
#undef PG8_LDA
#undef PG8_LDB
#undef PG8_MMA
#undef PG8_WAIT_V
#undef PG8_WAIT_L
#undef PG8_BAR
#undef PG8_SCHED
#undef PG8_APTR
#undef PG8_BPTR
}
#else
static thread_local float* emu_tile = nullptr;
template <class Epi, class Sched, bool ALIGN_EPI = false, bool SP2 = false>
static void gemm_phase(unsigned char* lds, const Gemm g, const Sched& S, const Epi& E, const int tid_) {
    const int tid = tid_, wid = tid >> 6, lane = tid & 63, wr = wid >> 2, wc = wid & 3, fr = lane & 15, fq = lane >> 4;
    if (!emu_tile) emu_tile = (float*)malloc(256 * 256 * 4);
    Unit u;
    for (int i = 0; S.next(i, u); ++i) {
        const bf16_t* A = g.A + (size_t)u.pm * BM * g.lda + (size_t)u.pn * g.a_col_pn; const bf16_t* Bt = g.Bt + (size_t)u.pn * BM * g.ldb;
        { const int r = tid >> 1, c0 = (tid & 1) * 128; std::vector<float> ar(g.K); for (int k = 0; k < g.K; ++k) ar[k] = bf2f(A[(size_t)r * g.lda + k]);
          for (int c = c0; c < c0 + 128; ++c) { const bf16_t* br = Bt + (size_t)c * g.ldb; float s0 = 0, s1 = 0, s2 = 0, s3 = 0; for (int k = 0; k < g.K; k += 4) { s0 += ar[k] * bf2f(br[k]); s1 += ar[k + 1] * bf2f(br[k + 1]); s2 += ar[k + 2] * bf2f(br[k + 2]); s3 += ar[k + 3] * bf2f(br[k + 3]); } emu_tile[r * 256 + c] = (s0 + s1) + (s2 + s3); } }
        __syncthreads();
        f32x4 acc[2][2][4][2];
        for (int ai = 0; ai < 2; ++ai) for (int bj = 0; bj < 2; ++bj) for (int m = 0; m < 4; ++m) for (int n = 0; n < 2; ++n) for (int e = 0; e < 4; ++e) {
            const int r = 128 * ai + 64 * wr + 16 * m + fr; const int c = Epi::PERM ? (128 * bj + 32 * wc + 8 * fq + 4 * n + e) : (128 * bj + 32 * wc + 16 * n + 4 * fq + e);
            acc[ai][bj][m][n][e] = emu_tile[r * 256 + c]; }
        E(acc, u, wr, wc, fr, fq);
        __syncthreads();
    }
}
#endif
}

constexpr size_t al256(size_t x) { return (x + 255) & ~(size_t)255; }
constexpr size_t WS_CTL = 0, CTL_BYTES = 1u << 20;
constexpr size_t WS_MOD = WS_CTL + CTL_BYTES;
constexpr size_t SZ_MOD = al256((size_t)DEPTH * 3 * 6 * D * 4);
constexpr int ADA_KC = 16;
constexpr size_t WS_ADAP = WS_MOD + SZ_MOD;
constexpr size_t SZ_ADAP = al256((size_t)DEPTH * ADA_KC * 3 * 6 * D * 4);
constexpr size_t WL_WIN = 0, WL_WOUT = WL_WIN + (size_t)INWP * D * 2, WL_WGU = WL_WOUT + (size_t)D * D * 2, WL_WDN = WL_WGU + (size_t)2 * DFF * D * 2,
                 WL_GUP = WL_WDN + (size_t)D * DFF * 2, WL_POOL = WL_GUP + (size_t)RW * GL * 2, WL_DUP = WL_POOL + (size_t)4 * PG * PG * 2,
                 WL_IUP = WL_DUP + (size_t)2 * RW * LORA * 2, WL_SIZE = al256(WL_IUP + (size_t)2 * RW * LORA * 2);
constexpr size_t WS_W = WS_ADAP + SZ_ADAP;
constexpr size_t WS_XN = WS_W + WL_SIZE * DEPTH;
constexpr size_t WS_MIX = WS_XN + (size_t)MR * D * 2;
constexpr size_t WS_CTXH = WS_MIX + (size_t)MR * D * 2;
constexpr size_t WS_SSEG = WS_CTXH + (size_t)MC * D * 4;
constexpr size_t SZ_ST = (size_t)NB * NH * 2 * NSEG * 4096 * 4;
constexpr size_t WS_PSEG = WS_SSEG + SZ_ST, WS_HIN = WS_PSEG + SZ_ST;
constexpr size_t WS_BS = WS_HIN + SZ_ST;
constexpr size_t WS_BIG = al256(WS_BS + (size_t)2 * MR * NH * 4);
constexpr size_t WS_U = WS_BIG;
constexpr size_t WS_YF = WS_U + (size_t)MR * INWP * 2;
constexpr size_t WS_G = WS_YF + (size_t)2 * MR * RW * 4;
constexpr size_t WS_PD = WS_G + (size_t)MR * RW * 2;
constexpr size_t WS_VS = WS_PD + (size_t)MR * PWD * 2;
constexpr size_t WS_BIG_END1 = WS_VS + (size_t)ML * PWD * 2;
constexpr size_t WS_H = WS_BIG;
constexpr size_t WS_BIG_END2 = WS_H + (size_t)MR * DFF * 2;
constexpr size_t WS_END = WS_BIG_END1 > WS_BIG_END2 ? WS_BIG_END1 : WS_BIG_END2;
constexpr int CW_BAR = 4096;

constexpr int IMG = 8192;
constexpr int M_RT = 0, M_AT = 1, M_KB = 2, M_BB = 3, M_KT = 4, M_BT = 5, M_VT = 6, M_AAK = 7, M_ARK = 8, M_ARB = 9, M_TM = 10, M_H0 = 11, M_H1 = 12, M_T0 = 13;
constexpr int SC_DIAG = 18 * IMG;
constexpr int SC_GC = SC_DIAG + 4096;
constexpr int MISC_OFF = SC_GC + 256;
constexpr int LDS_BYTES = MISC_OFF + 256;
constexpr int SCR_G = M_T0 * IMG, SCR_AI = SCR_G + 64 * 68 * 4;
static_assert(SCR_AI + 64 * 68 * 4 <= 18 * IMG, "scratch overlay");
static_assert(LDS_BYTES <= 160 * 1024 && pg8::STAGE_BYTES <= MISC_OFF, "LDS");

#define XB_TMO      128
#define XB_XCNT(j)  (256  + 64 * (j))
#define XB_XSUB(j)  (1280 + 64 * (j))
#define XB_XGEN(j)  (2304 + 64 * (j))
#define XB_TOP      3328
#define XB_TOPGEN   3392
#define XCD_BAR_WORDS 3456
#define XB_SPIN_CAP (1u << 18)
#ifndef EMU
__device__ __forceinline__ unsigned xb_ld(unsigned* p)              { return __hip_atomic_load(p, __ATOMIC_RELAXED, __HIP_MEMORY_SCOPE_AGENT); }
__device__ __forceinline__ unsigned xb_add(unsigned* p, unsigned v) { return __hip_atomic_fetch_add(p, v, __ATOMIC_RELAXED, __HIP_MEMORY_SCOPE_AGENT); }
__device__ __forceinline__ unsigned xb_xcc_id() { return (unsigned)__builtin_amdgcn_s_getreg((3 << 11) | 20) & 0xFu; }
#define XB_SPIN(cond, bar) do { unsigned _sp = 0; while (cond) { __builtin_amdgcn_s_sleep(1); \
    if ((++_sp & 255u) == 0u) { if (xb_ld(&(bar)[XB_TMO])) break; if (_sp > XB_SPIN_CAP) { atomicAdd(&(bar)[XB_TMO], 1u); break; } } } } while (0)
struct XcdBarrier { unsigned* bar; unsigned x; volatile LAS unsigned* st; };
__device__ __forceinline__ XcdBarrier xcd_barrier_post(unsigned* bar, volatile LAS unsigned* st) {
    XcdBarrier b; b.bar = bar; b.x = xb_xcc_id(); b.st = st;
    if (threadIdx.x == 0) (void)xb_add(&bar[XB_XCNT(b.x)], 1u);
    return b;
}
__device__ __forceinline__ void xcd_barrier_complete(unsigned* bar, unsigned x, unsigned& nloc, unsigned& nx) {
    const unsigned G = gridDim.x * gridDim.y * gridDim.z;
    unsigned sum, cnt, mine, sp = 0u;
    for (;;) {
        sum = 0u; cnt = 0u; mine = 0u;
#pragma unroll
        for (unsigned j = 0; j < 16; ++j) { const unsigned c = xb_ld(&bar[XB_XCNT(j)]); sum += c; cnt += (c > 0u) ? 1u : 0u; mine = (j == x) ? c : mine; }
        if (sum == G) break;
        __builtin_amdgcn_s_sleep(1);
        if ((++sp & 255u) == 0u) { if (xb_ld(&bar[XB_TMO])) break; if (sp > XB_SPIN_CAP) { atomicAdd(&bar[XB_TMO], 1u); break; } }
    }
    nloc = mine > 0u ? mine : 1u; nx = cnt > 0u ? cnt : 1u;
}
__device__ __forceinline__ void xcd_barrier(const XcdBarrier& b) {
    asm volatile("s_waitcnt vmcnt(0)" ::: "memory");
    __syncthreads();
    if (threadIdx.x == 0) {
        unsigned* bar = b.bar;
        __builtin_amdgcn_s_waitcnt(0);
        unsigned nloc = b.st[0], nx = b.st[1];
        if (nloc == 0u) { xcd_barrier_complete(bar, b.x, nloc, nx); b.st[0] = nloc; b.st[1] = nx; }
        const unsigned old = xb_add(&bar[XB_XSUB(b.x)], 1u);
        const unsigned gen = old / nloc;
        if (old + 1u == (gen + 1u) * nloc) {
            __builtin_amdgcn_fence(__ATOMIC_RELEASE, "agent");
            asm volatile("s_waitcnt vmcnt(0)" ::: "memory");
            const unsigned og = xb_add(&bar[XB_TOP], 1u);
            const unsigned tg = og / nx;
            if (og + 1u == (tg + 1u) * nx) xb_add(&bar[XB_TOPGEN], 1u);
            else XB_SPIN(xb_ld(&bar[XB_TOPGEN]) == tg, bar);
            __builtin_amdgcn_fence(__ATOMIC_ACQUIRE, "agent");
            xb_add(&bar[XB_XGEN(b.x)], 1u);
            asm volatile("s_waitcnt vmcnt(0)" ::: "memory");
        } else {
            XB_SPIN(xb_ld(&bar[XB_XGEN(b.x)]) == gen, bar);
            __builtin_amdgcn_fence(__ATOMIC_ACQUIRE, "agent");
            asm volatile("s_waitcnt vmcnt(0)" ::: "memory");
        }
    }
    __syncthreads();
}
#else
struct XcdBarrier { unsigned* bar; };
static inline void xcd_barrier(const XcdBarrier&) { fprintf(stderr, "EMU: grid barrier not supported (use per-phase launches)\n"); abort(); }
#endif

struct Inputs {
    const float *x, *c, *ctx, *c_ctx, *ada_w, *ada_b, *norm_mix, *norm_ffn, *w_in, *conv_rkv, *decay_bias, *decay_up, *iclr_bias, *iclr_up, *gate_up,
        *k_k, *k_a, *r_k, *gn_w, *gn_b, *pool_w, *pool_scale, *w_out, *ffn_gate, *ffn_up, *ffn_down, *final_norm;
};
struct Args { Inputs in; float* out; unsigned char* ws; int ph_lo, ph_hi; };
struct Frame {
    LAS unsigned char* lds;
    int tid, lane, wave, vcu, G;
    float* out; unsigned char* ws;
};
DI bf16_t* wl_ptr(const Frame& F, int l, size_t off) { return (bf16_t*)(F.ws + WS_W + (size_t)l * WL_SIZE + off); }
DI const float* mod_ptr(const Frame& F, int l, int s, int j) { return (const float*)(F.ws + WS_MOD) + ((size_t)(l * 3 + s) * 6 + j) * D; }
DI int sample_of_row(int row) { return row < ML ? row / SEQ : 2; }

DI void p0_transpose_item(const float* W, int N, bf16_t* WT, int ldo, int dst_row0, LAS float* scr, int k0, int n0, int lane) {
#pragma unroll 8
    for (int i = 0; i < 32; ++i) { const int kk = 2 * i + (lane >> 5); scr[kk * 33 + (lane & 31)] = W[(size_t)(k0 + kk) * N + n0 + (lane & 31)]; }
    LDS_WAIT();
    const int c = lane & 7;
#pragma unroll
    for (int j = 0; j < 4; ++j) { const int n = (lane >> 3) + 8 * j; const LAS float* s = scr + (8 * c) * 33 + n;
        u32x4 o; o.x = pk2(s[0 * 33], s[1 * 33]); o.y = pk2(s[2 * 33], s[3 * 33]); o.z = pk2(s[4 * 33], s[5 * 33]); o.w = pk2(s[6 * 33], s[7 * 33]);
        *(u32x4*)(WT + (size_t)(dst_row0 + n) * ldo + k0 + 8 * c) = o; }
    LDS_WAIT();
}
DI void phase_p0(Frame& F, const CAS Inputs& IN_) {
    LAS float* scr = (LAS float*)(F.lds + F.wave * 16384);
    const int gw = F.vcu * 8 + F.wave, NGW = F.G * 8;
    constexpr int I_WIN = (D / 64) * (INW / 32), I_WOUT = (D / 64) * (D / 32), I_G = (D / 64) * (DFF / 32), I_DN = (DFF / 64) * (D / 32), I_GUP = (GL / 64) * (RW / 32), I_POOL = 4 * (PG / 64) * (PG / 32);
    constexpr int I_LAYER = I_WIN + I_WOUT + 2 * I_G + I_DN + I_GUP + I_POOL;
    for (int it = gw; it < I_LAYER * DEPTH; it += NGW) {
        const int l = it / I_LAYER; int r = it % I_LAYER;
        if (r < I_WIN) { const int nb = INW / 32, kb = r / nb, n0 = 32 * (r % nb); p0_transpose_item(IN_.w_in + (size_t)l * D * INW, INW, wl_ptr(F, l, WL_WIN), D, n0, scr, 64 * kb, n0, F.lane); continue; } r -= I_WIN;
        if (r < I_WOUT) { const int nb = D / 32, kb = r / nb, n0 = 32 * (r % nb); p0_transpose_item(IN_.w_out + (size_t)l * D * D, D, wl_ptr(F, l, WL_WOUT), D, n0, scr, 64 * kb, n0, F.lane); continue; } r -= I_WOUT;
        if (r < 2 * I_G) { const int up = r >= I_G; if (up) r -= I_G; const int nb = DFF / 32, kb = r / nb, n0 = 32 * (r % nb);
            p0_transpose_item((up ? IN_.ffn_up : IN_.ffn_gate) + (size_t)l * D * DFF, DFF, wl_ptr(F, l, WL_WGU), D, (n0 / 128) * 256 + (n0 % 128) + (up ? 128 : 0), scr, 64 * kb, n0, F.lane); continue; } r -= 2 * I_G;
        if (r < I_DN) { const int nb = D / 32, kb = r / nb, n0 = 32 * (r % nb); p0_transpose_item(IN_.ffn_down + (size_t)l * DFF * D, D, wl_ptr(F, l, WL_WDN), DFF, n0, scr, 64 * kb, n0, F.lane); continue; } r -= I_DN;
        if (r < I_GUP) { const int nb = RW / 32, kb = r / nb, n0 = 32 * (r % nb); p0_transpose_item(IN_.gate_up + (size_t)l * GL * RW, RW, wl_ptr(F, l, WL_GUP), GL, n0, scr, 64 * kb, n0, F.lane); continue; } r -= I_GUP;
        { const int gi = r / ((PG / 64) * (PG / 32)); r %= (PG / 64) * (PG / 32); const int nb = PG / 32, kb = r / nb, n0 = 32 * (r % nb);
          p0_transpose_item(IN_.pool_w + ((size_t)l * 4 + gi) * PG * PG, PG, wl_ptr(F, l, WL_POOL) + (size_t)gi * PG * PG, PG, n0, scr, 64 * kb, n0, F.lane); }
    }
    const int gt = F.vcu * 512 + F.tid, NGT = F.G * 512;
    for (int i = gt; i < DEPTH * (INWP - INW) * D / 8; i += NGT) { const int l = i / ((INWP - INW) * D / 8), r = i % ((INWP - INW) * D / 8);
        *(u32x4*)(wl_ptr(F, l, WL_WIN) + (size_t)INW * D + (size_t)r * 8) = (u32x4){0u, 0u, 0u, 0u}; }
    for (int i = gt; i < DEPTH * 2 * 2 * RW * LORA; i += NGT) { int r = i; const int k = r % LORA; r /= LORA; const int n = r % RW; r /= RW; const int d = r % 2; r /= 2; const int which = r % 2; const int l = r / 2;
        const float* src = (which ? IN_.iclr_up : IN_.decay_up) + (((size_t)l * 2 + d) * LORA + k) * RW + n;
        wl_ptr(F, l, which ? WL_IUP : WL_DUP)[((size_t)d * RW + n) * LORA + k] = (bf16_t)f2bf(*src); }
    constexpr int NJB = 6 * D / 256, KCH = D / ADA_KC;
    for (int it = gw; it < DEPTH * NJB * ADA_KC; it += NGW) {
        const int kc = it % ADA_KC, jb = (it / ADA_KC) % NJB, l = it / (ADA_KC * NJB);
        const float* w = IN_.ada_w + ((size_t)l * D + (size_t)kc * KCH) * 6 * D + jb * 256 + 4 * F.lane;
        f32x4 a0 = {0.f, 0.f, 0.f, 0.f}, a1 = a0, a2 = a0;
#pragma unroll 8
        for (int k = 0; k < KCH; ++k) { const int kk = kc * KCH + k; const f32x4 wv = *(const f32x4*)(w + (size_t)k * 6 * D);
            const float c0 = fsilu(IN_.c[kk]), c1 = fsilu(IN_.c[D + kk]), c2 = fsilu(IN_.c_ctx[kk]);
            a0 += wv * c0; a1 += wv * c1; a2 += wv * c2; }
        float* p = (float*)(F.ws + WS_ADAP) + (((size_t)l * ADA_KC + kc) * 3) * 6 * D + jb * 256 + 4 * F.lane;
        *(f32x4*)(p) = a0; *(f32x4*)(p + 6 * D) = a1; *(f32x4*)(p + 12 * D) = a2;
    }
}
DI void phase_p0b(Frame& F, const CAS Inputs& IN_) {
    const int gt = F.vcu * 512 + F.tid, NGT = F.G * 512;
    for (int i = gt; i < DEPTH * 3 * 6 * D; i += NGT) { const int j = i % (6 * D), s = (i / (6 * D)) % 3, l = i / (18 * D);
        float a = IN_.ada_b[(size_t)l * 6 * D + j];
        for (int kc = 0; kc < ADA_KC; ++kc) a += ((const float*)(F.ws + WS_ADAP))[(((size_t)l * ADA_KC + kc) * 3 + s) * 6 * D + j];
        ((float*)(F.ws + WS_MOD))[i] = a; }
}

DI void phase_norm(Frame& F, const CAS Inputs& IN_, int l, bool second, int nrows) {
    const int gw = F.vcu * 8 + F.wave, NGW = F.G * 8;
    const float* gvec = (second ? IN_.norm_ffn : IN_.norm_mix) + (size_t)l * D;
    bf16_t* XN = (bf16_t*)(F.ws + WS_XN);
    for (int row = gw; row < nrows; row += NGW) {
        const float* xr;
        if (row < ML) xr = ((l == 0 && !second) ? IN_.x : F.out) + (size_t)row * D;
        else xr = ((l == 0 && !second) ? IN_.ctx : (const float*)(F.ws + WS_CTXH)) + (size_t)(row - ML) * D;
        const int s = sample_of_row(row);
        const float* sh = mod_ptr(F, l, s, second ? 3 : 0); const float* sc = mod_ptr(F, l, s, second ? 4 : 1);
        f32x4 v[8]; float ss = 0.f;
#pragma unroll
        for (int j = 0; j < 8; ++j) { v[j] = *(const f32x4*)(xr + 4 * (F.lane + 64 * j)); ss += (v[j].x * v[j].x + v[j].y * v[j].y) + (v[j].z * v[j].z + v[j].w * v[j].w); }
        const float rs = frsq(wave_sum(ss) * (1.f / D) + RMS_EPS);
#pragma unroll
        for (int j = 0; j < 8; ++j) { const int c = 4 * (F.lane + 64 * j); const f32x4 g = *(const f32x4*)(gvec + c), a = *(const f32x4*)(sc + c), b = *(const f32x4*)(sh + c);
            const f32x4 o = v[j] * rs * g * (a + 1.0f) + b; u32x2 w; w.x = pk2(o.x, o.y); w.y = pk2(o.z, o.w); *(u32x2*)(XN + (size_t)row * D + c) = w; }
    }
}
DI void phase_final_norm(Frame& F, const CAS Inputs& IN_) {
    const int gw = F.vcu * 8 + F.wave, NGW = F.G * 8;
    for (int row = gw; row < ML; row += NGW) {
        float* xr = F.out + (size_t)row * D; f32x4 v[8]; float ss = 0.f;
#pragma unroll
        for (int j = 0; j < 8; ++j) { v[j] = *(const f32x4*)(xr + 4 * (F.lane + 64 * j)); ss += (v[j].x * v[j].x + v[j].y * v[j].y) + (v[j].z * v[j].z + v[j].w * v[j].w); }
        const float rs = frsq(wave_sum(ss) * (1.f / D) + RMS_EPS);
#pragma unroll
        for (int j = 0; j < 8; ++j) { const int c = 4 * (F.lane + 64 * j); *(f32x4*)(xr + c) = v[j] * rs * *(const f32x4*)(IN_.final_norm + c); }
    }
}

struct EpiU {
    static constexpr bool PERM = true;
    bf16_t* O; int ldc; int act;
    DI void operator()(const f32x4 (&acc)[2][2][4][2], const pg8::Unit& u, int wr, int wc, int fr, int fq) const {
        const int row0 = u.pm * 256 + wr * 64 + fr, col0 = u.pn * 256 + wc * 32 + 8 * fq;
        const bool special = act && (col0 + 128 + 8 > OFF_W) && (col0 < OFF_POOL);
#pragma unroll
        for (int ai = 0; ai < 2; ++ai)
#pragma unroll
            for (int m = 0; m < 4; ++m) { bf16_t* rowp = O + (size_t)(row0 + ai * 128 + m * 16) * ldc + col0;
#pragma unroll
                for (int bj = 0; bj < 2; ++bj) { f32x4 v0 = acc[ai][bj][m][0], v1 = acc[ai][bj][m][1];
                    if (special) { const int c = col0 + bj * 128;
                        if (c >= OFF_W && c < OFF_A) {
#pragma unroll
                            for (int e = 0; e < 4; ++e) { v0[e] = ftanh(v0[e]); v1[e] = ftanh(v1[e]); } }
                        else if (c >= OFF_G && c < OFF_POOL) {
#pragma unroll
                            for (int e = 0; e < 4; ++e) { v0[e] = fsigmoid(v0[e]); v1[e] = fsigmoid(v1[e]); } } }
                    u32x4 w; w.x = pk2(v0[0], v0[1]); w.y = pk2(v0[2], v0[3]); w.z = pk2(v1[0], v1[1]); w.w = pk2(v1[2], v1[3]);
                    *(u32x4*)(rowp + bj * 128) = w; } }
    }
};
struct EpiPool {
    static constexpr bool PERM = true;
    bf16_t* O; const float* scale;
    DI void operator()(const f32x4 (&acc)[2][2][4][2], const pg8::Unit& u, int wr, int wc, int fr, int fq) const {
        const int row0 = u.pm * 256 + wr * 64 + fr, col0 = u.pn * 256 + wc * 32 + 8 * fq;
#pragma unroll
        for (int bj = 0; bj < 2; ++bj) { const f32x4 s0 = *(const f32x4*)(scale + col0 + bj * 128), s1 = *(const f32x4*)(scale + col0 + bj * 128 + 4);
#pragma unroll
            for (int ai = 0; ai < 2; ++ai)
#pragma unroll
                for (int m = 0; m < 4; ++m) { bf16_t* rowp = O + (size_t)(row0 + ai * 128 + m * 16) * D + RW + col0;
                    const f32x4 v0 = acc[ai][bj][m][0] * s0, v1 = acc[ai][bj][m][1] * s1;
                    u32x4 w; w.x = pk2(v0[0], v0[1]); w.y = pk2(v0[2], v0[3]); w.z = pk2(v1[0], v1[1]); w.w = pk2(v1[2], v1[3]);
                    *(u32x4*)(rowp + bj * 128) = w; }
            CFENCE(); }
    }
};
struct EpiSwiglu {
    static constexpr bool PERM = true;
    bf16_t* O;
    DI void operator()(const f32x4 (&acc)[2][2][4][2], const pg8::Unit& u, int wr, int wc, int fr, int fq) const {
        const int row0 = u.pm * 256 + wr * 64 + fr, col0 = u.pn * 128 + wc * 32 + 8 * fq;
#pragma unroll
        for (int ai = 0; ai < 2; ++ai)
#pragma unroll
            for (int m = 0; m < 4; ++m) { f32x4 v0, v1;
#pragma unroll
                for (int e = 0; e < 4; ++e) { v0[e] = fsilu(acc[ai][0][m][0][e]) * acc[ai][1][m][0][e]; v1[e] = fsilu(acc[ai][0][m][1][e]) * acc[ai][1][m][1][e]; }
                u32x4 w; w.x = pk2(v0[0], v0[1]); w.y = pk2(v0[2], v0[3]); w.z = pk2(v1[0], v1[1]); w.w = pk2(v1[2], v1[3]);
                *(u32x4*)(O + (size_t)(row0 + ai * 128 + m * 16) * DFF + col0) = w; }
    }
};
struct EpiRes {
    static constexpr bool PERM = false;
    const float* base_l; float* out_l; long long dbase_c, dout_c; const float* gate0;
    DI void operator()(const f32x4 (&acc)[2][2][4][2], const pg8::Unit& u, int wr, int wc, int fr, int fq) const {
        const bool lat = u.pm < NPM_L; const int prow = lat ? u.pm * 256 : (u.pm - NPM_L) * 256;
        const float* base = (const float*)((const char*)base_l + (lat ? 0ll : dbase_c)); float* out = (float*)((char*)out_l + (lat ? 0ll : dout_c));
        const float* gv = gate0 + (size_t)(lat ? (u.pm * 256) / SEQ : 2) * 6 * D;
        const int row0 = prow + wr * 64 + fr, col0 = u.pn * 256 + wc * 32 + 4 * fq;
        f32x4 g4[2][2];
#pragma unroll
        for (int bj = 0; bj < 2; ++bj)
#pragma unroll
            for (int n = 0; n < 2; ++n) g4[bj][n] = *(const f32x4*)(gv + col0 + bj * 128 + n * 16);
#pragma unroll
        for (int ai = 0; ai < 2; ++ai)
#pragma unroll
            for (int m = 0; m < 4; ++m) { const size_t off = (size_t)(row0 + ai * 128 + m * 16) * D + col0;
#pragma unroll
                for (int bj = 0; bj < 2; ++bj)
#pragma unroll
                    for (int n = 0; n < 2; ++n) { const f32x4 b = *(const f32x4*)(base + off + bj * 128 + n * 16); *(f32x4*)(out + off + bj * 128 + n * 16) = b + g4[bj][n] * acc[ai][bj][m][n]; }
                CFENCE(); }
    }
};

DI int img_off(int r, int c) { return r * 128 + ((((c >> 3) ^ (r & 7)) << 4) | ((c & 7) << 1)); }
DI bf16x8 ldfrag(const LAS unsigned char* img, int r0, int k0, int lane) { const int r = r0 + (lane & 15), c = k0 + 8 * (lane >> 4); return *(const LAS bf16x8*)(img + r * 128 + (((c >> 3) ^ (r & 7)) << 4)); }
template <int KK> DI f32x4 tile_mm(f32x4 acc, const LAS unsigned char* X, int x0, const LAS unsigned char* Y, int y0, int lane) {
#pragma unroll
    for (int ks = 0; ks < KK / 32; ++ks) { const bf16x8 xf = ldfrag(X, x0, 32 * ks, lane), yf = ldfrag(Y, y0, 32 * ks, lane); acc = MFMA16(xf, yf, acc); }
    return acc;
}
DI void st_tile(LAS unsigned char* img, int yrow, int xcol, const f32x4& v) { u32x2 w; w.x = pk2(v[0], v[1]); w.y = pk2(v[2], v[3]); *(LAS u32x2*)(img + img_off(yrow, xcol)) = w; }
DI f32x4 ld_tile(const LAS unsigned char* img, int yrow, int xcol) { const u32x2 w = *(const LAS u32x2*)(img + img_off(yrow, xcol)); return (f32x4){bflo(w.x), bfhi(w.x), bflo(w.y), bfhi(w.y)}; }

struct ScanItem { int b, h, dir, seg; };
DI int item_index(const ScanItem& it) { return ((it.b * NH + it.h) * 2 + it.dir) * NSEG + it.seg; }
struct SegGeom { int nchunks, seqlen, rowbase, pos0; };
DI SegGeom seg_geom(const ScanItem& it) { SegGeom g; if (it.seg == 0) { g.nchunks = CTX / 64; g.seqlen = CTX; g.rowbase = ML + it.b * CTX; g.pos0 = 0; } else { g.nchunks = SEGLEN / 64; g.seqlen = SEQ; g.rowbase = it.b * SEQ; g.pos0 = (it.seg - 1) * SEGLEN; } return g; }

template <bool PASS3>
DI void scan_item(Frame& F, const CAS Inputs& IN_, int l, const ScanItem it) {
    LAS unsigned char* L = F.lds;
    const SegGeom sg = seg_geom(it);
    const bf16_t* U = (const bf16_t*)(F.ws + WS_U);
    constexpr int NVT = PASS3 ? 4 : 8;
    constexpr int NHT = NVT * 4 / 8;
    f32x4 hacc[NHT];
    const size_t st_off = (size_t)item_index(it) * 4096;
    { const int lane = F.lane, wave = F.wave, q = lane >> 4, l15 = lane & 15;
#pragma unroll
    for (int i = 0; i < NHT; ++i) { const int t = wave + 8 * i, yt = t >> 2, xt = t & 3; const int v = 16 * yt + l15, k = 16 * xt + 4 * q;
        if (PASS3) hacc[i] = *(const f32x4*)((const float*)(F.ws + WS_HIN) + st_off + (size_t)v * 64 + k);
        else { hacc[i] = (f32x4){0.f, 0.f, 0.f, 0.f}; if (v >= 64) {
#pragma unroll
            for (int e = 0; e < 4; ++e) hacc[i][e] = (v - 64 == k + e) ? 1.f : 0.f; } }
        st_tile(L + M_H0 * IMG, v, k, hacc[i]); } }
    float* YO = (float*)(F.ws + WS_YF) + (size_t)it.dir * MR * RW;
    float* BS = (float*)(F.ws + WS_BS) + (size_t)it.dir * MR * NH;
    const bf16_t* DUP = wl_ptr(F, l, WL_DUP) + (size_t)it.dir * RW * LORA;
    const bf16_t* IUP = wl_ptr(F, l, WL_IUP) + (size_t)it.dir * RW * LORA;
    for (int c = 0; c < sg.nchunks; ++c) {
        int tid_o = F.tid; OPAQUE_V(tid_o);
        const int tid = tid_o, lane = tid & 63, wave = RFL(tid >> 6), q = lane >> 4, l15 = lane & 15;
        const int qpos0 = sg.pos0 + 64 * c;
        {
            const int mat = wave >> 2, ntile = wave & 3;
            f32x4 a4[4];
#pragma unroll
            for (int mt = 0; mt < 4; ++mt) a4[mt] = (f32x4){0.f, 0.f, 0.f, 0.f};
            const bf16_t* Wt = (mat ? IUP : DUP) + (size_t)(it.h * 64 + 16 * ntile + l15) * LORA + 8 * q;
            bf16x8 bfr[3];
#pragma unroll
            for (int ks = 0; ks < 3; ++ks) bfr[ks] = *(const bf16x8*)(Wt + 32 * ks);
#pragma unroll
            for (int mt = 0; mt < 4; ++mt) { const int qq = qpos0 + 16 * mt + l15; const int tau = it.dir ? sg.seqlen - 1 - qq : qq;
                const bf16_t* ur = U + (size_t)(sg.rowbase + tau) * INWP + (mat ? OFF_A : OFF_W) + 8 * q;
#pragma unroll
                for (int ks = 0; ks < 3; ++ks) { const bf16x8 af = *(const bf16x8*)(ur + 32 * ks); a4[mt] = MFMA16(af, bfr[ks], a4[mt]); } }
            const int chn = it.h * 64 + 16 * ntile + l15;
            if (mat == 0) {
                const float bias = IN_.decay_bias[((size_t)l * 2 + it.dir) * RW + chn];
                float run = 0.f;
                LAS float* G = (LAS float*)(L + SCR_G);
#pragma unroll
                for (int mt = 0; mt < 4; ++mt) {
                    float c0 = -0.6065306597126334f * fsigmoid(bias + a4[mt][0]), c1 = -0.6065306597126334f * fsigmoid(bias + a4[mt][1]), c2 = -0.6065306597126334f * fsigmoid(bias + a4[mt][2]), c3 = -0.6065306597126334f * fsigmoid(bias + a4[mt][3]);
                    c1 += c0; c2 += c1; c3 += c2;
                    const float t1 = __shfl(c3, lane - 16), t2 = __shfl(c3, lane - 32), t3 = __shfl(c3, lane - 48);
                    const float off = run + (q >= 1 ? t1 : 0.f) + (q >= 2 ? t2 : 0.f) + (q >= 3 ? t3 : 0.f);
                    const float tot = __shfl(off + c3, 48 + l15);
                    const int p0 = 16 * mt + 4 * q, cc = 16 * ntile + l15;
                    G[(p0 + 0) * 68 + cc] = off + c0; G[(p0 + 1) * 68 + cc] = off + c1; G[(p0 + 2) * 68 + cc] = off + c2; G[(p0 + 3) * 68 + cc] = off + c3;
                    run = tot;
                }
            } else {
                const float bias = IN_.iclr_bias[((size_t)l * 2 + it.dir) * RW + chn];
                LAS float* AI = (LAS float*)(L + SCR_AI);
#pragma unroll
                for (int mt = 0; mt < 4; ++mt) { const int p0 = 16 * mt + 4 * q, cc = 16 * ntile + l15;
#pragma unroll
                    for (int e = 0; e < 4; ++e) AI[(p0 + e) * 68 + cc] = fsigmoid(bias + a4[mt][e]); }
            }
        }
        LDS_WAIT(); WG_BAR();
#pragma unroll 1
        for (int half = 0; half < 2; ++half) {
            const int p = (tid >> 4) + 32 * half, cg = tid & 15, ch0 = it.h * 64 + 4 * cg;
            const int qq = qpos0 + p; const int tau = it.dir ? sg.seqlen - 1 - qq : qq; const size_t row = (size_t)(sg.rowbase + tau);
            const bool hasm = tau > 0, hasp = tau < sg.seqlen - 1;
            float r4[4], k4[4], v4[4];
            {
                const float* cw = IN_.conv_rkv + (size_t)l * 3 * 3 * RW;
#pragma unroll
                for (int x = 0; x < 3; ++x) {
                    const bf16_t* up = U + row * INWP + x * RW + ch0;
                    float cen[4], lo[4], hi[4];
                    unpack4(*(const u32x2*)up, cen);
                    if (hasm) unpack4(*(const u32x2*)(up - INWP), lo); else {
#pragma unroll
                        for (int j = 0; j < 4; ++j) lo[j] = 0.f; }
                    if (hasp) unpack4(*(const u32x2*)(up + INWP), hi); else {
#pragma unroll
                        for (int j = 0; j < 4; ++j) hi[j] = 0.f; }
                    const f32x4 w0 = *(const f32x4*)(cw + x * RW + ch0), w1 = *(const f32x4*)(cw + 3 * RW + x * RW + ch0), w2 = *(const f32x4*)(cw + 6 * RW + x * RW + ch0);
                    float* dst = x == 0 ? r4 : (x == 1 ? k4 : v4);
#pragma unroll
                    for (int j = 0; j < 4; ++j) dst[j] = lo[j] * w0[j] + cen[j] * w1[j] + hi[j] * w2[j];
                }
            }
            float kk4[4]; float nn = 0.f;
            { const f32x4 kkp = *(const f32x4*)(IN_.k_k + (size_t)l * RW + ch0);
#pragma unroll
              for (int j = 0; j < 4; ++j) { kk4[j] = k4[j] * kkp[j]; nn += kk4[j] * kk4[j]; } }
            nn += __shfl_xor(nn, 1); nn += __shfl_xor(nn, 2); nn += __shfl_xor(nn, 4); nn += __shfl_xor(nn, 8);
            const float inv = frsq(fmaxf(nn, 1e-24f));
            const LAS float* G = (const LAS float*)(L + SCR_G); const LAS float* AI = (const LAS float*)(L + SCR_AI);
            const f32x4 g4 = *(const LAS f32x4*)(G + p * 68 + 4 * cg), gc4 = *(const LAS f32x4*)(G + 63 * 68 + 4 * cg), a4 = *(const LAS f32x4*)(AI + p * 68 + 4 * cg);
            f32x4 gp4 = {0.f, 0.f, 0.f, 0.f}; if (p > 0) gp4 = *(const LAS f32x4*)(G + (p - 1) * 68 + 4 * cg);
            const f32x4 kap = *(const f32x4*)(IN_.k_a + (size_t)l * RW + ch0), rkp = *(const f32x4*)(IN_.r_k + (size_t)l * RW + ch0);
            float rt[4], at[4], kb[4], bb[4], kt[4], bt[4]; float bsum = 0.f;
#pragma unroll
            for (int j = 0; j < 4; ++j) { const float kkn = kk4[j] * inv; const float kd = k4[j] * (1.0f + (a4[j] - 1.0f) * kap[j]); const float bh = kkn * a4[j];
                const float eg = fexp(g4[j]), egp = fexp(gp4[j]), eng = fexp(-g4[j]), egc = fexp(gc4[j] - g4[j]);
                rt[j] = r4[j] * eg; at[j] = -kkn * egp; kb[j] = kd * eng; bb[j] = bh * eng; kt[j] = kd * egc; bt[j] = bh * egc; bsum += r4[j] * kd * rkp[j]; }
            *(LAS u32x2*)(L + M_RT * IMG + img_off(p, 4 * cg)) = pack4(rt);
            *(LAS u32x2*)(L + M_AT * IMG + img_off(p, 4 * cg)) = pack4(at);
            *(LAS u32x2*)(L + M_KB * IMG + img_off(p, 4 * cg)) = pack4(kb);
            *(LAS u32x2*)(L + M_BB * IMG + img_off(p, 4 * cg)) = pack4(bb);
#pragma unroll
            for (int j = 0; j < 4; ++j) { const int chl = 4 * cg + j;
                *(LAS unsigned short*)(L + M_KT * IMG + img_off(chl, p)) = (unsigned short)f2bf(kt[j]);
                *(LAS unsigned short*)(L + M_BT * IMG + img_off(chl, p)) = (unsigned short)f2bf(bt[j]);
                *(LAS unsigned short*)(L + M_VT * IMG + img_off(chl, p)) = (unsigned short)f2bf(v4[j]); }
            if (p == 63) {
#pragma unroll
                for (int j = 0; j < 4; ++j) ((LAS float*)(L + SC_GC))[4 * cg + j] = fexp(gc4[j]); }
            if (PASS3) { bsum += __shfl_xor(bsum, 1); bsum += __shfl_xor(bsum, 2); bsum += __shfl_xor(bsum, 4); bsum += __shfl_xor(bsum, 8); if (cg == 0) BS[row * NH + it.h] = bsum; }
        }
        LDS_WAIT(); WG_BAR();
        {
            *(LAS u32x4*)(L + (M_T0 + 1) * IMG + tid * 16) = (u32x4){0u, 0u, 0u, 0u};
            *(LAS u32x4*)(L + (M_T0 + 3) * IMG + tid * 16) = (u32x4){0u, 0u, 0u, 0u};
            for (int t = wave; t < 16; t += 8) { const int yt = t >> 2, xt = t & 3; f32x4 a = {0.f, 0.f, 0.f, 0.f};
                if (xt <= yt) { a = tile_mm<64>(a, L + M_KB * IMG, 16 * xt, L + M_AT * IMG, 16 * yt, lane);
#pragma unroll
                    for (int e = 0; e < 4; ++e) if (!(16 * xt + 4 * q + e < 16 * yt + l15)) a[e] = 0.f; }
                st_tile(L + M_AAK * IMG, 16 * yt + l15, 16 * xt + 4 * q, a); }
            for (int t = wave; t < 16; t += 8) { const int yt = t >> 2, xt = t & 3; f32x4 a = {0.f, 0.f, 0.f, 0.f};
                if (xt >= yt) a = tile_mm<64>(a, L + M_AT * IMG, 16 * xt, L + M_BB * IMG, 16 * yt, lane);
                if (xt == yt) { LAS float* DG = (LAS float*)(L + SC_DIAG) + yt * 256;
#pragma unroll
                    for (int e = 0; e < 4; ++e) DG[(4 * q + e) * 16 + l15] = (l15 < 4 * q + e) ? a[e] : 0.f;
                    a = (f32x4){0.f, 0.f, 0.f, 0.f}; }
                st_tile(L + M_T0 * IMG, 16 * yt + l15, 16 * xt + 4 * q, a); }
            if (PASS3) {
                for (int t = wave; t < 32; t += 8) { const int which = t >> 4, yt = (t >> 2) & 3, xt = t & 3; f32x4 a = {0.f, 0.f, 0.f, 0.f};
                    if (xt <= yt) { a = tile_mm<64>(a, L + (which ? M_BB : M_KB) * IMG, 16 * xt, L + M_RT * IMG, 16 * yt, lane);
#pragma unroll
                        for (int e = 0; e < 4; ++e) if (!(16 * xt + 4 * q + e <= 16 * yt + l15)) a[e] = 0.f; }
                    st_tile(L + (which ? M_ARB : M_ARK) * IMG, 16 * yt + l15, 16 * xt + 4 * q, a); }
            }
        }
        LDS_WAIT(); WG_BAR();
        if (wave == 0) {
            const int ib = q, cc = l15; const LAS float* DG = (const LAS float*)(L + SC_DIAG) + ib * 256;
            float d[16];
#pragma unroll
            for (int t = 0; t < 16; ++t) { float a = (t == cc) ? 1.f : 0.f;
                float rowv[16];
#pragma unroll
                for (int j4 = 0; j4 < 4; ++j4) { if (4 * j4 < t) { const f32x4 x = *(const LAS f32x4*)(DG + t * 16 + 4 * j4); rowv[4 * j4] = x[0]; rowv[4 * j4 + 1] = x[1]; rowv[4 * j4 + 2] = x[2]; rowv[4 * j4 + 3] = x[3]; } }
#pragma unroll
                for (int j = 0; j < t; ++j) a += rowv[j] * d[j];
                d[t] = a; }
#pragma unroll
            for (int t = 0; t < 16; ++t) *(LAS unsigned short*)(L + (M_T0 + 1) * IMG + img_off(16 * ib + t, 16 * ib + cc)) = (unsigned short)f2bf(d[t]);
            { float lo8[8], hi8[8];
#pragma unroll
              for (int t = 0; t < 8; ++t) { lo8[t] = d[t]; hi8[t] = d[8 + t]; }
              *(LAS u32x4*)(L + (M_T0 + 3) * IMG + img_off(16 * ib + cc, 16 * ib)) = pack8(lo8);
              *(LAS u32x4*)(L + (M_T0 + 3) * IMG + img_off(16 * ib + cc, 16 * ib + 8)) = pack8(hi8); }
        }
        LDS_WAIT(); WG_BAR();
        for (int t = wave; t < 16; t += 8) { const int yt = t >> 2, xt = t & 3; f32x4 a = {0.f, 0.f, 0.f, 0.f};
            if (xt < yt) a = tile_mm<64>(a, L + M_T0 * IMG, 16 * xt, L + (M_T0 + 1) * IMG, 16 * yt, lane);
            st_tile(L + (M_T0 + 2) * IMG, 16 * yt + l15, 16 * xt + 4 * q, a); }
        LDS_WAIT(); WG_BAR();
#pragma unroll
        for (int iter = 0; iter < 2; ++iter) {
            const LAS unsigned char* src = L + (M_T0 + (iter == 0 ? 3 : 4)) * IMG; LAS unsigned char* dst = L + (M_T0 + (iter == 0 ? 4 : 3)) * IMG;
            for (int t = wave; t < 16; t += 8) { const int yt = t >> 2, xt = t & 3; f32x4 a = {0.f, 0.f, 0.f, 0.f};
                if (xt == yt) {
#pragma unroll
                    for (int e = 0; e < 4; ++e) a[e] = bf2f(*(const LAS unsigned short*)(L + (M_T0 + 1) * IMG + img_off(16 * xt + 4 * q + e, 16 * yt + l15))); }
                if (xt >= yt) a = tile_mm<64>(a, L + (M_T0 + 2) * IMG, 16 * xt, src, 16 * yt, lane);
                st_tile(dst, 16 * yt + l15, 16 * xt + 4 * q, a); }
            LDS_WAIT(); WG_BAR();
        }
        for (int t = wave; t < 16; t += 8) { const int yt = t >> 2, xt = t & 3; f32x4 a = {0.f, 0.f, 0.f, 0.f};
            if (xt == yt) a = ld_tile(L + (M_T0 + 1) * IMG, 16 * yt + l15, 16 * xt + 4 * q);
            if (xt <= yt) a = tile_mm<64>(a, L + (M_T0 + 3) * IMG, 16 * xt, L + (M_T0 + 2) * IMG, 16 * yt, lane);
            st_tile(L + M_TM * IMG, 16 * yt + l15, 16 * xt + 4 * q, a); }
        LDS_WAIT(); WG_BAR();
        for (int t = wave; t < NVT * 4; t += 8) { const int yt = t >> 2, xt = t & 3; f32x4 a = {0.f, 0.f, 0.f, 0.f};
            if (yt < 4) a = tile_mm<64>(a, L + M_AAK * IMG, 16 * xt, L + M_VT * IMG, 16 * yt, lane);
            a = tile_mm<64>(a, L + M_AT * IMG, 16 * xt, L + M_H0 * IMG, 16 * yt, lane);
            st_tile(L + M_T0 * IMG, 16 * yt + l15, 16 * xt + 4 * q, a); }
        LDS_WAIT(); WG_BAR();
        for (int t = wave; t < NVT * 4; t += 8) { const int yt = t >> 2, xt = t & 3; f32x4 a = {0.f, 0.f, 0.f, 0.f};
            a = tile_mm<64>(a, L + M_TM * IMG, 16 * xt, L + M_T0 * IMG, 16 * yt, lane);
            st_tile(L + (M_T0 + 2) * IMG, 16 * yt + l15, 16 * xt + 4 * q, a); }
        LDS_WAIT(); WG_BAR();
        if (PASS3) {
            for (int t = wave; t < 16; t += 8) { const int yt = t >> 2, xt = t & 3; f32x4 a = {0.f, 0.f, 0.f, 0.f};
                a = tile_mm<64>(a, L + M_H0 * IMG, 16 * xt, L + M_RT * IMG, 16 * yt, lane);
                a = tile_mm<64>(a, L + M_VT * IMG, 16 * xt, L + M_ARK * IMG, 16 * yt, lane);
                a = tile_mm<64>(a, L + (M_T0 + 2) * IMG, 16 * xt, L + M_ARB * IMG, 16 * yt, lane);
                const int pp = 16 * yt + l15; const int qq = qpos0 + pp; const int tau = it.dir ? sg.seqlen - 1 - qq : qq;
                *(f32x4*)(YO + (size_t)(sg.rowbase + tau) * RW + it.h * 64 + 16 * xt + 4 * q) = a; }
        }
#pragma unroll
        for (int i = 0; i < NHT; ++i) { const int t = wave + 8 * i, yt = t >> 2, xt = t & 3;
            const f32x4 gc = *(const LAS f32x4*)(L + SC_GC + (16 * xt + 4 * q) * 4);
            f32x4 a = hacc[i] * gc;
            if (yt < 4) a = tile_mm<64>(a, L + M_KT * IMG, 16 * xt, L + M_VT * IMG, 16 * yt, lane);
            a = tile_mm<64>(a, L + M_BT * IMG, 16 * xt, L + (M_T0 + 2) * IMG, 16 * yt, lane);
            hacc[i] = a; }
        LDS_WAIT(); WG_BAR();
#pragma unroll
        for (int i = 0; i < NHT; ++i) { const int t = wave + 8 * i, yt = t >> 2, xt = t & 3; st_tile(L + M_H0 * IMG, 16 * yt + l15, 16 * xt + 4 * q, hacc[i]); }
        LDS_WAIT(); WG_BAR();
    }
    if (!PASS3) { const int lane = F.lane, wave = F.wave, q = lane >> 4, l15 = lane & 15;
#pragma unroll
        for (int i = 0; i < NHT; ++i) { const int t = wave + 8 * i, yt = t >> 2, xt = t & 3; const int v = 16 * yt + l15, k = 16 * xt + 4 * q;
            float* dst = (v < 64) ? (float*)(F.ws + WS_SSEG) + st_off + (size_t)v * 64 + k : (float*)(F.ws + WS_PSEG) + st_off + (size_t)(v - 64) * 64 + k;
            *(f32x4*)dst = hacc[i]; }
    }
}
DI bool scan_item_of(int idx, bool pass3, bool skip_ctx, ScanItem& it) {
    const int nl = pass3 ? NSEGL : NSEGL - 1;
    const int n_lat = NB * NH * 2 * nl, n_ctx = (pass3 && skip_ctx) ? 0 : NB * NH * 2;
    if (idx < n_lat) { it.seg = 1 + idx % nl; int r = idx / nl; it.dir = r & 1; r >>= 1; it.h = r % NH; it.b = r / NH; return true; }
    idx -= n_lat; if (idx >= n_ctx) return false;
    it.seg = 0; it.dir = idx & 1; idx >>= 1; it.h = idx % NH; it.b = idx / NH; return true;
}
DI void phase_chain(Frame& F) {
    LAS float* Sm = (LAS float*)F.lds; LAS float* Pm = Sm + 64 * 65;
    const int v = F.tid >> 3, kg = F.tid & 7;
    for (int ci = F.vcu; ci < NB * NH * 2; ci += F.G) {
        const size_t base = (size_t)ci * NSEG * 4096;
        float s8[8];
#pragma unroll
        for (int j = 0; j < 8; ++j) s8[j] = 0.f;
        for (int seg = 0; seg < NSEG; ++seg) {
            float* hin = (float*)(F.ws + WS_HIN) + base + (size_t)seg * 4096 + v * 64 + 8 * kg;
            *(f32x4*)hin = (f32x4){s8[0], s8[1], s8[2], s8[3]}; *(f32x4*)(hin + 4) = (f32x4){s8[4], s8[5], s8[6], s8[7]};
            if (seg == NSEG - 1) break;
            const float* pp = (const float*)(F.ws + WS_PSEG) + base + (size_t)seg * 4096 + v * 64 + 8 * kg;
            const float* sp = (const float*)(F.ws + WS_SSEG) + base + (size_t)seg * 4096 + v * 64 + 8 * kg;
            WG_BAR();
#pragma unroll
            for (int j = 0; j < 8; ++j) { Sm[v * 65 + 8 * kg + j] = s8[j]; Pm[v * 64 + 8 * kg + j] = pp[j]; }
            float o8[8];
#pragma unroll
            for (int j = 0; j < 8; ++j) o8[j] = sp[j];
            LDS_WAIT(); WG_BAR();
            for (int j = 0; j < 64; ++j) { const float sv = Sm[v * 65 + j]; const f32x4 p0 = *(const LAS f32x4*)(Pm + j * 64 + 8 * kg), p1 = *(const LAS f32x4*)(Pm + j * 64 + 8 * kg + 4);
                o8[0] += sv * p0[0]; o8[1] += sv * p0[1]; o8[2] += sv * p0[2]; o8[3] += sv * p0[3]; o8[4] += sv * p1[0]; o8[5] += sv * p1[1]; o8[6] += sv * p1[2]; o8[7] += sv * p1[3]; }
#pragma unroll
            for (int j = 0; j < 8; ++j) s8[j] = o8[j];
        }
        WG_BAR();
    }
}

DI void phase_poolv(Frame& F, int start, int stride) {
    const bf16_t* U = (const bf16_t*)(F.ws + WS_U); bf16_t* VS = (bf16_t*)(F.ws + WS_VS);
    for (int i = start; i < ML * 128; i += stride) { const int row = i >> 7, ck = i & 127; const int half = 1 << (ck >> 5);
        const int b = row / SEQ, t = row % SEQ, y = t / GW; const int ylo = y - half < 0 ? 0 : y - half, yhi = y + half > GROWS ? GROWS : y + half;
        float s[8];
#pragma unroll
        for (int j = 0; j < 8; ++j) s[j] = 0.f;
        for (int yy = ylo; yy < yhi; ++yy) { float f[8]; unpack8(*(const u32x4*)(U + (size_t)(b * SEQ + yy * GW + (t % GW)) * INWP + OFF_POOL + 8 * ck), f);
#pragma unroll
            for (int j = 0; j < 8; ++j) s[j] += f[j]; }
        *(u32x4*)(VS + (size_t)row * PWD + 8 * ck) = pack8(s); }
}
DI void phase_poolh(Frame& F, int start, int stride) {
    const bf16_t* U = (const bf16_t*)(F.ws + WS_U); const bf16_t* VS = (const bf16_t*)(F.ws + WS_VS); bf16_t* PD = (bf16_t*)(F.ws + WS_PD);
    for (int i = start; i < MR * 128; i += stride) { const int row = i >> 7, ck = i & 127; const int half = 1 << (ck >> 5);
        float s[8], f[8];
#pragma unroll
        for (int j = 0; j < 8; ++j) s[j] = 0.f;
        float cnt;
        if (row < ML) { const int t = row % SEQ, y = t / GW, x = t % GW; const int xlo = x - half < 0 ? 0 : x - half, xhi = x + half > GW ? GW : x + half;
            const int ylo = y - half < 0 ? 0 : y - half, yhi = y + half > GROWS ? GROWS : y + half;
            for (int xx = xlo; xx < xhi; ++xx) { unpack8(*(const u32x4*)(VS + (size_t)(row - x + xx) * PWD + 8 * ck), f);
#pragma unroll
                for (int j = 0; j < 8; ++j) s[j] += f[j]; }
            cnt = (float)((xhi - xlo) * (yhi - ylo));
        } else { const int t = (row - ML) % CTX; const int lo = t - half < 0 ? 0 : t - half, hi = t + half > CTX ? CTX : t + half;
            for (int tt = lo; tt < hi; ++tt) { unpack8(*(const u32x4*)(U + (size_t)(row - t + tt) * INWP + OFF_POOL + 8 * ck), f);
#pragma unroll
                for (int j = 0; j < 8; ++j) s[j] += f[j]; }
            cnt = (float)(hi - lo); }
        unpack8(*(const u32x4*)(U + (size_t)row * INWP + OFF_POOL + 8 * ck), f);
        const float ic = 1.0f / cnt;
#pragma unroll
        for (int j = 0; j < 8; ++j) s[j] = s[j] * ic - f[j];
        *(u32x4*)(PD + (size_t)row * PWD + 8 * ck) = pack8(s); }
}

DI void phase_finish(Frame& F, const CAS Inputs& IN_, int l, int nrows) {
    const bf16_t* U = (const bf16_t*)(F.ws + WS_U); const bf16_t* Gt = (const bf16_t*)(F.ws + WS_G); bf16_t* MIX = (bf16_t*)(F.ws + WS_MIX);
    const float* YF = (const float*)(F.ws + WS_YF); const float* YB = YF + (size_t)MR * RW; const float* BS0 = (const float*)(F.ws + WS_BS); const float* BS1 = BS0 + (size_t)MR * NH;
    const float* cw = IN_.conv_rkv + (size_t)l * 9 * RW + 2 * RW;
    const int gt = F.vcu * 512 + F.tid, NGT = F.G * 512;
    for (int i = gt; i < nrows * 128; i += NGT) { const int row = i >> 7, cg = i & 127, h = cg >> 3, ch = 8 * cg;
        int tau, len; if (row < ML) { tau = row % SEQ; len = SEQ; } else { tau = (row - ML) % CTX; len = CTX; }
        float y[8];
        { const f32x4 a0 = *(const f32x4*)(YF + (size_t)row * RW + ch), a1 = *(const f32x4*)(YF + (size_t)row * RW + ch + 4), b0 = *(const f32x4*)(YB + (size_t)row * RW + ch), b1 = *(const f32x4*)(YB + (size_t)row * RW + ch + 4);
#pragma unroll
          for (int e = 0; e < 4; ++e) { y[e] = a0[e] + b0[e]; y[4 + e] = a1[e] + b1[e]; } }
        float s = 0.f;
#pragma unroll
        for (int j = 0; j < 8; ++j) s += y[j];
        s += __shfl_xor(s, 1); s += __shfl_xor(s, 2); s += __shfl_xor(s, 4);
        const float mu = s * (1.f / 64.f); float vq = 0.f;
#pragma unroll
        for (int j = 0; j < 8; ++j) { y[j] -= mu; vq += y[j] * y[j]; }
        vq += __shfl_xor(vq, 1); vq += __shfl_xor(vq, 2); vq += __shfl_xor(vq, 4);
        const float rstd = frsq(vq * (1.f / 64.f) + GN_EPS);
        float cen[8], lo[8], hi[8], g8[8];
        const bf16_t* up = U + (size_t)row * INWP + OFF_V + ch;
        unpack8(*(const u32x4*)up, cen);
        if (tau > 0) unpack8(*(const u32x4*)(up - INWP), lo); else {
#pragma unroll
            for (int j = 0; j < 8; ++j) lo[j] = 0.f; }
        if (tau < len - 1) unpack8(*(const u32x4*)(up + INWP), hi); else {
#pragma unroll
            for (int j = 0; j < 8; ++j) hi[j] = 0.f; }
        unpack8(*(const u32x4*)(Gt + (size_t)row * RW + ch), g8);
        const float bsum = BS0[(size_t)row * NH + h] + BS1[(size_t)row * NH + h];
        const float* gw = IN_.gn_w + (size_t)l * RW + ch; const float* gb = IN_.gn_b + (size_t)l * RW + ch;
        float o[8];
#pragma unroll
        for (int j = 0; j < 8; ++j) { const float v = lo[j] * cw[ch + j] + cen[j] * cw[3 * RW + ch + j] + hi[j] * cw[6 * RW + ch + j];
            o[j] = (y[j] * rstd * gw[j] + gb[j] + bsum * v) * g8[j]; }
        *(u32x4*)(MIX + (size_t)row * D + ch) = pack8(o); }
}

constexpr int PH_P0 = 0, PH_P0B = 1, PH_L0 = 2, PH_PER_LAYER = 11, PH_FINAL = PH_L0 + PH_PER_LAYER * DEPTH, NPHASES = PH_FINAL + 1;
#define IN(k) (lo <= (k) && (k) < hi)
#define PHASE_BEGIN() const CAS Args* AP = kargs; OPAQUE_S(AP); do { F.ws = AP->ws; F.out = AP->out; F.wave = wave_id; OPAQUE_S(F.wave); F.lane = LANE_ID(); OPAQUE_V(F.lane); F.tid = F.wave * 64 + F.lane; } while (0)
#ifdef EMU
#define SEAM(k) do { if (IN(k) && IN((k) + 1)) xcd_barrier(bar); } while (0)
#else
#define SEAM(k) do { if (IN(k) && IN((k) + 1)) { XcdBarrier bb_ = bar; { const CAS Args* ap_ = kargs; OPAQUE_S(ap_); bb_.bar = (unsigned*)(ap_->ws + WS_CTL) + CW_BAR; } OPAQUE_S(bb_.bar); xcd_barrier(bb_); } } while (0)
#endif
template <int l> DI void run_layer(Frame F, const CAS Args* const kargs, const int lo, const int hi, const XcdBarrier bar, const int wave_id) {

        const int pb = PH_L0 + PH_PER_LAYER * l; const bool last = (l == DEPTH - 1);
        const int npm = last ? NPM_L : NPM;
        if (IN(pb + 0)) { PHASE_BEGIN(); phase_norm(F, AP->in, l, false, MR); }
        SEAM(pb + 0);
        if (IN(pb + 1)) { PHASE_BEGIN(); pg8::Gemm g{(const bf16_t*)(F.ws + WS_XN), wl_ptr(F, l, WL_WIN), D, D, D, 0}; pg8::StaticOrder S; S.init(NPM, INWP / 256, F.G, (int)blockIdx.x);
            EpiU E{(bf16_t*)(F.ws + WS_U), INWP, 1}; pg8::gemm_phase<EpiU, pg8::StaticOrder, true, true>(F.lds, g, S, E, F.tid); }
        SEAM(pb + 1);
        if (IN(pb + 2)) { PHASE_BEGIN(); ScanItem it; for (int i = F.vcu; scan_item_of(i, false, false, it); i += F.G) scan_item<false>(F, AP->in, l, it);
            phase_poolv(F, F.vcu * 512 + F.tid, F.G * 512); }
        SEAM(pb + 2);
        if (IN(pb + 3)) { PHASE_BEGIN(); phase_chain(F); phase_poolh(F, F.vcu * 512 + F.tid, F.G * 512); }
        SEAM(pb + 3);
        if (IN(pb + 4)) { PHASE_BEGIN(); ScanItem it; for (int i = F.vcu; scan_item_of(i, true, last, it); i += F.G) scan_item<true>(F, AP->in, l, it); }
        SEAM(pb + 4);
        if (IN(pb + 5)) { PHASE_BEGIN();
            { pg8::Gemm g{(const bf16_t*)(F.ws + WS_U) + OFF_G, wl_ptr(F, l, WL_GUP), INWP, GL, GL, 0}; pg8::StaticOrder S; S.init(npm, RW / 256, F.G, (int)blockIdx.x);
              EpiU E{(bf16_t*)(F.ws + WS_G), RW, 0}; pg8::gemm_phase<EpiU, pg8::StaticOrder, true, true>(F.lds, g, S, E, F.tid); }
            { pg8::Gemm g{(const bf16_t*)(F.ws + WS_PD), wl_ptr(F, l, WL_POOL), PWD, PG, PG, 256}; pg8::StaticOrder S; S.init(npm, 4, F.G, (int)blockIdx.x);
              EpiPool E{(bf16_t*)(F.ws + WS_MIX), AP->in.pool_scale + (size_t)l * PWD}; pg8::gemm_phase<EpiPool, pg8::StaticOrder, true, true>(F.lds, g, S, E, F.tid); }
        }
        SEAM(pb + 5);
        if (IN(pb + 6)) { PHASE_BEGIN(); phase_finish(F, AP->in, l, npm * 256); }
        SEAM(pb + 6);
        if (IN(pb + 7)) { PHASE_BEGIN(); pg8::Gemm g{(const bf16_t*)(F.ws + WS_MIX), wl_ptr(F, l, WL_WOUT), D, D, D, 0}; pg8::StaticOrder S; S.init(npm, D / 256, F.G, (int)blockIdx.x);
            const float* bl = l == 0 ? AP->in.x : (const float*)F.out; const float* bc = l == 0 ? AP->in.ctx : (const float*)(F.ws + WS_CTXH);
            EpiRes E{bl, F.out, (long long)((const char*)bc - (const char*)bl), (long long)((const char*)(F.ws + WS_CTXH) - (const char*)F.out), mod_ptr(F, l, 0, 2)};
            pg8::gemm_phase<EpiRes, pg8::StaticOrder, true, true>(F.lds, g, S, E, F.tid); }
        SEAM(pb + 7);
        if (IN(pb + 8)) { PHASE_BEGIN(); phase_norm(F, AP->in, l, true, npm * 256); }
        SEAM(pb + 8);
        if (IN(pb + 9)) { PHASE_BEGIN(); pg8::Gemm g{(const bf16_t*)(F.ws + WS_XN), wl_ptr(F, l, WL_WGU), D, D, D, 0}; pg8::StaticOrder S; S.init(npm, 2 * DFF / 256, F.G, (int)blockIdx.x);
            EpiSwiglu E{(bf16_t*)(F.ws + WS_H)}; pg8::gemm_phase<EpiSwiglu, pg8::StaticOrder, true, true>(F.lds, g, S, E, F.tid); }
        SEAM(pb + 9);
        if (IN(pb + 10)) { PHASE_BEGIN(); pg8::Gemm g{(const bf16_t*)(F.ws + WS_H), wl_ptr(F, l, WL_WDN), DFF, DFF, DFF, 0}; pg8::StaticOrder S; S.init(npm, D / 256, F.G, (int)blockIdx.x);
            const long long dc = (long long)((const char*)(F.ws + WS_CTXH) - (const char*)F.out);
            EpiRes E{F.out, F.out, dc, dc, mod_ptr(F, l, 0, 5)};
            pg8::gemm_phase<EpiRes, pg8::StaticOrder, true, true>(F.lds, g, S, E, F.tid); }
        SEAM(pb + 10);
    }
__global__ void __launch_bounds__(512, 2) fwd_kernel(Args args) {
#ifdef EMU
    unsigned char* lds = emu_blk->lds;
#else
    extern __shared__ __attribute__((aligned(16))) unsigned char lds[];
#endif
    Frame F;
    F.lds = (LAS unsigned char*)lds;
    F.tid = threadIdx.x; F.lane = F.tid & 63; F.wave = RFL(F.tid >> 6);
    const int wave_id = F.wave;
    F.G = gridDim.x; { const int bx = blockIdx.x; F.vcu = (F.G % 8 == 0) ? (bx % 8) * (F.G / 8) + bx / 8 : bx; }
#ifdef EMU
    const Args* const kargs = &args;
#else
    const CAS Args* const kargs = (const CAS Args*)__builtin_amdgcn_kernarg_segment_ptr();
#endif
    F.out = kargs->out; F.ws = kargs->ws;
    const int lo = args.ph_lo, hi = args.ph_hi;
#ifndef EMU
    volatile LAS unsigned* MISC = (volatile LAS unsigned*)(F.lds + MISC_OFF);
    if (F.tid < 64) MISC[F.tid] = 0u;
    __syncthreads();
    XcdBarrier bar; bar.bar = (unsigned*)(F.ws + WS_CTL) + CW_BAR; bar.x = 0; bar.st = nullptr;
    if (hi - lo > 1) bar = xcd_barrier_post((unsigned*)(F.ws + WS_CTL) + CW_BAR, MISC + 8);
#else
    XcdBarrier bar; bar.bar = nullptr;
#endif
    if (IN(PH_P0)) { PHASE_BEGIN(); phase_p0(F, AP->in); }
    SEAM(PH_P0);
    if (IN(PH_P0B)) { PHASE_BEGIN(); phase_p0b(F, AP->in); }
    SEAM(PH_P0B);
    run_layer<0>(F, kargs, lo, hi, bar, wave_id);
    if constexpr (DEPTH > 1) run_layer<1>(F, kargs, lo, hi, bar, wave_id);
    if constexpr (DEPTH > 2) run_layer<2>(F, kargs, lo, hi, bar, wave_id);
    if constexpr (DEPTH > 3) run_layer<3>(F, kargs, lo, hi, bar, wave_id);
    static_assert(DEPTH <= 4, "layers");
    if (IN(PH_FINAL)) { PHASE_BEGIN(); phase_final_norm(F, AP->in); }
#undef IN
#undef SEAM
}

extern "C" void kernel_launch(void* const* d_in, const int* in_sizes, int n_in, void* d_out, int out_size, void* d_ws, size_t ws_size, hipStream_t stream) {
    static int grid = 0;
    if (grid == 0) {
        if (n_in != 27 || in_sizes[0] != ML * D || out_size != ML * D || ws_size < WS_END) {
            fprintf(stderr, "kernel_launch: shape/workspace mismatch: n_in %d in0 %d out %d ws %zu (need %zu)\n", n_in, n_in > 0 ? in_sizes[0] : -1, out_size, ws_size, (size_t)WS_END); grid = -1; return; }
        int dev = 0, cus = 0, per_cu = 0;
        if (hipGetDevice(&dev) != hipSuccess || hipDeviceGetAttribute(&cus, hipDeviceAttributeMultiprocessorCount, dev) != hipSuccess) { grid = -1; return; }
        if (hipFuncSetAttribute((const void*)fwd_kernel, hipFuncAttributeMaxDynamicSharedMemorySize, LDS_BYTES) != hipSuccess) { fprintf(stderr, "kernel_launch: hipFuncSetAttribute failed\n"); grid = -1; return; }
        if (hipOccupancyMaxActiveBlocksPerMultiprocessor(&per_cu, (const void*)fwd_kernel, 512, LDS_BYTES) != hipSuccess || per_cu < 1) fprintf(stderr, "kernel_launch: occupancy query reports %d\n", per_cu);
        (void)hipGetLastError();
        grid = cus;
    }
    if (grid < 0) return;
    (void)hipMemsetAsync((char*)d_ws + WS_CTL, 0, CTL_BYTES, stream);
    Args a{};
    const float** ip = (const float**)&a.in;
    for (int i = 0; i < 27; ++i) ip[i] = (const float*)d_in[i];
    a.out = (float*)d_out; a.ws = (unsigned char*)d_ws;
#if MK_ONE_LAUNCH
    a.ph_lo = 0; a.ph_hi = NPHASES;
    hipLaunchKernelGGL(fwd_kernel, dim3(grid), dim3(512), LDS_BYTES, stream, a);
#else
    for (int ph = 0; ph < NPHASES; ++ph) {
#ifdef EMU
        extern int emu_stop_phase; if (emu_stop_phase >= 0 && ph >= emu_stop_phase) break; fprintf(stderr, "phase %d\n", ph);
#endif
        a.ph_lo = ph; a.ph_hi = ph + 1; hipLaunchKernelGGL(fwd_kernel, dim3(grid), dim3(512), LDS_BYTES, stream, a); }
#endif
}
```

```cpp
#ifndef EMU
#include <hip/hip_runtime.h>
#endif
#include <cstdio>
#include <cstdint>
#include <cstddef>

#ifndef CFG_SEQ
#define CFG_SEQ 16384
#endif
#ifndef CFG_CTX
#define CFG_CTX 256
#endif
#ifndef CFG_DEPTH
#define CFG_DEPTH 4
#endif
#ifndef CFG_SEGLEN
#define CFG_SEGLEN 1024
#endif
#ifndef MK_ONE_LAUNCH
#define MK_ONE_LAUNCH 1
#endif
constexpr int D = 2048, NB = 2, SEQ = CFG_SEQ, DEPTH = CFG_DEPTH, CTX = CFG_CTX, GW = 64, HS = 64, RW = 1024, NH = 16, PWD = 1024;
constexpr int PG = 256, LORA = 96, GL = 256, DFF = 5632;
constexpr int OFF_R = 0, OFF_K = 1024, OFF_V = 2048, OFF_W = 3072, OFF_A = 3168, OFF_G = 3264, OFF_POOL = 3520, INW = 4544, INWP = 4608;
constexpr int ML = NB * SEQ, MC = NB * CTX, MR = ML + MC;
constexpr int SEGLEN = CFG_SEGLEN, NSEGL = SEQ / SEGLEN, NSEG = NSEGL + 1;
constexpr int GROWS = SEQ / GW;
constexpr float RMS_EPS = 1e-6f, GN_EPS = 64e-5f;
static_assert(ML % 256 == 0 && MR % 256 == 0 && SEQ % 256 == 0 && SEGLEN % 64 == 0 && CTX % 64 == 0 && SEQ % SEGLEN == 0, "shape");
constexpr int NPM = MR / 256, NPM_L = ML / 256;

typedef unsigned short bf16_t;
typedef short bf16x8 __attribute__((ext_vector_type(8)));
typedef float f32x4 __attribute__((ext_vector_type(4)));
typedef float f32x2 __attribute__((ext_vector_type(2)));
typedef unsigned u32x4 __attribute__((ext_vector_type(4)));
typedef unsigned u32x2 __attribute__((ext_vector_type(2)));
#define DI __device__ __forceinline__
#ifdef EMU
#define LAS
#define GAS
#define CAS
#define MFMA16(a, b, c) emu_mfma16((a), (b), (c))
#define RFL(x) (x)
#define LDS_WAIT() emu_wave_sync()
#define VM_WAIT() do {} while (0)
#define WG_BAR() __syncthreads()
#define CFENCE() do {} while (0)
#define OPAQUE_S(x) do {} while (0)
#define OPAQUE_V(x) do {} while (0)
#define LANE_ID() ((int)(threadIdx.x & 63))
static inline float fexp(float x) { return expf(x); }
static inline float frcp(float x) { return 1.0f / x; }
static inline float frsq(float x) { return 1.0f / sqrtf(x); }
#else
#define LAS __attribute__((address_space(3)))
#define GAS __attribute__((address_space(1)))
#define CAS __attribute__((address_space(4)))
#define MFMA16(a, b, c) __builtin_amdgcn_mfma_f32_16x16x32_bf16((a), (b), (c), 0, 0, 0)
#define RFL(x) __builtin_amdgcn_readfirstlane(x)
#define LDS_WAIT() asm volatile("s_waitcnt lgkmcnt(0)" ::: "memory")
#define VM_WAIT() asm volatile("s_waitcnt vmcnt(0)" ::: "memory")
#define WG_BAR() __syncthreads()
#define CFENCE() asm volatile("" ::: "memory")
#define OPAQUE_S(x) asm volatile("" : "+s"(x))
#define OPAQUE_V(x) asm volatile("" : "+v"(x))
DI int lane_id_volatile() { int l; asm volatile("v_mbcnt_lo_u32_b32 %0, -1, 0\n\tv_mbcnt_hi_u32_b32 %0, -1, %0" : "=v"(l)); return l; }
#define LANE_ID() lane_id_volatile()
DI float fexp(float x) { return __expf(x); }
DI float frcp(float x) { return __builtin_amdgcn_rcpf(x); }
DI float frsq(float x) { return __builtin_amdgcn_rsqf(x); }
#endif
DI unsigned f2bf(float f) { unsigned u = __builtin_bit_cast(unsigned, f); return (u + 0x7fffu + ((u >> 16) & 1u)) >> 16; }
DI unsigned pk2(float lo, float hi) { return f2bf(lo) | (f2bf(hi) << 16); }
DI float bf2f(unsigned h) { return __builtin_bit_cast(float, h << 16); }
DI float bflo(unsigned w) { return __builtin_bit_cast(float, w << 16); }
DI float bfhi(unsigned w) { return __builtin_bit_cast(float, w & 0xffff0000u); }
DI float fsigmoid(float x) { return frcp(1.0f + fexp(-x)); }
DI float ftanh(float x) { return 1.0f - 2.0f * frcp(fexp(2.0f * x) + 1.0f); }
DI float fsilu(float x) { return x * fsigmoid(x); }
DI void unpack8(const u32x4& w, float (&f)[8]) { f[0] = bflo(w.x); f[1] = bfhi(w.x); f[2] = bflo(w.y); f[3] = bfhi(w.y); f[4] = bflo(w.z); f[5] = bfhi(w.z); f[6] = bflo(w.w); f[7] = bfhi(w.w); }
DI u32x4 pack8(const float (&f)[8]) { u32x4 w; w.x = pk2(f[0], f[1]); w.y = pk2(f[2], f[3]); w.z = pk2(f[4], f[5]); w.w = pk2(f[6], f[7]); return w; }
DI void unpack4(const u32x2& w, float (&f)[4]) { f[0] = bflo(w.x); f[1] = bfhi(w.x); f[2] = bflo(w.y); f[3] = bfhi(w.y); }
DI u32x2 pack4(const float (&f)[4]) { u32x2 w; w.x = pk2(f[0], f[1]); w.y = pk2(f[2], f[3]); return w; }
DI float wave_sum(float v) {
#pragma unroll
    for (int o = 1; o < 64; o <<= 1) v += __shfl_xor(v, o);
    return v;
}

namespace pg8 {
constexpr int BM = 256, BK = 64, HALF = 128, HTB = HALF * BK * 2, STAGE_BYTES = 8 * HTB, NXCD = 8, WGM = 8;
__host__ __device__ __forceinline__ int lds_byte(int r, int c) { const int st = (r >> 4) * 2 + (c >> 5), rr = r & 15, cc = c & 31, ob = rr * 64 + cc * 2; return st * 1024 + (ob ^ (((ob >> 9) & 1) << 5)); }
__host__ __device__ __forceinline__ void stage_rc(int b, int& R, int& C) { const int st = b / 1024, sb = b % 1024, swz = sb ^ (((sb >> 9) & 1) << 5); R = (st >> 1) * 16 + swz / 64; C = (st & 1) * 32 + (swz % 64) / 2; }
__host__ __device__ __forceinline__ int perm32(int rho) { const int n = rho >> 4, i = rho & 15; return 8 * (i >> 2) + 4 * n + (i & 3); }
struct Unit { int pm, pn; };
struct Gemm { const bf16_t* A; const bf16_t* Bt; int lda, ldb, K, a_col_pn; };
struct StaticOrder {
    int nM, nN, nwg, G, c;
    __host__ __device__ void init(int nM_, int nN_, int G_, int c_) { nM = nM_; nN = nN_; nwg = nM * nN; G = G_; c = c_; }
    __host__ __device__ bool next(int i, Unit& u) const {
        const long L = (long)i * G + c; if (L >= nwg) return false;
        int wgid = (int)L; { const int q = nwg / NXCD, r = nwg % NXCD, xcd = wgid % NXCD, off = wgid / NXCD; wgid = (xcd < r ? xcd * (q + 1) : r * (q + 1) + (xcd - r) * q) + off; }
        const int nig = WGM * nN, gid = wgid / nig, fm = gid * WGM, gsz = (nM - fm) < WGM ? (nM - fm) : WGM;
        u.pm = fm + ((wgid % nig) % gsz); u.pn = (wgid % nig) / gsz; return true;
    }
};
#ifndef EMU
#define PG8_LAS __attribute__((address_space(3)))
template <class Epi, class Sched, bool ALIGN_EPI = false, bool SP2 = false>
__device__ __forceinline__ void gemm_phase(PG8_LAS unsigned char* lds, const Gemm g, const Sched& S, const Epi& E, const int tid_) {
    const int tid = tid_, wid = __builtin_amdgcn_readfirstlane(tid >> 6), lane = tid & 63, wr = wid >> 2, wc = wid & 3, fr = lane & 15, fq = lane >> 4;
    const int K = g.K, nt = K / BK;
    unsigned voffA[2], voffB[2];
#pragma unroll
    for (int i = 0; i < 2; ++i) { int R, C; stage_rc(tid * 16 + i * 8192, R, C); const int Rb = Epi::PERM ? ((R & ~31) + perm32(R & 31)) : R;
        voffA[i] = (unsigned)(R * g.lda + C) * 2u; voffB[i] = (unsigned)(Rb * g.ldb + C) * 2u; }
    const size_t kstep = (size_t)(BK * 2);
    const size_t hstepA = (size_t)HALF * g.lda * 2, hstepB = (size_t)HALF * g.ldb * 2;
    const unsigned ldsw = (unsigned)wid * 1024u;
    const int aoff = lds_byte(wr * 64 + fr, fq * 8), boff = lds_byte(wc * 32 + fr, fq * 8);
#define PG8_SA(b, h) (((b) * 2 + (h)) * HTB)
#define PG8_SB(b, h) ((4 + (b) * 2 + (h)) * HTB)
#define PG8_STAGE(bufoff, gbase, voff) do { _Pragma("unroll") for (int _i = 0; _i < 2; ++_i) \
        __builtin_amdgcn_global_load_lds((const unsigned*)((const char*)(gbase) + (voff)[_i]), (PG8_LAS unsigned*)(lds + (bufoff) + ldsw + _i * 8192), 16, 0, 0); } while (0)
#define PG8_LDA(dst, b, h) do { _Pragma("unroll") for (int m = 0; m < 4; ++m) _Pragma("unroll") for (int k = 0; k < 2; ++k) dst[m][k] = *(const PG8_LAS bf16x8*)(lds + PG8_SA(b, h) + aoff + m * 2048 + k * 1024); } while (0)
#define PG8_LDB(dst, b, h) do { _Pragma("unroll") for (int n = 0; n < 2; ++n) _Pragma("unroll") for (int k = 0; k < 2; ++k) dst[n][k] = *(const PG8_LAS bf16x8*)(lds + PG8_SB(b, h) + boff + n * 2048 + k * 1024); } while (0)
#define PG8_MMA(ai, bj, At, Bt) do { __builtin_amdgcn_s_setprio(1); _Pragma("unroll") for (int m = 0; m < 4; ++m) _Pragma("unroll") for (int n = 0; n < 2; ++n) _Pragma("unroll") for (int k = 0; k < 2; ++k) \
        acc[ai][bj][m][n] = __builtin_amdgcn_mfma_f32_16x16x32_bf16(Bt[n][k], At[m][k], acc[ai][bj][m][n], 0, 0, 0); __builtin_amdgcn_s_setprio(0); } while (0)
#define PG8_WAIT_V(n) asm volatile("s_waitcnt vmcnt(" #n ")" ::: "memory")
#define PG8_WAIT_L(n) asm volatile("s_waitcnt lgkmcnt(" #n ")" ::: "memory")
#define PG8_BAR __builtin_amdgcn_s_barrier()
#define PG8_SCHED __builtin_amdgcn_sched_barrier(0)
#define PG8_APTR(u) ((const char*)g.A + ((size_t)(u).pm * BM * g.lda + (size_t)(u).pn * g.a_col_pn) * 2)
#define PG8_BPTR(u) ((const char*)g.Bt + (size_t)(u).pn * BM * g.ldb * 2)
    Unit cur, nxt; int ui = 0;
    if (!S.next(0, cur)) return;
    f32x4 acc[2][2][4][2];
#pragma unroll
    for (int a = 0; a < 2; ++a)
#pragma unroll
        for (int b = 0; b < 2; ++b)
#pragma unroll
            for (int m = 0; m < 4; ++m)
#pragma unroll
                for (int n = 0; n < 2; ++n) acc[a][b][m][n] = (f32x4){0.f, 0.f, 0.f, 0.f};
    bf16x8 At[4][2], B0[2][2], B1[2][2];
    const char* cA = PG8_APTR(cur); const char* cB = PG8_BPTR(cur);
    if constexpr (SP2) {
        PG8_STAGE(PG8_SB(0, 0), cB, voffB); PG8_STAGE(PG8_SB(0, 1), cB + hstepB, voffB); PG8_STAGE(PG8_SA(0, 0), cA, voffA); PG8_STAGE(PG8_SA(0, 1), cA + hstepA, voffA);
        if (wr == 1) PG8_BAR;
        PG8_WAIT_V(2); PG8_BAR;
        PG8_STAGE(PG8_SB(1, 0), cB + kstep, voffB); PG8_STAGE(PG8_SA(1, 0), cA + kstep, voffA); PG8_STAGE(PG8_SB(1, 1), cB + hstepB + kstep, voffB);
        PG8_WAIT_V(6); PG8_BAR;
    } else {
        PG8_STAGE(PG8_SB(0, 0), cB, voffB); PG8_STAGE(PG8_SA(0, 0), cA, voffA); PG8_STAGE(PG8_SB(0, 1), cB + hstepB, voffB); PG8_STAGE(PG8_SA(0, 1), cA + hstepA, voffA);
        if (wr == 1) PG8_BAR;
        PG8_WAIT_V(4); PG8_BAR;
        PG8_STAGE(PG8_SB(1, 0), cB + kstep, voffB); PG8_STAGE(PG8_SA(1, 0), cA + kstep, voffA); PG8_STAGE(PG8_SB(1, 1), cB + hstepB + kstep, voffB);
        PG8_WAIT_V(6); PG8_BAR;
    }
    for (;;) {
        const bool has_next = S.next(ui + 1, nxt);
        const char* nA = has_next ? PG8_APTR(nxt) : cA; const char* nB = has_next ? PG8_BPTR(nxt) : cB;
#pragma unroll 1
        for (int t = 0; t < nt; t += 2) {
            const bool last = (t == nt - 2);
            const char* a1 = cA + (size_t)(t + 1) * kstep;
            const char* a2 = last ? nA : cA + (size_t)(t + 2) * kstep; const char* b2 = last ? nB : cB + (size_t)(t + 2) * kstep;
            const char* a3 = a2 + kstep; const char* b3 = b2 + kstep;
            if constexpr (SP2) {
            PG8_LDB(B0, 0, 0); PG8_LDB(B1, 0, 1); PG8_SCHED; PG8_LDA(At, 0, 0); PG8_STAGE(PG8_SA(1, 1), a1 + hstepA, voffA);
            PG8_WAIT_V(8); PG8_WAIT_L(0); PG8_BAR; PG8_MMA(0, 0, At, B0); PG8_MMA(0, 1, At, B1); PG8_BAR; PG8_SCHED;
            PG8_LDA(At, 0, 1); PG8_STAGE(PG8_SB(0, 0), b2, voffB); PG8_STAGE(PG8_SB(0, 1), b2 + hstepB, voffB); PG8_STAGE(PG8_SA(0, 0), a2, voffA);
            PG8_WAIT_V(8); PG8_WAIT_L(0); PG8_BAR; PG8_MMA(1, 0, At, B0); PG8_MMA(1, 1, At, B1); PG8_BAR; PG8_SCHED;
            PG8_LDB(B0, 1, 0); PG8_LDB(B1, 1, 1); PG8_SCHED; PG8_LDA(At, 1, 0); PG8_STAGE(PG8_SA(0, 1), a2 + hstepA, voffA);
            PG8_WAIT_V(8); PG8_WAIT_L(0); PG8_BAR; PG8_MMA(0, 0, At, B0); PG8_MMA(0, 1, At, B1); PG8_BAR; PG8_SCHED;
            PG8_LDA(At, 1, 1); PG8_STAGE(PG8_SB(1, 0), b3, voffB); PG8_STAGE(PG8_SB(1, 1), b3 + hstepB, voffB); PG8_STAGE(PG8_SA(1, 0), a3, voffA);
            PG8_WAIT_V(8); PG8_WAIT_L(0); PG8_BAR; PG8_MMA(1, 0, At, B0); PG8_MMA(1, 1, At, B1); PG8_BAR; PG8_SCHED;
            } else {
            PG8_LDB(B0, 0, 0); PG8_SCHED; PG8_LDA(At, 0, 0); PG8_STAGE(PG8_SA(1, 1), a1 + hstepA, voffA);
            PG8_WAIT_L(8); PG8_BAR; PG8_WAIT_L(0); PG8_MMA(0, 0, At, B0); PG8_BAR; PG8_SCHED;
            PG8_LDB(B1, 0, 1); PG8_STAGE(PG8_SB(0, 0), b2, voffB);
            PG8_BAR; PG8_WAIT_L(0); PG8_MMA(0, 1, At, B1); PG8_BAR;
            PG8_LDA(At, 0, 1); PG8_STAGE(PG8_SA(0, 0), a2, voffA);
            PG8_BAR; PG8_WAIT_L(0); PG8_MMA(1, 0, At, B0); PG8_BAR; PG8_SCHED;
            PG8_STAGE(PG8_SB(0, 1), b2 + hstepB, voffB);
            PG8_WAIT_V(6); PG8_BAR; PG8_MMA(1, 1, At, B1); PG8_BAR;
            PG8_LDB(B0, 1, 0); PG8_SCHED; PG8_LDA(At, 1, 0); PG8_STAGE(PG8_SA(0, 1), a2 + hstepA, voffA);
            PG8_WAIT_L(8); PG8_BAR; PG8_WAIT_L(0); PG8_MMA(0, 0, At, B0); PG8_BAR; PG8_SCHED;
            PG8_LDB(B1, 1, 1); PG8_STAGE(PG8_SB(1, 0), b3, voffB);
            PG8_BAR; PG8_WAIT_L(0); PG8_MMA(0, 1, At, B1); PG8_BAR;
            PG8_LDA(At, 1, 1); PG8_STAGE(PG8_SA(1, 0), a3, voffA);
            PG8_BAR; PG8_WAIT_L(0); PG8_MMA(1, 0, At, B0); PG8_BAR; PG8_SCHED;
            PG8_STAGE(PG8_SB(1, 1), b3 + hstepB, voffB);
            PG8_WAIT_V(6); PG8_BAR; PG8_MMA(1, 1, At, B1); PG8_BAR;
            }
        }
        if constexpr (ALIGN_EPI) { if (wr == 0) PG8_BAR; }
        E(acc, cur, wr, wc, fr, fq);
        if (!has_next) break;
#pragma unroll
        for (int a = 0; a < 2; ++a)
#pragma unroll
            for (int b = 0; b < 2; ++b)
#pragma unroll
                for (int m = 0; m < 4; ++m)
#pragma unroll
                    for (int n = 0; n < 2; ++n) acc[a][b][m][n] = (f32x4){0.f, 0.f, 0.f, 0.f};
        cur = nxt; cA = nA; cB = nB; ++ui;
        if constexpr (ALIGN_EPI) { if (wr == 1) PG8_BAR; }
    }
    PG8_WAIT_V(0);
    if constexpr (!ALIGN_EPI) { if (wr == 0) PG8_BAR; }
    PG8_BAR;
#undef PG8_SA
#undef PG8_SB
#undef PG8_STAGE
#undef PG8_LDA
#undef PG8_LDB
#undef PG8_MMA
#undef PG8_WAIT_V
#undef PG8_WAIT_L
#undef PG8_BAR
#undef PG8_SCHED
#undef PG8_APTR
#undef PG8_BPTR
}
#else
static thread_local float* emu_tile = nullptr;
template <class Epi, class Sched, bool ALIGN_EPI = false, bool SP2 = false>
static void gemm_phase(unsigned char* lds, const Gemm g, const Sched& S, const Epi& E, const int tid_) {
    const int tid = tid_, wid = tid >> 6, lane = tid & 63, wr = wid >> 2, wc = wid & 3, fr = lane & 15, fq = lane >> 4;
    if (!emu_tile) emu_tile = (float*)malloc(256 * 256 * 4);
    Unit u;
    for (int i = 0; S.next(i, u); ++i) {
        const bf16_t* A = g.A + (size_t)u.pm * BM * g.lda + (size_t)u.pn * g.a_col_pn; const bf16_t* Bt = g.Bt + (size_t)u.pn * BM * g.ldb;
        { const int r = tid >> 1, c0 = (tid & 1) * 128; std::vector<float> ar(g.K); for (int k = 0; k < g.K; ++k) ar[k] = bf2f(A[(size_t)r * g.lda + k]);
          for (int c = c0; c < c0 + 128; ++c) { const bf16_t* br = Bt + (size_t)c * g.ldb; float s0 = 0, s1 = 0, s2 = 0, s3 = 0; for (int k = 0; k < g.K; k += 4) { s0 += ar[k] * bf2f(br[k]); s1 += ar[k + 1] * bf2f(br[k + 1]); s2 += ar[k + 2] * bf2f(br[k + 2]); s3 += ar[k + 3] * bf2f(br[k + 3]); } emu_tile[r * 256 + c] = (s0 + s1) + (s2 + s3); } }
        __syncthreads();
        f32x4 acc[2][2][4][2];
        for (int ai = 0; ai < 2; ++ai) for (int bj = 0; bj < 2; ++bj) for (int m = 0; m < 4; ++m) for (int n = 0; n < 2; ++n) for (int e = 0; e < 4; ++e) {
            const int r = 128 * ai + 64 * wr + 16 * m + fr; const int c = Epi::PERM ? (128 * bj + 32 * wc + 8 * fq + 4 * n + e) : (128 * bj + 32 * wc + 16 * n + 4 * fq + e);
            acc[ai][bj][m][n][e] = emu_tile[r * 256 + c]; }
        E(acc, u, wr, wc, fr, fq);
        __syncthreads();
    }
}
#endif
}

constexpr size_t al256(size_t x) { return (x + 255) & ~(size_t)255; }
constexpr size_t WS_CTL = 0, CTL_BYTES = 1u << 20;
constexpr size_t WS_MOD = WS_CTL + CTL_BYTES;
constexpr size_t SZ_MOD = al256((size_t)DEPTH * 3 * 6 * D * 4);
constexpr int ADA_KC = 16;
constexpr size_t WS_ADAP = WS_MOD + SZ_MOD;
constexpr size_t SZ_ADAP = al256((size_t)DEPTH * ADA_KC * 3 * 6 * D * 4);
constexpr size_t WL_WIN = 0, WL_WOUT = WL_WIN + (size_t)INWP * D * 2, WL_WGU = WL_WOUT + (size_t)D * D * 2, WL_WDN = WL_WGU + (size_t)2 * DFF * D * 2,
                 WL_GUP = WL_WDN + (size_t)D * DFF * 2, WL_POOL = WL_GUP + (size_t)RW * GL * 2, WL_DUP = WL_POOL + (size_t)4 * PG * PG * 2,
                 WL_IUP = WL_DUP + (size_t)2 * RW * LORA * 2, WL_SIZE = al256(WL_IUP + (size_t)2 * RW * LORA * 2);
constexpr size_t WS_W = WS_ADAP + SZ_ADAP;
constexpr size_t WS_XN = WS_W + WL_SIZE * DEPTH;
constexpr size_t WS_MIX = WS_XN + (size_t)MR * D * 2;
constexpr size_t WS_CTXH = WS_MIX + (size_t)MR * D * 2;
constexpr size_t WS_SSEG = WS_CTXH + (size_t)MC * D * 4;
constexpr size_t SZ_ST = (size_t)NB * NH * 2 * NSEG * 4096 * 4;
constexpr size_t WS_PSEG = WS_SSEG + SZ_ST, WS_HIN = WS_PSEG + SZ_ST;
constexpr size_t WS_BS = WS_HIN + SZ_ST;
constexpr size_t WS_BIG = al256(WS_BS + (size_t)2 * MR * NH * 4);
constexpr size_t WS_U = WS_BIG;
constexpr size_t WS_YF = WS_U + (size_t)MR * INWP * 2;
constexpr size_t WS_G = WS_YF + (size_t)2 * MR * RW * 4;
constexpr size_t WS_PD = WS_G + (size_t)MR * RW * 2;
constexpr size_t WS_VS = WS_PD + (size_t)MR * PWD * 2;
constexpr size_t WS_BIG_END1 = WS_VS + (size_t)ML * PWD * 2;
constexpr size_t WS_H = WS_BIG;
constexpr size_t WS_BIG_END2 = WS_H + (size_t)MR * DFF * 2;
constexpr size_t WS_END = WS_BIG_END1 > WS_BIG_END2 ? WS_BIG_END1 : WS_BIG_END2;
constexpr int CW_BAR = 4096;

constexpr int IMG = 8192;
constexpr int M_RT = 0, M_AT = 1, M_KB = 2, M_BB = 3, M_KT = 4, M_BT = 5, M_VT = 6, M_AAK = 7, M_ARK = 8, M_ARB = 9, M_TM = 10, M_H0 = 11, M_H1 = 12, M_T0 = 13;
constexpr int SC_DIAG = 18 * IMG;
constexpr int SC_GC = SC_DIAG + 4096;
constexpr int MISC_OFF = SC_GC + 256;
constexpr int LDS_BYTES = MISC_OFF + 256;
constexpr int SCR_G = M_T0 * IMG, SCR_AI = SCR_G + 64 * 68 * 4;
static_assert(SCR_AI + 64 * 68 * 4 <= 18 * IMG, "scratch overlay");
static_assert(LDS_BYTES <= 160 * 1024 && pg8::STAGE_BYTES <= MISC_OFF, "LDS");

#define XB_TMO      128
#define XB_XCNT(j)  (256  + 64 * (j))
#define XB_XSUB(j)  (1280 + 64 * (j))
#define XB_XGEN(j)  (2304 + 64 * (j))
#define XB_TOP      3328
#define XB_TOPGEN   3392
#define XCD_BAR_WORDS 3456
#define XB_SPIN_CAP (1u << 18)
#ifndef EMU
__device__ __forceinline__ unsigned xb_ld(unsigned* p)              { return __hip_atomic_load(p, __ATOMIC_RELAXED, __HIP_MEMORY_SCOPE_AGENT); }
__device__ __forceinline__ unsigned xb_add(unsigned* p, unsigned v) { return __hip_atomic_fetch_add(p, v, __ATOMIC_RELAXED, __HIP_MEMORY_SCOPE_AGENT); }
__device__ __forceinline__ unsigned xb_xcc_id() { return (unsigned)__builtin_amdgcn_s_getreg((3 << 11) | 20) & 0xFu; }
#define XB_SPIN(cond, bar) do { unsigned _sp = 0; while (cond) { __builtin_amdgcn_s_sleep(1); \
    if ((++_sp & 255u) == 0u) { if (xb_ld(&(bar)[XB_TMO])) break; if (_sp > XB_SPIN_CAP) { atomicAdd(&(bar)[XB_TMO], 1u); break; } } } } while (0)
struct XcdBarrier { unsigned* bar; unsigned x; volatile LAS unsigned* st; };
__device__ __forceinline__ XcdBarrier xcd_barrier_post(unsigned* bar, volatile LAS unsigned* st) {
    XcdBarrier b; b.bar = bar; b.x = xb_xcc_id(); b.st = st;
    if (threadIdx.x == 0) (void)xb_add(&bar[XB_XCNT(b.x)], 1u);
    return b;
}
__device__ __forceinline__ void xcd_barrier_complete(unsigned* bar, unsigned x, unsigned& nloc, unsigned& nx) {
    const unsigned G = gridDim.x * gridDim.y * gridDim.z;
    unsigned sum, cnt, mine, sp = 0u;
    for (;;) {
        sum = 0u; cnt = 0u; mine = 0u;
#pragma unroll
        for (unsigned j = 0; j < 16; ++j) { const unsigned c = xb_ld(&bar[XB_XCNT(j)]); sum += c; cnt += (c > 0u) ? 1u : 0u; mine = (j == x) ? c : mine; }
        if (sum == G) break;
        __builtin_amdgcn_s_sleep(1);
        if ((++sp & 255u) == 0u) { if (xb_ld(&bar[XB_TMO])) break; if (sp > XB_SPIN_CAP) { atomicAdd(&bar[XB_TMO], 1u); break; } }
    }
    nloc = mine > 0u ? mine : 1u; nx = cnt > 0u ? cnt : 1u;
}
__device__ __forceinline__ void xcd_barrier(const XcdBarrier& b) {
    asm volatile("s_waitcnt vmcnt(0)" ::: "memory");
    __syncthreads();
    if (threadIdx.x == 0) {
        unsigned* bar = b.bar;
        __builtin_amdgcn_s_waitcnt(0);
        unsigned nloc = b.st[0], nx = b.st[1];
        if (nloc == 0u) { xcd_barrier_complete(bar, b.x, nloc, nx); b.st[0] = nloc; b.st[1] = nx; }
        const unsigned old = xb_add(&bar[XB_XSUB(b.x)], 1u);
        const unsigned gen = old / nloc;
        if (old + 1u == (gen + 1u) * nloc) {
            __builtin_amdgcn_fence(__ATOMIC_RELEASE, "agent");
            asm volatile("s_waitcnt vmcnt(0)" ::: "memory");
            const unsigned og = xb_add(&bar[XB_TOP], 1u);
            const unsigned tg = og / nx;
            if (og + 1u == (tg + 1u) * nx) xb_add(&bar[XB_TOPGEN], 1u);
            else XB_SPIN(xb_ld(&bar[XB_TOPGEN]) == tg, bar);
            __builtin_amdgcn_fence(__ATOMIC_ACQUIRE, "agent");
            xb_add(&bar[XB_XGEN(b.x)], 1u);
            asm volatile("s_waitcnt vmcnt(0)" ::: "memory");
        } else {
            XB_SPIN(xb_ld(&bar[XB_XGEN(b.x)]) == gen, bar);
            __builtin_amdgcn_fence(__ATOMIC_ACQUIRE, "agent");
            asm volatile("s_waitcnt vmcnt(0)" ::: "memory");
        }
    }
    __syncthreads();
}
#else
struct XcdBarrier { unsigned* bar; };
static inline void xcd_barrier(const XcdBarrier&) { fprintf(stderr, "EMU: grid barrier not supported (use per-phase launches)\n"); abort(); }
#endif

struct Inputs {
    const float *x, *c, *ctx, *c_ctx, *ada_w, *ada_b, *norm_mix, *norm_ffn, *w_in, *conv_rkv, *decay_bias, *decay_up, *iclr_bias, *iclr_up, *gate_up,
        *k_k, *k_a, *r_k, *gn_w, *gn_b, *pool_w, *pool_scale, *w_out, *ffn_gate, *ffn_up, *ffn_down, *final_norm;
};
struct Args { Inputs in; float* out; unsigned char* ws; int ph_lo, ph_hi; };
struct Frame {
    LAS unsigned char* lds;
    int tid, lane, wave, vcu, G;
    float* out; unsigned char* ws;
};
DI bf16_t* wl_ptr(const Frame& F, int l, size_t off) { return (bf16_t*)(F.ws + WS_W + (size_t)l * WL_SIZE + off); }
DI const float* mod_ptr(const Frame& F, int l, int s, int j) { return (const float*)(F.ws + WS_MOD) + ((size_t)(l * 3 + s) * 6 + j) * D; }
DI int sample_of_row(int row) { return row < ML ? row / SEQ : 2; }

DI void p0_transpose_item(const float* W, int N, bf16_t* WT, int ldo, int dst_row0, LAS float* scr, int k0, int n0, int lane) {
#pragma unroll 8
    for (int i = 0; i < 32; ++i) { const int kk = 2 * i + (lane >> 5); scr[kk * 33 + (lane & 31)] = W[(size_t)(k0 + kk) * N + n0 + (lane & 31)]; }
    LDS_WAIT();
    const int c = lane & 7;
#pragma unroll
    for (int j = 0; j < 4; ++j) { const int n = (lane >> 3) + 8 * j; const LAS float* s = scr + (8 * c) * 33 + n;
        u32x4 o; o.x = pk2(s[0 * 33], s[1 * 33]); o.y = pk2(s[2 * 33], s[3 * 33]); o.z = pk2(s[4 * 33], s[5 * 33]); o.w = pk2(s[6 * 33], s[7 * 33]);
        *(u32x4*)(WT + (size_t)(dst_row0 + n) * ldo + k0 + 8 * c) = o; }
    LDS_WAIT();
}
DI void phase_p0(Frame& F, const CAS Inputs& IN_) {
    LAS float* scr = (LAS float*)(F.lds + F.wave * 16384);
    const int gw = F.vcu * 8 + F.wave, NGW = F.G * 8;
    constexpr int I_WIN = (D / 64) * (INW / 32), I_WOUT = (D / 64) * (D / 32), I_G = (D / 64) * (DFF / 32), I_DN = (DFF / 64) * (D / 32), I_GUP = (GL / 64) * (RW / 32), I_POOL = 4 * (PG / 64) * (PG / 32);
    constexpr int I_LAYER = I_WIN + I_WOUT + 2 * I_G + I_DN + I_GUP + I_POOL;
    for (int it = gw; it < I_LAYER * DEPTH; it += NGW) {
        const int l = it / I_LAYER; int r = it % I_LAYER;
        if (r < I_WIN) { const int nb = INW / 32, kb = r / nb, n0 = 32 * (r % nb); p0_transpose_item(IN_.w_in + (size_t)l * D * INW, INW, wl_ptr(F, l, WL_WIN), D, n0, scr, 64 * kb, n0, F.lane); continue; } r -= I_WIN;
        if (r < I_WOUT) { const int nb = D / 32, kb = r / nb, n0 = 32 * (r % nb); p0_transpose_item(IN_.w_out + (size_t)l * D * D, D, wl_ptr(F, l, WL_WOUT), D, n0, scr, 64 * kb, n0, F.lane); continue; } r -= I_WOUT;
        if (r < 2 * I_G) { const int up = r >= I_G; if (up) r -= I_G; const int nb = DFF / 32, kb = r / nb, n0 = 32 * (r % nb);
            p0_transpose_item((up ? IN_.ffn_up : IN_.ffn_gate) + (size_t)l * D * DFF, DFF, wl_ptr(F, l, WL_WGU), D, (n0 / 128) * 256 + (n0 % 128) + (up ? 128 : 0), scr, 64 * kb, n0, F.lane); continue; } r -= 2 * I_G;
        if (r < I_DN) { const int nb = D / 32, kb = r / nb, n0 = 32 * (r % nb); p0_transpose_item(IN_.ffn_down + (size_t)l * DFF * D, D, wl_ptr(F, l, WL_WDN), DFF, n0, scr, 64 * kb, n0, F.lane); continue; } r -= I_DN;
        if (r < I_GUP) { const int nb = RW / 32, kb = r / nb, n0 = 32 * (r % nb); p0_transpose_item(IN_.gate_up + (size_t)l * GL * RW, RW, wl_ptr(F, l, WL_GUP), GL, n0, scr, 64 * kb, n0, F.lane); continue; } r -= I_GUP;
        { const int gi = r / ((PG / 64) * (PG / 32)); r %= (PG / 64) * (PG / 32); const int nb = PG / 32, kb = r / nb, n0 = 32 * (r % nb);
          p0_transpose_item(IN_.pool_w + ((size_t)l * 4 + gi) * PG * PG, PG, wl_ptr(F, l, WL_POOL) + (size_t)gi * PG * PG, PG, n0, scr, 64 * kb, n0, F.lane); }
    }
    const int gt = F.vcu * 512 + F.tid, NGT = F.G * 512;
    for (int i = gt; i < DEPTH * (INWP - INW) * D / 8; i += NGT) { const int l = i / ((INWP - INW) * D / 8), r = i % ((INWP - INW) * D / 8);
        *(u32x4*)(wl_ptr(F, l, WL_WIN) + (size_t)INW * D + (size_t)r * 8) = (u32x4){0u, 0u, 0u, 0u}; }
    for (int i = gt; i < DEPTH * 2 * 2 * RW * LORA; i += NGT) { int r = i; const int k = r % LORA; r /= LORA; const int n = r % RW; r /= RW; const int d = r % 2; r /= 2; const int which = r % 2; const int l = r / 2;
        const float* src = (which ? IN_.iclr_up : IN_.decay_up) + (((size_t)l * 2 + d) * LORA + k) * RW + n;
        wl_ptr(F, l, which ? WL_IUP : WL_DUP)[((size_t)d * RW + n) * LORA + k] = (bf16_t)f2bf(*src); }
    constexpr int NJB = 6 * D / 256, KCH = D / ADA_KC;
    for (int it = gw; it < DEPTH * NJB * ADA_KC; it += NGW) {
        const int kc = it % ADA_KC, jb = (it / ADA_KC) % NJB, l = it / (ADA_KC * NJB);
        const float* w = IN_.ada_w + ((size_t)l * D + (size_t)kc * KCH) * 6 * D + jb * 256 + 4 * F.lane;
        f32x4 a0 = {0.f, 0.f, 0.f, 0.f}, a1 = a0, a2 = a0;
#pragma unroll 8
        for (int k = 0; k < KCH; ++k) { const int kk = kc * KCH + k; const f32x4 wv = *(const f32x4*)(w + (size_t)k * 6 * D);
            const float c0 = fsilu(IN_.c[kk]), c1 = fsilu(IN_.c[D + kk]), c2 = fsilu(IN_.c_ctx[kk]);
            a0 += wv * c0; a1 += wv * c1; a2 += wv * c2; }
        float* p = (float*)(F.ws + WS_ADAP) + (((size_t)l * ADA_KC + kc) * 3) * 6 * D + jb * 256 + 4 * F.lane;
        *(f32x4*)(p) = a0; *(f32x4*)(p + 6 * D) = a1; *(f32x4*)(p + 12 * D) = a2;
    }
}
DI void phase_p0b(Frame& F, const CAS Inputs& IN_) {
    const int gt = F.vcu * 512 + F.tid, NGT = F.G * 512;
    for (int i = gt; i < DEPTH * 3 * 6 * D; i += NGT) { const int j = i % (6 * D), s = (i / (6 * D)) % 3, l = i / (18 * D);
        float a = IN_.ada_b[(size_t)l * 6 * D + j];
        for (int kc = 0; kc < ADA_KC; ++kc) a += ((const float*)(F.ws + WS_ADAP))[(((size_t)l * ADA_KC + kc) * 3 + s) * 6 * D + j];
        ((float*)(F.ws + WS_MOD))[i] = a; }
}

DI void phase_norm(Frame& F, const CAS Inputs& IN_, int l, bool second, int nrows) {
    const int gw = F.vcu * 8 + F.wave, NGW = F.G * 8;
    const float* gvec = (second ? IN_.norm_ffn : IN_.norm_mix) + (size_t)l * D;
    bf16_t* XN = (bf16_t*)(F.ws + WS_XN);
    for (int row = gw; row < nrows; row += NGW) {
        const float* xr;
        if (row < ML) xr = ((l == 0 && !second) ? IN_.x : F.out) + (size_t)row * D;
        else xr = ((l == 0 && !second) ? IN_.ctx : (const float*)(F.ws + WS_CTXH)) + (size_t)(row - ML) * D;
        const int s = sample_of_row(row);
        const float* sh = mod_ptr(F, l, s, second ? 3 : 0); const float* sc = mod_ptr(F, l, s, second ? 4 : 1);
        f32x4 v[8]; float ss = 0.f;
#pragma unroll
        for (int j = 0; j < 8; ++j) { v[j] = *(const f32x4*)(xr + 4 * (F.lane + 64 * j)); ss += (v[j].x * v[j].x + v[j].y * v[j].y) + (v[j].z * v[j].z + v[j].w * v[j].w); }
        const float rs = frsq(wave_sum(ss) * (1.f / D) + RMS_EPS);
#pragma unroll
        for (int j = 0; j < 8; ++j) { const int c = 4 * (F.lane + 64 * j); const f32x4 g = *(const f32x4*)(gvec + c), a = *(const f32x4*)(sc + c), b = *(const f32x4*)(sh + c);
            const f32x4 o = v[j] * rs * g * (a + 1.0f) + b; u32x2 w; w.x = pk2(o.x, o.y); w.y = pk2(o.z, o.w); *(u32x2*)(XN + (size_t)row * D + c) = w; }
    }
}
DI void phase_final_norm(Frame& F, const CAS Inputs& IN_) {
    const int gw = F.vcu * 8 + F.wave, NGW = F.G * 8;
    for (int row = gw; row < ML; row += NGW) {
        float* xr = F.out + (size_t)row * D; f32x4 v[8]; float ss = 0.f;
#pragma unroll
        for (int j = 0; j < 8; ++j) { v[j] = *(const f32x4*)(xr + 4 * (F.lane + 64 * j)); ss += (v[j].x * v[j].x + v[j].y * v[j].y) + (v[j].z * v[j].z + v[j].w * v[j].w); }
        const float rs = frsq(wave_sum(ss) * (1.f / D) + RMS_EPS);
#pragma unroll
        for (int j = 0; j < 8; ++j) { const int c = 4 * (F.lane + 64 * j); *(f32x4*)(xr + c) = v[j] * rs * *(const f32x4*)(IN_.final_norm + c); }
    }
}

struct EpiU {
    static constexpr bool PERM = true;
    bf16_t* O; int ldc; int act;
    DI void operator()(const f32x4 (&acc)[2][2][4][2], const pg8::Unit& u, int wr, int wc, int fr, int fq) const {
        const int row0 = u.pm * 256 + wr * 64 + fr, col0 = u.pn * 256 + wc * 32 + 8 * fq;
        const bool special = act && (col0 + 128 + 8 > OFF_W) && (col0 < OFF_POOL);
#pragma unroll
        for (int ai = 0; ai < 2; ++ai)
#pragma unroll
            for (int m = 0; m < 4; ++m) { bf16_t* rowp = O + (size_t)(row0 + ai * 128 + m * 16) * ldc + col0;
#pragma unroll
                for (int bj = 0; bj < 2; ++bj) { f32x4 v0 = acc[ai][bj][m][0], v1 = acc[ai][bj][m][1];
                    if (special) { const int c = col0 + bj * 128;
                        if (c >= OFF_W && c < OFF_A) {
#pragma unroll
                            for (int e = 0; e < 4; ++e) { v0[e] = ftanh(v0[e]); v1[e] = ftanh(v1[e]); } }
                        else if (c >= OFF_G && c < OFF_POOL) {
#pragma unroll
                            for (int e = 0; e < 4; ++e) { v0[e] = fsigmoid(v0[e]); v1[e] = fsigmoid(v1[e]); } } }
                    u32x4 w; w.x = pk2(v0[0], v0[1]); w.y = pk2(v0[2], v0[3]); w.z = pk2(v1[0], v1[1]); w.w = pk2(v1[2], v1[3]);
                    *(u32x4*)(rowp + bj * 128) = w; } }
    }
};
struct EpiPool {
    static constexpr bool PERM = true;
    bf16_t* O; const float* scale;
    DI void operator()(const f32x4 (&acc)[2][2][4][2], const pg8::Unit& u, int wr, int wc, int fr, int fq) const {
        const int row0 = u.pm * 256 + wr * 64 + fr, col0 = u.pn * 256 + wc * 32 + 8 * fq;
#pragma unroll
        for (int bj = 0; bj < 2; ++bj) { const f32x4 s0 = *(const f32x4*)(scale + col0 + bj * 128), s1 = *(const f32x4*)(scale + col0 + bj * 128 + 4);
#pragma unroll
            for (int ai = 0; ai < 2; ++ai)
#pragma unroll
                for (int m = 0; m < 4; ++m) { bf16_t* rowp = O + (size_t)(row0 + ai * 128 + m * 16) * D + RW + col0;
                    const f32x4 v0 = acc[ai][bj][m][0] * s0, v1 = acc[ai][bj][m][1] * s1;
                    u32x4 w; w.x = pk2(v0[0], v0[1]); w.y = pk2(v0[2], v0[3]); w.z = pk2(v1[0], v1[1]); w.w = pk2(v1[2], v1[3]);
                    *(u32x4*)(rowp + bj * 128) = w; }
            CFENCE(); }
    }
};
struct EpiSwiglu {
    static constexpr bool PERM = true;
    bf16_t* O;
    DI void operator()(const f32x4 (&acc)[2][2][4][2], const pg8::Unit& u, int wr, int wc, int fr, int fq) const {
        const int row0 = u.pm * 256 + wr * 64 + fr, col0 = u.pn * 128 + wc * 32 + 8 * fq;
#pragma unroll
        for (int ai = 0; ai < 2; ++ai)
#pragma unroll
            for (int m = 0; m < 4; ++m) { f32x4 v0, v1;
#pragma unroll
                for (int e = 0; e < 4; ++e) { v0[e] = fsilu(acc[ai][0][m][0][e]) * acc[ai][1][m][0][e]; v1[e] = fsilu(acc[ai][0][m][1][e]) * acc[ai][1][m][1][e]; }
                u32x4 w; w.x = pk2(v0[0], v0[1]); w.y = pk2(v0[2], v0[3]); w.z = pk2(v1[0], v1[1]); w.w = pk2(v1[2], v1[3]);
                *(u32x4*)(O + (size_t)(row0 + ai * 128 + m * 16) * DFF + col0) = w; }
    }
};
struct EpiRes {
    static constexpr bool PERM = false;
    const float* base_l; float* out_l; long long dbase_c, dout_c; const float* gate0;
    DI void operator()(const f32x4 (&acc)[2][2][4][2], const pg8::Unit& u, int wr, int wc, int fr, int fq) const {
        const bool lat = u.pm < NPM_L; const int prow = lat ? u.pm * 256 : (u.pm - NPM_L) * 256;
        const float* base = (const float*)((const char*)base_l + (lat ? 0ll : dbase_c)); float* out = (float*)((char*)out_l + (lat ? 0ll : dout_c));
        const float* gv = gate0 + (size_t)(lat ? (u.pm * 256) / SEQ : 2) * 6 * D;
        const int row0 = prow + wr * 64 + fr, col0 = u.pn * 256 + wc * 32 + 4 * fq;
        f32x4 g4[2][2];
#pragma unroll
        for (int bj = 0; bj < 2; ++bj)
#pragma unroll
            for (int n = 0; n < 2; ++n) g4[bj][n] = *(const f32x4*)(gv + col0 + bj * 128 + n * 16);
#pragma unroll
        for (int ai = 0; ai < 2; ++ai)
#pragma unroll
            for (int m = 0; m < 4; ++m) { const size_t off = (size_t)(row0 + ai * 128 + m * 16) * D + col0;
#pragma unroll
                for (int bj = 0; bj < 2; ++bj)
#pragma unroll
                    for (int n = 0; n < 2; ++n) { const f32x4 b = *(const f32x4*)(base + off + bj * 128 + n * 16); *(f32x4*)(out + off + bj * 128 + n * 16) = b + g4[bj][n] * acc[ai][bj][m][n]; }
                CFENCE(); }
    }
};

DI int img_off(int r, int c) { return r * 128 + ((((c >> 3) ^ (r & 7)) << 4) | ((c & 7) << 1)); }
DI bf16x8 ldfrag(const LAS unsigned char* img, int r0, int k0, int lane) { const int r = r0 + (lane & 15), c = k0 + 8 * (lane >> 4); return *(const LAS bf16x8*)(img + r * 128 + (((c >> 3) ^ (r & 7)) << 4)); }
template <int KK> DI f32x4 tile_mm(f32x4 acc, const LAS unsigned char* X, int x0, const LAS unsigned char* Y, int y0, int lane) {
#pragma unroll
    for (int ks = 0; ks < KK / 32; ++ks) { const bf16x8 xf = ldfrag(X, x0, 32 * ks, lane), yf = ldfrag(Y, y0, 32 * ks, lane); acc = MFMA16(xf, yf, acc); }
    return acc;
}
DI void st_tile(LAS unsigned char* img, int yrow, int xcol, const f32x4& v) { u32x2 w; w.x = pk2(v[0], v[1]); w.y = pk2(v[2], v[3]); *(LAS u32x2*)(img + img_off(yrow, xcol)) = w; }
DI f32x4 ld_tile(const LAS unsigned char* img, int yrow, int xcol) { const u32x2 w = *(const LAS u32x2*)(img + img_off(yrow, xcol)); return (f32x4){bflo(w.x), bfhi(w.x), bflo(w.y), bfhi(w.y)}; }

struct ScanItem { int b, h, dir, seg; };
DI int item_index(const ScanItem& it) { return ((it.b * NH + it.h) * 2 + it.dir) * NSEG + it.seg; }
struct SegGeom { int nchunks, seqlen, rowbase, pos0; };
DI SegGeom seg_geom(const ScanItem& it) { SegGeom g; if (it.seg == 0) { g.nchunks = CTX / 64; g.seqlen = CTX; g.rowbase = ML + it.b * CTX; g.pos0 = 0; } else { g.nchunks = SEGLEN / 64; g.seqlen = SEQ; g.rowbase = it.b * SEQ; g.pos0 = (it.seg - 1) * SEGLEN; } return g; }

template <bool PASS3>
DI void scan_item(Frame& F, const CAS Inputs& IN_, int l, const ScanItem it) {
    LAS unsigned char* L = F.lds;
    const SegGeom sg = seg_geom(it);
    const bf16_t* U = (const bf16_t*)(F.ws + WS_U);
    constexpr int NVT = PASS3 ? 4 : 8;
    constexpr int NHT = NVT * 4 / 8;
    f32x4 hacc[NHT];
    const size_t st_off = (size_t)item_index(it) * 4096;
    { const int lane = F.lane, wave = F.wave, q = lane >> 4, l15 = lane & 15;
#pragma unroll
    for (int i = 0; i < NHT; ++i) { const int t = wave + 8 * i, yt = t >> 2, xt = t & 3; const int v = 16 * yt + l15, k = 16 * xt + 4 * q;
        if (PASS3) hacc[i] = *(const f32x4*)((const float*)(F.ws + WS_HIN) + st_off + (size_t)v * 64 + k);
        else { hacc[i] = (f32x4){0.f, 0.f, 0.f, 0.f}; if (v >= 64) {
#pragma unroll
            for (int e = 0; e < 4; ++e) hacc[i][e] = (v - 64 == k + e) ? 1.f : 0.f; } }
        st_tile(L + M_H0 * IMG, v, k, hacc[i]); } }
    float* YO = (float*)(F.ws + WS_YF) + (size_t)it.dir * MR * RW;
    float* BS = (float*)(F.ws + WS_BS) + (size_t)it.dir * MR * NH;
    const bf16_t* DUP = wl_ptr(F, l, WL_DUP) + (size_t)it.dir * RW * LORA;
    const bf16_t* IUP = wl_ptr(F, l, WL_IUP) + (size_t)it.dir * RW * LORA;
    for (int c = 0; c < sg.nchunks; ++c) {
        int tid_o = F.tid; OPAQUE_V(tid_o);
        const int tid = tid_o, lane = tid & 63, wave = RFL(tid >> 6), q = lane >> 4, l15 = lane & 15;
        const int qpos0 = sg.pos0 + 64 * c;
        {
            const int mat = wave >> 2, ntile = wave & 3;
            f32x4 a4[4];
#pragma unroll
            for (int mt = 0; mt < 4; ++mt) a4[mt] = (f32x4){0.f, 0.f, 0.f, 0.f};
            const bf16_t* Wt = (mat ? IUP : DUP) + (size_t)(it.h * 64 + 16 * ntile + l15) * LORA + 8 * q;
            bf16x8 bfr[3];
#pragma unroll
            for (int ks = 0; ks < 3; ++ks) bfr[ks] = *(const bf16x8*)(Wt + 32 * ks);
#pragma unroll
            for (int mt = 0; mt < 4; ++mt) { const int qq = qpos0 + 16 * mt + l15; const int tau = it.dir ? sg.seqlen - 1 - qq : qq;
                const bf16_t* ur = U + (size_t)(sg.rowbase + tau) * INWP + (mat ? OFF_A : OFF_W) + 8 * q;
#pragma unroll
                for (int ks = 0; ks < 3; ++ks) { const bf16x8 af = *(const bf16x8*)(ur + 32 * ks); a4[mt] = MFMA16(af, bfr[ks], a4[mt]); } }
            const int chn = it.h * 64 + 16 * ntile + l15;
            if (mat == 0) {
                const float bias = IN_.decay_bias[((size_t)l * 2 + it.dir) * RW + chn];
                float run = 0.f;
                LAS float* G = (LAS float*)(L + SCR_G);
#pragma unroll
                for (int mt = 0; mt < 4; ++mt) {
                    float c0 = -0.6065306597126334f * fsigmoid(bias + a4[mt][0]), c1 = -0.6065306597126334f * fsigmoid(bias + a4[mt][1]), c2 = -0.6065306597126334f * fsigmoid(bias + a4[mt][2]), c3 = -0.6065306597126334f * fsigmoid(bias + a4[mt][3]);
                    c1 += c0; c2 += c1; c3 += c2;
                    const float t1 = __shfl(c3, lane - 16), t2 = __shfl(c3, lane - 32), t3 = __shfl(c3, lane - 48);
                    const float off = run + (q >= 1 ? t1 : 0.f) + (q >= 2 ? t2 : 0.f) + (q >= 3 ? t3 : 0.f);
                    const float tot = __shfl(off + c3, 48 + l15);
                    const int p0 = 16 * mt + 4 * q, cc = 16 * ntile + l15;
                    G[(p0 + 0) * 68 + cc] = off + c0; G[(p0 + 1) * 68 + cc] = off + c1; G[(p0 + 2) * 68 + cc] = off + c2; G[(p0 + 3) * 68 + cc] = off + c3;
                    run = tot;
                }
            } else {
                const float bias = IN_.iclr_bias[((size_t)l * 2 + it.dir) * RW + chn];
                LAS float* AI = (LAS float*)(L + SCR_AI);
#pragma unroll
                for (int mt = 0; mt < 4; ++mt) { const int p0 = 16 * mt + 4 * q, cc = 16 * ntile + l15;
#pragma unroll
                    for (int e = 0; e < 4; ++e) AI[(p0 + e) * 68 + cc] = fsigmoid(bias + a4[mt][e]); }
            }
        }
        LDS_WAIT(); WG_BAR();
#pragma unroll 1
        for (int half = 0; half < 2; ++half) {
            const int p = (tid >> 4) + 32 * half, cg = tid & 15, ch0 = it.h * 64 + 4 * cg;
            const int qq = qpos0 + p; const int tau = it.dir ? sg.seqlen - 1 - qq : qq; const size_t row = (size_t)(sg.rowbase + tau);
            const bool hasm = tau > 0, hasp = tau < sg.seqlen - 1;
            float r4[4], k4[4], v4[4];
            {
                const float* cw = IN_.conv_rkv + (size_t)l * 3 * 3 * RW;
#pragma unroll
                for (int x = 0; x < 3; ++x) {
                    const bf16_t* up = U + row * INWP + x * RW + ch0;
                    float cen[4], lo[4], hi[4];
                    unpack4(*(const u32x2*)up, cen);
                    if (hasm) unpack4(*(const u32x2*)(up - INWP), lo); else {
#pragma unroll
                        for (int j = 0; j < 4; ++j) lo[j] = 0.f; }
                    if (hasp) unpack4(*(const u32x2*)(up + INWP), hi); else {
#pragma unroll
                        for (int j = 0; j < 4; ++j) hi[j] = 0.f; }
                    const f32x4 w0 = *(const f32x4*)(cw + x * RW + ch0), w1 = *(const f32x4*)(cw + 3 * RW + x * RW + ch0), w2 = *(const f32x4*)(cw + 6 * RW + x * RW + ch0);
                    float* dst = x == 0 ? r4 : (x == 1 ? k4 : v4);
#pragma unroll
                    for (int j = 0; j < 4; ++j) dst[j] = lo[j] * w0[j] + cen[j] * w1[j] + hi[j] * w2[j];
                }
            }
            float kk4[4]; float nn = 0.f;
            { const f32x4 kkp = *(const f32x4*)(IN_.k_k + (size_t)l * RW + ch0);
#pragma unroll
              for (int j = 0; j < 4; ++j) { kk4[j] = k4[j] * kkp[j]; nn += kk4[j] * kk4[j]; } }
            nn += __shfl_xor(nn, 1); nn += __shfl_xor(nn, 2); nn += __shfl_xor(nn, 4); nn += __shfl_xor(nn, 8);
            const float inv = frsq(fmaxf(nn, 1e-24f));
            const LAS float* G = (const LAS float*)(L + SCR_G); const LAS float* AI = (const LAS float*)(L + SCR_AI);
            const f32x4 g4 = *(const LAS f32x4*)(G + p * 68 + 4 * cg), gc4 = *(const LAS f32x4*)(G + 63 * 68 + 4 * cg), a4 = *(const LAS f32x4*)(AI + p * 68 + 4 * cg);
            f32x4 gp4 = {0.f, 0.f, 0.f, 0.f}; if (p > 0) gp4 = *(const LAS f32x4*)(G + (p - 1) * 68 + 4 * cg);
            const f32x4 kap = *(const f32x4*)(IN_.k_a + (size_t)l * RW + ch0), rkp = *(const f32x4*)(IN_.r_k + (size_t)l * RW + ch0);
            float rt[4], at[4], kb[4], bb[4], kt[4], bt[4]; float bsum = 0.f;
#pragma unroll
            for (int j = 0; j < 4; ++j) { const float kkn = kk4[j] * inv; const float kd = k4[j] * (1.0f + (a4[j] - 1.0f) * kap[j]); const float bh = kkn * a4[j];
                const float eg = fexp(g4[j]), egp = fexp(gp4[j]), eng = fexp(-g4[j]), egc = fexp(gc4[j] - g4[j]);
                rt[j] = r4[j] * eg; at[j] = -kkn * egp; kb[j] = kd * eng; bb[j] = bh * eng; kt[j] = kd * egc; bt[j] = bh * egc; bsum += r4[j] * kd * rkp[j]; }
            *(LAS u32x2*)(L + M_RT * IMG + img_off(p, 4 * cg)) = pack4(rt);
            *(LAS u32x2*)(L + M_AT * IMG + img_off(p, 4 * cg)) = pack4(at);
            *(LAS u32x2*)(L + M_KB * IMG + img_off(p, 4 * cg)) = pack4(kb);
            *(LAS u32x2*)(L + M_BB * IMG + img_off(p, 4 * cg)) = pack4(bb);
#pragma unroll
            for (int j = 0; j < 4; ++j) { const int chl = 4 * cg + j;
                *(LAS unsigned short*)(L + M_KT * IMG + img_off(chl, p)) = (unsigned short)f2bf(kt[j]);
                *(LAS unsigned short*)(L + M_BT * IMG + img_off(chl, p)) = (unsigned short)f2bf(bt[j]);
                *(LAS unsigned short*)(L + M_VT * IMG + img_off(chl, p)) = (unsigned short)f2bf(v4[j]); }
            if (p == 63) {
#pragma unroll
                for (int j = 0; j < 4; ++j) ((LAS float*)(L + SC_GC))[4 * cg + j] = fexp(gc4[j]); }
            if (PASS3) { bsum += __shfl_xor(bsum, 1); bsum += __shfl_xor(bsum, 2); bsum += __shfl_xor(bsum, 4); bsum += __shfl_xor(bsum, 8); if (cg == 0) BS[row * NH + it.h] = bsum; }
        }
        LDS_WAIT(); WG_BAR();
        {
            *(LAS u32x4*)(L + (M_T0 + 1) * IMG + tid * 16) = (u32x4){0u, 0u, 0u, 0u};
            *(LAS u32x4*)(L + (M_T0 + 3) * IMG + tid * 16) = (u32x4){0u, 0u, 0u, 0u};
            for (int t = wave; t < 16; t += 8) { const int yt = t >> 2, xt = t & 3; f32x4 a = {0.f, 0.f, 0.f, 0.f};
                if (xt <= yt) { a = tile_mm<64>(a, L + M_KB * IMG, 16 * xt, L + M_AT * IMG, 16 * yt, lane);
#pragma unroll
                    for (int e = 0; e < 4; ++e) if (!(16 * xt + 4 * q + e < 16 * yt + l15)) a[e] = 0.f; }
                st_tile(L + M_AAK * IMG, 16 * yt + l15, 16 * xt + 4 * q, a); }
            for (int t = wave; t < 16; t += 8) { const int yt = t >> 2, xt = t & 3; f32x4 a = {0.f, 0.f, 0.f, 0.f};
                if (xt >= yt) a = tile_mm<64>(a, L + M_AT * IMG, 16 * xt, L + M_BB * IMG, 16 * yt, lane);
                if (xt == yt) { LAS float* DG = (LAS float*)(L + SC_DIAG) + yt * 256;
#pragma unroll
                    for (int e = 0; e < 4; ++e) DG[(4 * q + e) * 16 + l15] = (l15 < 4 * q + e) ? a[e] : 0.f;
                    a = (f32x4){0.f, 0.f, 0.f, 0.f}; }
                st_tile(L + M_T0 * IMG, 16 * yt + l15, 16 * xt + 4 * q, a); }
            if (PASS3) {
                for (int t = wave; t < 32; t += 8) { const int which = t >> 4, yt = (t >> 2) & 3, xt = t & 3; f32x4 a = {0.f, 0.f, 0.f, 0.f};
                    if (xt <= yt) { a = tile_mm<64>(a, L + (which ? M_BB : M_KB) * IMG, 16 * xt, L + M_RT * IMG, 16 * yt, lane);
#pragma unroll
                        for (int e = 0; e < 4; ++e) if (!(16 * xt + 4 * q + e <= 16 * yt + l15)) a[e] = 0.f; }
                    st_tile(L + (which ? M_ARB : M_ARK) * IMG, 16 * yt + l15, 16 * xt + 4 * q, a); }
            }
        }
        LDS_WAIT(); WG_BAR();
        if (wave == 0) {
            const int ib = q, cc = l15; const LAS float* DG = (const LAS float*)(L + SC_DIAG) + ib * 256;
            float d[16];
#pragma unroll
            for (int t = 0; t < 16; ++t) { float a = (t == cc) ? 1.f : 0.f;
                float rowv[16];
#pragma unroll
                for (int j4 = 0; j4 < 4; ++j4) { if (4 * j4 < t) { const f32x4 x = *(const LAS f32x4*)(DG + t * 16 + 4 * j4); rowv[4 * j4] = x[0]; rowv[4 * j4 + 1] = x[1]; rowv[4 * j4 + 2] = x[2]; rowv[4 * j4 + 3] = x[3]; } }
#pragma unroll
                for (int j = 0; j < t; ++j) a += rowv[j] * d[j];
                d[t] = a; }
#pragma unroll
            for (int t = 0; t < 16; ++t) *(LAS unsigned short*)(L + (M_T0 + 1) * IMG + img_off(16 * ib + t, 16 * ib + cc)) = (unsigned short)f2bf(d[t]);
            { float lo8[8], hi8[8];
#pragma unroll
              for (int t = 0; t < 8; ++t) { lo8[t] = d[t]; hi8[t] = d[8 + t]; }
              *(LAS u32x4*)(L + (M_T0 + 3) * IMG + img_off(16 * ib + cc, 16 * ib)) = pack8(lo8);
              *(LAS u32x4*)(L + (M_T0 + 3) * IMG + img_off(16 * ib + cc, 16 * ib + 8)) = pack8(hi8); }
        }
        LDS_WAIT(); WG_BAR();
        for (int t = wave; t < 16; t += 8) { const int yt = t >> 2, xt = t & 3; f32x4 a = {0.f, 0.f, 0.f, 0.f};
            if (xt < yt) a = tile_mm<64>(a, L + M_T0 * IMG, 16 * xt, L + (M_T0 + 1) * IMG, 16 * yt, lane);
            st_tile(L + (M_T0 + 2) * IMG, 16 * yt + l15, 16 * xt + 4 * q, a); }
        LDS_WAIT(); WG_BAR();
#pragma unroll
        for (int iter = 0; iter < 2; ++iter) {
            const LAS unsigned char* src = L + (M_T0 + (iter == 0 ? 3 : 4)) * IMG; LAS unsigned char* dst = L + (M_T0 + (iter == 0 ? 4 : 3)) * IMG;
            for (int t = wave; t < 16; t += 8) { const int yt = t >> 2, xt = t & 3; f32x4 a = {0.f, 0.f, 0.f, 0.f};
                if (xt == yt) {
#pragma unroll
                    for (int e = 0; e < 4; ++e) a[e] = bf2f(*(const LAS unsigned short*)(L + (M_T0 + 1) * IMG + img_off(16 * xt + 4 * q + e, 16 * yt + l15))); }
                if (xt >= yt) a = tile_mm<64>(a, L + (M_T0 + 2) * IMG, 16 * xt, src, 16 * yt, lane);
                st_tile(dst, 16 * yt + l15, 16 * xt + 4 * q, a); }
            LDS_WAIT(); WG_BAR();
        }
        for (int t = wave; t < 16; t += 8) { const int yt = t >> 2, xt = t & 3; f32x4 a = {0.f, 0.f, 0.f, 0.f};
            if (xt == yt) a = ld_tile(L + (M_T0 + 1) * IMG, 16 * yt + l15, 16 * xt + 4 * q);
            if (xt <= yt) a = tile_mm<64>(a, L + (M_T0 + 3) * IMG, 16 * xt, L + (M_T0 + 2) * IMG, 16 * yt, lane);
            st_tile(L + M_TM * IMG, 16 * yt + l15, 16 * xt + 4 * q, a); }
        LDS_WAIT(); WG_BAR();
        for (int t = wave; t < NVT * 4; t += 8) { const int yt = t >> 2, xt = t & 3; f32x4 a = {0.f, 0.f, 0.f, 0.f};
            if (yt < 4) a = tile_mm<64>(a, L + M_AAK * IMG, 16 * xt, L + M_VT * IMG, 16 * yt, lane);
            a = tile_mm<64>(a, L + M_AT * IMG, 16 * xt, L + M_H0 * IMG, 16 * yt, lane);
            st_tile(L + M_T0 * IMG, 16 * yt + l15, 16 * xt + 4 * q, a); }
        LDS_WAIT(); WG_BAR();
        for (int t = wave; t < NVT * 4; t += 8) { const int yt = t >> 2, xt = t & 3; f32x4 a = {0.f, 0.f, 0.f, 0.f};
            a = tile_mm<64>(a, L + M_TM * IMG, 16 * xt, L + M_T0 * IMG, 16 * yt, lane);
            st_tile(L + (M_T0 + 2) * IMG, 16 * yt + l15, 16 * xt + 4 * q, a); }
        LDS_WAIT(); WG_BAR();
        if (PASS3) {
            for (int t = wave; t < 16; t += 8) { const int yt = t >> 2, xt = t & 3; f32x4 a = {0.f, 0.f, 0.f, 0.f};
                a = tile_mm<64>(a, L + M_H0 * IMG, 16 * xt, L + M_RT * IMG, 16 * yt, lane);
                a = tile_mm<64>(a, L + M_VT * IMG, 16 * xt, L + M_ARK * IMG, 16 * yt, lane);
                a = tile_mm<64>(a, L + (M_T0 + 2) * IMG, 16 * xt, L + M_ARB * IMG, 16 * yt, lane);
                const int pp = 16 * yt + l15; const int qq = qpos0 + pp; const int tau = it.dir ? sg.seqlen - 1 - qq : qq;
                *(f32x4*)(YO + (size_t)(sg.rowbase + tau) * RW + it.h * 64 + 16 * xt + 4 * q) = a; }
        }
#pragma unroll
        for (int i = 0; i < NHT; ++i) { const int t = wave + 8 * i, yt = t >> 2, xt = t & 3;
            const f32x4 gc = *(const LAS f32x4*)(L + SC_GC + (16 * xt + 4 * q) * 4);
            f32x4 a = hacc[i] * gc;
            if (yt < 4) a = tile_mm<64>(a, L + M_KT * IMG, 16 * xt, L + M_VT * IMG, 16 * yt, lane);
            a = tile_mm<64>(a, L + M_BT * IMG, 16 * xt, L + (M_T0 + 2) * IMG, 16 * yt, lane);
            hacc[i] = a; }
        LDS_WAIT(); WG_BAR();
#pragma unroll
        for (int i = 0; i < NHT; ++i) { const int t = wave + 8 * i, yt = t >> 2, xt = t & 3; st_tile(L + M_H0 * IMG, 16 * yt + l15, 16 * xt + 4 * q, hacc[i]); }
        LDS_WAIT(); WG_BAR();
    }
    if (!PASS3) { const int lane = F.lane, wave = F.wave, q = lane >> 4, l15 = lane & 15;
#pragma unroll
        for (int i = 0; i < NHT; ++i) { const int t = wave + 8 * i, yt = t >> 2, xt = t & 3; const int v = 16 * yt + l15, k = 16 * xt + 4 * q;
            float* dst = (v < 64) ? (float*)(F.ws + WS_SSEG) + st_off + (size_t)v * 64 + k : (float*)(F.ws + WS_PSEG) + st_off + (size_t)(v - 64) * 64 + k;
            *(f32x4*)dst = hacc[i]; }
    }
}
DI bool scan_item_of(int idx, bool pass3, bool skip_ctx, ScanItem& it) {
    const int nl = pass3 ? NSEGL : NSEGL - 1;
    const int n_lat = NB * NH * 2 * nl, n_ctx = (pass3 && skip_ctx) ? 0 : NB * NH * 2;
    if (idx < n_lat) { it.seg = 1 + idx % nl; int r = idx / nl; it.dir = r & 1; r >>= 1; it.h = r % NH; it.b = r / NH; return true; }
    idx -= n_lat; if (idx >= n_ctx) return false;
    it.seg = 0; it.dir = idx & 1; idx >>= 1; it.h = idx % NH; it.b = idx / NH; return true;
}
DI void phase_chain(Frame& F) {
    LAS float* Sm = (LAS float*)F.lds; LAS float* Pm = Sm + 64 * 65;
    const int v = F.tid >> 3, kg = F.tid & 7;
    for (int ci = F.vcu; ci < NB * NH * 2; ci += F.G) {
        const size_t base = (size_t)ci * NSEG * 4096;
        float s8[8];
#pragma unroll
        for (int j = 0; j < 8; ++j) s8[j] = 0.f;
        for (int seg = 0; seg < NSEG; ++seg) {
            float* hin = (float*)(F.ws + WS_HIN) + base + (size_t)seg * 4096 + v * 64 + 8 * kg;
            *(f32x4*)hin = (f32x4){s8[0], s8[1], s8[2], s8[3]}; *(f32x4*)(hin + 4) = (f32x4){s8[4], s8[5], s8[6], s8[7]};
            if (seg == NSEG - 1) break;
            const float* pp = (const float*)(F.ws + WS_PSEG) + base + (size_t)seg * 4096 + v * 64 + 8 * kg;
            const float* sp = (const float*)(F.ws + WS_SSEG) + base + (size_t)seg * 4096 + v * 64 + 8 * kg;
            WG_BAR();
#pragma unroll
            for (int j = 0; j < 8; ++j) { Sm[v * 65 + 8 * kg + j] = s8[j]; Pm[v * 64 + 8 * kg + j] = pp[j]; }
            float o8[8];
#pragma unroll
            for (int j = 0; j < 8; ++j) o8[j] = sp[j];
            LDS_WAIT(); WG_BAR();
            for (int j = 0; j < 64; ++j) { const float sv = Sm[v * 65 + j]; const f32x4 p0 = *(const LAS f32x4*)(Pm + j * 64 + 8 * kg), p1 = *(const LAS f32x4*)(Pm + j * 64 + 8 * kg + 4);
                o8[0] += sv * p0[0]; o8[1] += sv * p0[1]; o8[2] += sv * p0[2]; o8[3] += sv * p0[3]; o8[4] += sv * p1[0]; o8[5] += sv * p1[1]; o8[6] += sv * p1[2]; o8[7] += sv * p1[3]; }
#pragma unroll
            for (int j = 0; j < 8; ++j) s8[j] = o8[j];
        }
        WG_BAR();
    }
}

DI void phase_poolv(Frame& F, int start, int stride) {
    const bf16_t* U = (const bf16_t*)(F.ws + WS_U); bf16_t* VS = (bf16_t*)(F.ws + WS_VS);
    for (int i = start; i < ML * 128; i += stride) { const int row = i >> 7, ck = i & 127; const int half = 1 << (ck >> 5);
        const int b = row / SEQ, t = row % SEQ, y = t / GW; const int ylo = y - half < 0 ? 0 : y - half, yhi = y + half > GROWS ? GROWS : y + half;
        float s[8];
#pragma unroll
        for (int j = 0; j < 8; ++j) s[j] = 0.f;
        for (int yy = ylo; yy < yhi; ++yy) { float f[8]; unpack8(*(const u32x4*)(U + (size_t)(b * SEQ + yy * GW + (t % GW)) * INWP + OFF_POOL + 8 * ck), f);
#pragma unroll
            for (int j = 0; j < 8; ++j) s[j] += f[j]; }
        *(u32x4*)(VS + (size_t)row * PWD + 8 * ck) = pack8(s); }
}
DI void phase_poolh(Frame& F, int start, int stride) {
    const bf16_t* U = (const bf16_t*)(F.ws + WS_U); const bf16_t* VS = (const bf16_t*)(F.ws + WS_VS); bf16_t* PD = (bf16_t*)(F.ws + WS_PD);
    for (int i = start; i < MR * 128; i += stride) { const int row = i >> 7, ck = i & 127; const int half = 1 << (ck >> 5);
        float s[8], f[8];
#pragma unroll
        for (int j = 0; j < 8; ++j) s[j] = 0.f;
        float cnt;
        if (row < ML) { const int t = row % SEQ, y = t / GW, x = t % GW; const int xlo = x - half < 0 ? 0 : x - half, xhi = x + half > GW ? GW : x + half;
            const int ylo = y - half < 0 ? 0 : y - half, yhi = y + half > GROWS ? GROWS : y + half;
            for (int xx = xlo; xx < xhi; ++xx) { unpack8(*(const u32x4*)(VS + (size_t)(row - x + xx) * PWD + 8 * ck), f);
#pragma unroll
                for (int j = 0; j < 8; ++j) s[j] += f[j]; }
            cnt = (float)((xhi - xlo) * (yhi - ylo));
        } else { const int t = (row - ML) % CTX; const int lo = t - half < 0 ? 0 : t - half, hi = t + half > CTX ? CTX : t + half;
            for (int tt = lo; tt < hi; ++tt) { unpack8(*(const u32x4*)(U + (size_t)(row - t + tt) * INWP + OFF_POOL + 8 * ck), f);
#pragma unroll
                for (int j = 0; j < 8; ++j) s[j] += f[j]; }
            cnt = (float)(hi - lo); }
        unpack8(*(const u32x4*)(U + (size_t)row * INWP + OFF_POOL + 8 * ck), f);
        const float ic = 1.0f / cnt;
#pragma unroll
        for (int j = 0; j < 8; ++j) s[j] = s[j] * ic - f[j];
        *(u32x4*)(PD + (size_t)row * PWD + 8 * ck) = pack8(s); }
}

DI void phase_finish(Frame& F, const CAS Inputs& IN_, int l, int nrows) {
    const bf16_t* U = (const bf16_t*)(F.ws + WS_U); const bf16_t* Gt = (const bf16_t*)(F.ws + WS_G); bf16_t* MIX = (bf16_t*)(F.ws + WS_MIX);
    const float* YF = (const float*)(F.ws + WS_YF); const float* YB = YF + (size_t)MR * RW; const float* BS0 = (const float*)(F.ws + WS_BS); const float* BS1 = BS0 + (size_t)MR * NH;
    const float* cw = IN_.conv_rkv + (size_t)l * 9 * RW + 2 * RW;
    const int gt = F.vcu * 512 + F.tid, NGT = F.G * 512;
    for (int i = gt; i < nrows * 128; i += NGT) { const int row = i >> 7, cg = i & 127, h = cg >> 3, ch = 8 * cg;
        int tau, len; if (row < ML) { tau = row % SEQ; len = SEQ; } else { tau = (row - ML) % CTX; len = CTX; }
        float y[8];
        { const f32x4 a0 = *(const f32x4*)(YF + (size_t)row * RW + ch), a1 = *(const f32x4*)(YF + (size_t)row * RW + ch + 4), b0 = *(const f32x4*)(YB + (size_t)row * RW + ch), b1 = *(const f32x4*)(YB + (size_t)row * RW + ch + 4);
#pragma unroll
          for (int e = 0; e < 4; ++e) { y[e] = a0[e] + b0[e]; y[4 + e] = a1[e] + b1[e]; } }
        float s = 0.f;
#pragma unroll
        for (int j = 0; j < 8; ++j) s += y[j];
        s += __shfl_xor(s, 1); s += __shfl_xor(s, 2); s += __shfl_xor(s, 4);
        const float mu = s * (1.f / 64.f); float vq = 0.f;
#pragma unroll
        for (int j = 0; j < 8; ++j) { y[j] -= mu; vq += y[j] * y[j]; }
        vq += __shfl_xor(vq, 1); vq += __shfl_xor(vq, 2); vq += __shfl_xor(vq, 4);
        const float rstd = frsq(vq * (1.f / 64.f) + GN_EPS);
        float cen[8], lo[8], hi[8], g8[8];
        const bf16_t* up = U + (size_t)row * INWP + OFF_V + ch;
        unpack8(*(const u32x4*)up, cen);
        if (tau > 0) unpack8(*(const u32x4*)(up - INWP), lo); else {
#pragma unroll
            for (int j = 0; j < 8; ++j) lo[j] = 0.f; }
        if (tau < len - 1) unpack8(*(const u32x4*)(up + INWP), hi); else {
#pragma unroll
            for (int j = 0; j < 8; ++j) hi[j] = 0.f; }
        unpack8(*(const u32x4*)(Gt + (size_t)row * RW + ch), g8);
        const float bsum = BS0[(size_t)row * NH + h] + BS1[(size_t)row * NH + h];
        const float* gw = IN_.gn_w + (size_t)l * RW + ch; const float* gb = IN_.gn_b + (size_t)l * RW + ch;
        float o[8];
#pragma unroll
        for (int j = 0; j < 8; ++j) { const float v = lo[j] * cw[ch + j] + cen[j] * cw[3 * RW + ch + j] + hi[j] * cw[6 * RW + ch + j];
            o[j] = (y[j] * rstd * gw[j] + gb[j] + bsum * v) * g8[j]; }
        *(u32x4*)(MIX + (size_t)row * D + ch) = pack8(o); }
}

constexpr int PH_P0 = 0, PH_P0B = 1, PH_L0 = 2, PH_PER_LAYER = 11, PH_FINAL = PH_L0 + PH_PER_LAYER * DEPTH, NPHASES = PH_FINAL + 1;
#define IN(k) (lo <= (k) && (k) < hi)
#define PHASE_BEGIN() const CAS Args* AP = kargs; OPAQUE_S(AP); do { F.ws = AP->ws; F.out = AP->out; F.wave = wave_id; OPAQUE_S(F.wave); F.lane = LANE_ID(); OPAQUE_V(F.lane); F.tid = F.wave * 64 + F.lane; } while (0)
#ifdef EMU
#define SEAM(k) do { if (IN(k) && IN((k) + 1)) xcd_barrier(bar); } while (0)
#else
#define SEAM(k) do { if (IN(k) && IN((k) + 1)) { XcdBarrier bb_ = bar; { const CAS Args* ap_ = kargs; OPAQUE_S(ap_); bb_.bar = (unsigned*)(ap_->ws + WS_CTL) + CW_BAR; } OPAQUE_S(bb_.bar); xcd_barrier(bb_); } } while (0)
#endif
template <int l> DI void run_layer(Frame F, const CAS Args* const kargs, const int lo, const int hi, const XcdBarrier bar, const int wave_id) {

        const int pb = PH_L0 + PH_PER_LAYER * l; const bool last = (l == DEPTH - 1);
        const int npm = last ? NPM_L : NPM;
        if (IN(pb + 0)) { PHASE_BEGIN(); phase_norm(F, AP->in, l, false, MR); }
        SEAM(pb + 0);
        if (IN(pb + 1)) { PHASE_BEGIN(); pg8::Gemm g{(const bf16_t*)(F.ws + WS_XN), wl_ptr(F, l, WL_WIN), D, D, D, 0}; pg8::StaticOrder S; S.init(NPM, INWP / 256, F.G, (int)blockIdx.x);
            EpiU E{(bf16_t*)(F.ws + WS_U), INWP, 1}; pg8::gemm_phase<EpiU, pg8::StaticOrder, true, true>(F.lds, g, S, E, F.tid); }
        SEAM(pb + 1);
        if (IN(pb + 2)) { PHASE_BEGIN(); ScanItem it; for (int i = F.vcu; scan_item_of(i, false, false, it); i += F.G) scan_item<false>(F, AP->in, l, it);
            phase_poolv(F, F.vcu * 512 + F.tid, F.G * 512); }
        SEAM(pb + 2);
        if (IN(pb + 3)) { PHASE_BEGIN(); phase_chain(F); phase_poolh(F, F.vcu * 512 + F.tid, F.G * 512); }
        SEAM(pb + 3);
        if (IN(pb + 4)) { PHASE_BEGIN(); ScanItem it; for (int i = F.vcu; scan_item_of(i, true, last, it); i += F.G) scan_item<true>(F, AP->in, l, it); }
        SEAM(pb + 4);
        if (IN(pb + 5)) { PHASE_BEGIN();
            { pg8::Gemm g{(const bf16_t*)(F.ws + WS_U) + OFF_G, wl_ptr(F, l, WL_GUP), INWP, GL, GL, 0}; pg8::StaticOrder S; S.init(npm, RW / 256, F.G, (int)blockIdx.x);
              EpiU E{(bf16_t*)(F.ws + WS_G), RW, 0}; pg8::gemm_phase<EpiU, pg8::StaticOrder, true, true>(F.lds, g, S, E, F.tid); }
            { pg8::Gemm g{(const bf16_t*)(F.ws + WS_PD), wl_ptr(F, l, WL_POOL), PWD, PG, PG, 256}; pg8::StaticOrder S; S.init(npm, 4, F.G, (int)blockIdx.x);
              EpiPool E{(bf16_t*)(F.ws + WS_MIX), AP->in.pool_scale + (size_t)l * PWD}; pg8::gemm_phase<EpiPool, pg8::StaticOrder, true, true>(F.lds, g, S, E, F.tid); }
        }
        SEAM(pb + 5);
        if (IN(pb + 6)) { PHASE_BEGIN(); phase_finish(F, AP->in, l, npm * 256); }
        SEAM(pb + 6);
        if (IN(pb + 7)) { PHASE_BEGIN(); pg8::Gemm g{(const bf16_t*)(F.ws + WS_MIX), wl_ptr(F, l, WL_WOUT), D, D, D, 0}; pg8::StaticOrder S; S.init(npm, D / 256, F.G, (int)blockIdx.x);
            const float* bl = l == 0 ? AP->in.x : (const float*)F.out; const float* bc = l == 0 ? AP->in.ctx : (const float*)(F.ws + WS_CTXH);
            EpiRes E{bl, F.out, (long long)((const char*)bc - (const char*)bl), (long long)((const char*)(F.ws + WS_CTXH) - (const char*)F.out), mod_ptr(F, l, 0, 2)};
            pg8::gemm_phase<EpiRes, pg8::StaticOrder, true, true>(F.lds, g, S, E, F.tid); }
        SEAM(pb + 7);
        if (IN(pb + 8)) { PHASE_BEGIN(); phase_norm(F, AP->in, l, true, npm * 256); }
        SEAM(pb + 8);
        if (IN(pb + 9)) { PHASE_BEGIN(); pg8::Gemm g{(const bf16_t*)(F.ws + WS_XN), wl_ptr(F, l, WL_WGU), D, D, D, 0}; pg8::StaticOrder S; S.init(npm, 2 * DFF / 256, F.G, (int)blockIdx.x);
            EpiSwiglu E{(bf16_t*)(F.ws + WS_H)}; pg8::gemm_phase<EpiSwiglu, pg8::StaticOrder, true, true>(F.lds, g, S, E, F.tid); }
        SEAM(pb + 9);
        if (IN(pb + 10)) { PHASE_BEGIN(); pg8::Gemm g{(const bf16_t*)(F.ws + WS_H), wl_ptr(F, l, WL_WDN), DFF, DFF, DFF, 0}; pg8::StaticOrder S; S.init(npm, D / 256, F.G, (int)blockIdx.x);
            const long long dc = (long long)((const char*)(F.ws + WS_CTXH) - (const char*)F.out);
            EpiRes E{F.out, F.out, dc, dc, mod_ptr(F, l, 0, 5)};
            pg8::gemm_phase<EpiRes, pg8::StaticOrder, true, true>(F.lds, g, S, E, F.tid); }
        SEAM(pb + 10);
    }
__global__ void __launch_bounds__(512, 2) fwd_kernel(Args args) {
#ifdef EMU
    unsigned char* lds = emu_blk->lds;
#else
    extern __shared__ __attribute__((aligned(16))) unsigned char lds[];
#endif
    Frame F;
    F.lds = (LAS unsigned char*)lds;
    F.tid = threadIdx.x; F.lane = F.tid & 63; F.wave = RFL(F.tid >> 6);
    const int wave_id = F.wave;
    F.G = gridDim.x; { const int bx = blockIdx.x; F.vcu = (F.G % 8 == 0) ? (bx % 8) * (F.G / 8) + bx / 8 : bx; }
#ifdef EMU
    const Args* const kargs = &args;
#else
    const CAS Args* const kargs = (const CAS Args*)__builtin_amdgcn_kernarg_segment_ptr();
#endif
    F.out = kargs->out; F.ws = kargs->ws;
    const int lo = args.ph_lo, hi = args.ph_hi;
#ifndef EMU
    volatile LAS unsigned* MISC = (volatile LAS unsigned*)(F.lds + MISC_OFF);
    if (F.tid < 64) MISC[F.tid] = 0u;
    __syncthreads();
    XcdBarrier bar; bar.bar = (unsigned*)(F.ws + WS_CTL) + CW_BAR; bar.x = 0; bar.st = nullptr;
    if (hi - lo > 1) bar = xcd_barrier_post((unsigned*)(F.ws + WS_CTL) + CW_BAR, MISC + 8);
#else
    XcdBarrier bar; bar.bar = nullptr;
#endif
    if (IN(PH_P0)) { PHASE_BEGIN(); phase_p0(F, AP->in); }
    SEAM(PH_P0);
    if (IN(PH_P0B)) { PHASE_BEGIN(); phase_p0b(F, AP->in); }
    SEAM(PH_P0B);
    run_layer<0>(F, kargs, lo, hi, bar, wave_id);
    if constexpr (DEPTH > 1) run_layer<1>(F, kargs, lo, hi, bar, wave_id);
    if constexpr (DEPTH > 2) run_layer<2>(F, kargs, lo, hi, bar, wave_id);
    if constexpr (DEPTH > 3) run_layer<3>(F, kargs, lo, hi, bar, wave_id);
    static_assert(DEPTH <= 4, "layers");
    if (IN(PH_FINAL)) { PHASE_BEGIN(); phase_final_norm(F, AP->in); }
#undef IN
#undef SEAM
}

extern "C" void kernel_launch(void* const* d_in, const int* in_sizes, int n_in, void* d_out, int out_size, void* d_ws, size_t ws_size, hipStream_t stream) {
    static int grid = 0;
    if (grid == 0) {
        if (n_in != 27 || in_sizes[0] != ML * D || out_size != ML * D || ws_size < WS_END) {
            fprintf(stderr, "kernel_launch: shape/workspace mismatch: n_in %d in0 %d out %d ws %zu (need %zu)\n", n_in, n_in > 0 ? in_sizes[0] : -1, out_size, ws_size, (size_t)WS_END); grid = -1; return; }
        int dev = 0, cus = 0, per_cu = 0;
        if (hipGetDevice(&dev) != hipSuccess || hipDeviceGetAttribute(&cus, hipDeviceAttributeMultiprocessorCount, dev) != hipSuccess) { grid = -1; return; }
        if (hipFuncSetAttribute((const void*)fwd_kernel, hipFuncAttributeMaxDynamicSharedMemorySize, LDS_BYTES) != hipSuccess) { fprintf(stderr, "kernel_launch: hipFuncSetAttribute failed\n"); grid = -1; return; }
        if (hipOccupancyMaxActiveBlocksPerMultiprocessor(&per_cu, (const void*)fwd_kernel, 512, LDS_BYTES) != hipSuccess || per_cu < 1) fprintf(stderr, "kernel_launch: occupancy query reports %d\n", per_cu);
        (void)hipGetLastError();
        grid = cus;
    }
    if (grid < 0) return;
    (void)hipMemsetAsync((char*)d_ws + WS_CTL, 0, CTL_BYTES, stream);
    Args a{};
    const float** ip = (const float**)&a.in;
    for (int i = 0; i < 27; ++i) ip[i] = (const float*)d_in[i];
    a.out = (float*)d_out; a.ws = (unsigned char*)d_ws;
#if MK_ONE_LAUNCH
    a.ph_lo = 0; a.ph_hi = NPHASES;
    hipLaunchKernelGGL(fwd_kernel, dim3(grid), dim3(512), LDS_BYTES, stream, a);
#else
    for (int ph = 0; ph < NPHASES; ++ph) {
#ifdef EMU
        extern int emu_stop_phase; if (emu_stop_phase >= 0 && ph >= emu_stop_phase) break; fprintf(stderr, "phase %d\n", ph);
#endif
        a.ph_lo = ph; a.ph_hi = ph + 1; hipLaunchKernelGGL(fwd_kernel, dim3(grid), dim3(512), LDS_BYTES, stream, a); }
#endif
}
```

```cpp
#ifndef EMU
#include <hip/hip_runtime.h>
#endif
#include <cstdio>
#include <cstdint>
#include <cstddef>

#ifndef CFG_SEQ
#define CFG_SEQ 16384
#endif
#ifndef CFG_CTX
#define CFG_CTX 256
#endif
#ifndef CFG_DEPTH
#define CFG_DEPTH 4
#endif
#ifndef CFG_SEGLEN
#define CFG_SEGLEN 1024
#endif
#ifndef PROBE_MASK
#define PROBE_MASK 0
#endif
#ifndef MK_ONE_LAUNCH
#define MK_ONE_LAUNCH 1
#endif
constexpr int D = 2048, NB = 2, SEQ = CFG_SEQ, DEPTH = CFG_DEPTH, CTX = CFG_CTX, GW = 64, HS = 64, RW = 1024, NH = 16, PWD = 1024;
constexpr int PG = 256, LORA = 96, GL = 256, DFF = 5632;
constexpr int OFF_R = 0, OFF_K = 1024, OFF_V = 2048, OFF_W = 3072, OFF_A = 3168, OFF_G = 3264, OFF_POOL = 3520, INW = 4544, INWP = 4608;
constexpr int ML = NB * SEQ, MC = NB * CTX, MR = ML + MC;
constexpr int SEGLEN = CFG_SEGLEN, NSEGL = SEQ / SEGLEN, NSEG = NSEGL + 1;
constexpr int GROWS = SEQ / GW;
constexpr float RMS_EPS = 1e-6f, GN_EPS = 64e-5f;
static_assert(ML % 256 == 0 && MR % 256 == 0 && SEQ % 256 == 0 && SEGLEN % 64 == 0 && CTX % 64 == 0 && SEQ % SEGLEN == 0, "shape");
constexpr int NPM = MR / 256, NPM_L = ML / 256;

typedef unsigned short bf16_t;
typedef short bf16x8 __attribute__((ext_vector_type(8)));
typedef short bf16x4 __attribute__((ext_vector_type(4)));
typedef float f32x4 __attribute__((ext_vector_type(4)));
typedef float f32x2 __attribute__((ext_vector_type(2)));
typedef unsigned u32x4 __attribute__((ext_vector_type(4)));
typedef unsigned u32x2 __attribute__((ext_vector_type(2)));
#define DI __device__ __forceinline__
#ifdef EMU
#define LAS
#define GAS
#define CAS
#define MFMA16(a, b, c) emu_mfma16((a), (b), (c))
#define MFMA16K16(a, b, c) emu_mfma16k16((a), (b), (c))
#define RFL(x) (x)
#define LDS_WAIT() emu_wave_sync()
#define VM_WAIT() do {} while (0)
#define WG_BAR() __syncthreads()
#define CFENCE() do {} while (0)
#define OPAQUE_S(x) do {} while (0)
#define OPAQUE_V(x) do {} while (0)
#define LANE_ID() ((int)(threadIdx.x & 63))
static inline float fexp(float x) { return expf(x); }
static inline float frcp(float x) { return 1.0f / x; }
static inline float frsq(float x) { return 1.0f / sqrtf(x); }
#else
#define LAS __attribute__((address_space(3)))
#define GAS __attribute__((address_space(1)))
#define CAS __attribute__((address_space(4)))
#define MFMA16(a, b, c) __builtin_amdgcn_mfma_f32_16x16x32_bf16((a), (b), (c), 0, 0, 0)
#define MFMA16K16(a, b, c) __builtin_amdgcn_mfma_f32_16x16x16bf16_1k((a), (b), (c), 0, 0, 0)
#define RFL(x) __builtin_amdgcn_readfirstlane(x)
#define LDS_WAIT() asm volatile("s_waitcnt lgkmcnt(0)" ::: "memory")
#define VM_WAIT() asm volatile("s_waitcnt vmcnt(0)" ::: "memory")
#define WG_BAR() __syncthreads()
#define CFENCE() asm volatile("" ::: "memory")
#define OPAQUE_S(x) asm volatile("" : "+s"(x))
#define OPAQUE_V(x) asm volatile("" : "+v"(x))
DI int lane_id_volatile() { int l; asm volatile("v_mbcnt_lo_u32_b32 %0, -1, 0\n\tv_mbcnt_hi_u32_b32 %0, -1, %0" : "=v"(l)); return l; }
#define LANE_ID() lane_id_volatile()
DI float fexp(float x) { return __expf(x); }
DI float frcp(float x) { return __builtin_amdgcn_rcpf(x); }
DI float frsq(float x) { return __builtin_amdgcn_rsqf(x); }
#endif
DI unsigned f2bf(float f) { unsigned u = __builtin_bit_cast(unsigned, f); return (u + 0x7fffu + ((u >> 16) & 1u)) >> 16; }
DI unsigned pk2(float lo, float hi) { return f2bf(lo) | (f2bf(hi) << 16); }
DI float bf2f(unsigned h) { return __builtin_bit_cast(float, h << 16); }
DI float bflo(unsigned w) { return __builtin_bit_cast(float, w << 16); }
DI float bfhi(unsigned w) { return __builtin_bit_cast(float, w & 0xffff0000u); }
DI float fsigmoid(float x) { return frcp(1.0f + fexp(-x)); }
DI float ftanh(float x) { return 1.0f - 2.0f * frcp(fexp(2.0f * x) + 1.0f); }
DI float fsilu(float x) { return x * fsigmoid(x); }
DI void unpack8(const u32x4& w, float (&f)[8]) { f[0] = bflo(w.x); f[1] = bfhi(w.x); f[2] = bflo(w.y); f[3] = bfhi(w.y); f[4] = bflo(w.z); f[5] = bfhi(w.z); f[6] = bflo(w.w); f[7] = bfhi(w.w); }
DI u32x4 pack8(const float (&f)[8]) { u32x4 w; w.x = pk2(f[0], f[1]); w.y = pk2(f[2], f[3]); w.z = pk2(f[4], f[5]); w.w = pk2(f[6], f[7]); return w; }
DI void unpack4(const u32x2& w, float (&f)[4]) { f[0] = bflo(w.x); f[1] = bfhi(w.x); f[2] = bflo(w.y); f[3] = bfhi(w.y); }
DI u32x2 pack4(const float (&f)[4]) { u32x2 w; w.x = pk2(f[0], f[1]); w.y = pk2(f[2], f[3]); return w; }
DI float wave_sum(float v) {
#pragma unroll
    for (int o = 1; o < 64; o <<= 1) v += __shfl_xor(v, o);
    return v;
}

namespace pg8 {
constexpr int BM = 256, BK = 64, HALF = 128, HTB = HALF * BK * 2, STAGE_BYTES = 8 * HTB, NXCD = 8, WGM = 8;
__host__ __device__ __forceinline__ int lds_byte(int r, int c) { const int st = (r >> 4) * 2 + (c >> 5), rr = r & 15, cc = c & 31, ob = rr * 64 + cc * 2; return st * 1024 + (ob ^ (((ob >> 9) & 1) << 5)); }
__host__ __device__ __forceinline__ void stage_rc(int b, int& R, int& C) { const int st = b / 1024, sb = b % 1024, swz = sb ^ (((sb >> 9) & 1) << 5); R = (st >> 1) * 16 + swz / 64; C = (st & 1) * 32 + (swz % 64) / 2; }
__host__ __device__ __forceinline__ int perm32(int rho) { const int n = rho >> 4, i = rho & 15; return 8 * (i >> 2) + 4 * n + (i & 3); }
struct Unit { int pm, pn; };
struct Gemm { const bf16_t* A; const bf16_t* Bt; int lda, ldb, K, a_col_pn; };
struct StaticOrder {
    int nM, nN, nwg, G, c;
    __host__ __device__ void init(int nM_, int nN_, int G_, int c_) { nM = nM_; nN = nN_; nwg = nM * nN; G = G_; c = c_; }
    __host__ __device__ bool next(int i, Unit& u) const {
        const long L = (long)i * G + c; if (L >= nwg) return false;
        int wgid = (int)L; { const int q = nwg / NXCD, r = nwg % NXCD, xcd = wgid % NXCD, off = wgid / NXCD; wgid = (xcd < r ? xcd * (q + 1) : r * (q + 1) + (xcd - r) * q) + off; }
        const int nig = WGM * nN, gid = wgid / nig, fm = gid * WGM, gsz = (nM - fm) < WGM ? (nM - fm) : WGM;
        u.pm = fm + ((wgid % nig) % gsz); u.pn = (wgid % nig) / gsz; return true;
    }
};
#ifndef EMU
#define PG8_LAS __attribute__((address_space(3)))
template <class Epi, class Sched, bool ALIGN_EPI = false, bool SP2 = false>
__device__ __forceinline__ void gemm_phase(PG8_LAS unsigned char* lds, const Gemm g, const Sched& S, const Epi& E, const int tid_) {
    const int tid = tid_, wid = __builtin_amdgcn_readfirstlane(tid >> 6), lane = tid & 63, wr = wid >> 2, wc = wid & 3, fr = lane & 15, fq = lane >> 4;
    const int K = g.K, nt = K / BK;
    unsigned voffA[2], voffB[2];
#pragma unroll
    for (int i = 0; i < 2; ++i) { int R, C; stage_rc(tid * 16 + i * 8192, R, C); const int Rb = Epi::PERM ? ((R & ~31) + perm32(R & 31)) : R;
        voffA[i] = (unsigned)(R * g.lda + C) * 2u; voffB[i] = (unsigned)(Rb * g.ldb + C) * 2u; }
    const size_t kstep = (size_t)(BK * 2);
    const size_t hstepA = (size_t)HALF * g.lda * 2, hstepB = (size_t)HALF * g.ldb * 2;
    const unsigned ldsw = (unsigned)wid * 1024u;
    const int aoff = lds_byte(wr * 64 + fr, fq * 8), boff = lds_byte(wc * 32 + fr, fq * 8);
#define PG8_SA(b, h) (((b) * 2 + (h)) * HTB)
#define PG8_SB(b, h) ((4 + (b) * 2 + (h)) * HTB)
#define PG8_STAGE(bufoff, gbase, voff) do { _Pragma("unroll") for (int _i = 0; _i < 2; ++_i) \
        __builtin_amdgcn_global_load_lds((const unsigned*)((const char*)(gbase) + (voff)[_i]), (PG8_LAS unsigned*)(lds + (bufoff) + ldsw + _i * 8192), 16, 0, 0); } while (0)
#define PG8_LDA(dst, b, h) do { _Pragma("unroll") for (int m = 0; m < 4; ++m) _Pragma("unroll") for (int k = 0; k < 2; ++k) dst[m][k] = *(const PG8_LAS bf16x8*)(lds + PG8_SA(b, h) + aoff + m * 2048 + k * 1024); } while (0)
#define PG8_LDB(dst, b, h) do { _Pragma("unroll") for (int n = 0; n < 2; ++n) _Pragma("unroll") for (int k = 0; k < 2; ++k) dst[n][k] = *(const PG8_LAS bf16x8*)(lds + PG8_SB(b, h) + boff + n * 2048 + k * 1024); } while (0)
#define PG8_MMA(ai, bj, At, Bt) do { __builtin_amdgcn_s_setprio(1); _Pragma("unroll") for (int m = 0; m < 4; ++m) _Pragma("unroll") for (int n = 0; n < 2; ++n) _Pragma("unroll") for (int k = 0; k < 2; ++k) \
        acc[ai][bj][m][n] = __builtin_amdgcn_mfma_f32_16x16x32_bf16(Bt[n][k], At[m][k], acc[ai][bj][m][n], 0, 0, 0); __builtin_amdgcn_s_setprio(0); } while (0)
#define PG8_WAIT_V(n) asm volatile("s_waitcnt vmcnt(" #n ")" ::: "memory")
#define PG8_WAIT_L(n) asm volatile("s_waitcnt lgkmcnt(" #n ")" ::: "memory")
#define PG8_BAR __builtin_amdgcn_s_barrier()
#define PG8_SCHED __builtin_amdgcn_sched_barrier(0)
#define PG8_APTR(u) ((const char*)g.A + ((size_t)(u).pm * BM * g.lda + (size_t)(u).pn * g.a_col_pn) * 2)
#define PG8_BPTR(u) ((const char*)g.Bt + (size_t)(u).pn * BM * g.ldb * 2)
    Unit cur, nxt; int ui = 0;
    if (!S.next(0, cur)) return;
    f32x4 acc[2][2][4][2];
#pragma unroll
    for (int a = 0; a < 2; ++a)
#pragma unroll
        for (int b = 0; b < 2; ++b)
#pragma unroll
            for (int m = 0; m < 4; ++m)
#pragma unroll
                for (int n = 0; n < 2; ++n) acc[a][b][m][n] = (f32x4){0.f, 0.f, 0.f, 0.f};
    bf16x8 At[4][2], B0[2][2], B1[2][2];
    const char* cA = PG8_APTR(cur); const char* cB = PG8_BPTR(cur);
    if constexpr (SP2) {
        PG8_STAGE(PG8_SB(0, 0), cB, voffB); PG8_STAGE(PG8_SB(0, 1), cB + hstepB, voffB); PG8_STAGE(PG8_SA(0, 0), cA, voffA); PG8_STAGE(PG8_SA(0, 1), cA + hstepA, voffA);
        if (wr == 1) PG8_BAR;
        PG8_WAIT_V(2); PG8_BAR;
        PG8_STAGE(PG8_SB(1, 0), cB + kstep, voffB); PG8_STAGE(PG8_SA(1, 0), cA + kstep, voffA); PG8_STAGE(PG8_SB(1, 1), cB + hstepB + kstep, voffB);
        PG8_WAIT_V(6); PG8_BAR;
    } else {
        PG8_STAGE(PG8_SB(0, 0), cB, voffB); PG8_STAGE(PG8_SA(0, 0), cA, voffA); PG8_STAGE(PG8_SB(0, 1), cB + hstepB, voffB); PG8_STAGE(PG8_SA(0, 1), cA + hstepA, voffA);
        if (wr == 1) PG8_BAR;
        PG8_WAIT_V(4); PG8_BAR;
        PG8_STAGE(PG8_SB(1, 0), cB + kstep, voffB); PG8_STAGE(PG8_SA(1, 0), cA + kstep, voffA); PG8_STAGE(PG8_SB(1, 1), cB + hstepB + kstep, voffB);
        PG8_WAIT_V(6); PG8_BAR;
    }
    for (;;) {
        const bool has_next = S.next(ui + 1, nxt);
        const char* nA = has_next ? PG8_APTR(nxt) : cA; const char* nB = has_next ? PG8_BPTR(nxt) : cB;
#pragma unroll 1
        for (int t = 0; t < nt; t += 2) {
            const bool last = (t == nt - 2);
            const char* a1 = cA + (size_t)(t + 1) * kstep;
            const char* a2 = last ? nA : cA + (size_t)(t + 2) * kstep; const char* b2 = last ? nB : cB + (size_t)(t + 2) * kstep;
            const char* a3 = a2 + kstep; const char* b3 = b2 + kstep;
            if constexpr (SP2) {
            PG8_LDB(B0, 0, 0); PG8_LDB(B1, 0, 1); PG8_SCHED; PG8_LDA(At, 0, 0); PG8_STAGE(PG8_SA(1, 1), a1 + hstepA, voffA);
            PG8_WAIT_V(8); PG8_WAIT_L(0); PG8_BAR; PG8_MMA(0, 0, At, B0); PG8_MMA(0, 1, At, B1); PG8_BAR; PG8_SCHED;
            PG8_LDA(At, 0, 1); PG8_STAGE(PG8_SB(0, 0), b2, voffB); PG8_STAGE(PG8_SB(0, 1), b2 + hstepB, voffB); PG8_STAGE(PG8_SA(0, 0), a2, voffA);
            PG8_WAIT_V(8); PG8_WAIT_L(0); PG8_BAR; PG8_MMA(1, 0, At, B0); PG8_MMA(1, 1, At, B1); PG8_BAR; PG8_SCHED;
            PG8_LDB(B0, 1, 0); PG8_LDB(B1, 1, 1); PG8_SCHED; PG8_LDA(At, 1, 0); PG8_STAGE(PG8_SA(0, 1), a2 + hstepA, voffA);
            PG8_WAIT_V(8); PG8_WAIT_L(0); PG8_BAR; PG8_MMA(0, 0, At, B0); PG8_MMA(0, 1, At, B1); PG8_BAR; PG8_SCHED;
            PG8_LDA(At, 1, 1); PG8_STAGE(PG8_SB(1, 0), b3, voffB); PG8_STAGE(PG8_SB(1, 1), b3 + hstepB, voffB); PG8_STAGE(PG8_SA(1, 0), a3, voffA);
            PG8_WAIT_V(8); PG8_WAIT_L(0); PG8_BAR; PG8_MMA(1, 0, At, B0); PG8_MMA(1, 1, At, B1); PG8_BAR; PG8_SCHED;
            } else {
            PG8_LDB(B0, 0, 0); PG8_SCHED; PG8_LDA(At, 0, 0); PG8_STAGE(PG8_SA(1, 1), a1 + hstepA, voffA);
            PG8_WAIT_L(8); PG8_BAR; PG8_WAIT_L(0); PG8_MMA(0, 0, At, B0); PG8_BAR; PG8_SCHED;
            PG8_LDB(B1, 0, 1); PG8_STAGE(PG8_SB(0, 0), b2, voffB);
            PG8_BAR; PG8_WAIT_L(0); PG8_MMA(0, 1, At, B1); PG8_BAR;
            PG8_LDA(At, 0, 1); PG8_STAGE(PG8_SA(0, 0), a2, voffA);
            PG8_BAR; PG8_WAIT_L(0); PG8_MMA(1, 0, At, B0); PG8_BAR; PG8_SCHED;
            PG8_STAGE(PG8_SB(0, 1), b2 + hstepB, voffB);
            PG8_WAIT_V(6); PG8_BAR; PG8_MMA(1, 1, At, B1); PG8_BAR;
            PG8_LDB(B0, 1, 0); PG8_SCHED; PG8_LDA(At, 1, 0); PG8_STAGE(PG8_SA(0, 1), a2 + hstepA, voffA);
            PG8_WAIT_L(8); PG8_BAR; PG8_WAIT_L(0); PG8_MMA(0, 0, At, B0); PG8_BAR; PG8_SCHED;
            PG8_LDB(B1, 1, 1); PG8_STAGE(PG8_SB(1, 0), b3, voffB);
            PG8_BAR; PG8_WAIT_L(0); PG8_MMA(0, 1, At, B1); PG8_BAR;
            PG8_LDA(At, 1, 1); PG8_STAGE(PG8_SA(1, 0), a3, voffA);
            PG8_BAR; PG8_WAIT_L(0); PG8_MMA(1, 0, At, B0); PG8_BAR; PG8_SCHED;
            PG8_STAGE(PG8_SB(1, 1), b3 + hstepB, voffB);
            PG8_WAIT_V(6); PG8_BAR; PG8_MMA(1, 1, At, B1); PG8_BAR;
            }
        }
        if constexpr (ALIGN_EPI) { if (wr == 0) PG8_BAR; }
        E(acc, cur, wr, wc, fr, fq);
        if (!has_next) break;
#pragma unroll
        for (int a = 0; a < 2; ++a)
#pragma unroll
            for (int b = 0; b < 2; ++b)
#pragma unroll
                for (int m = 0; m < 4; ++m)
#pragma unroll
                    for (int n = 0; n < 2; ++n) acc[a][b][m][n] = (f32x4){0.f, 0.f, 0.f, 0.f};
        cur = nxt; cA = nA; cB = nB; ++ui;
        if constexpr (ALIGN_EPI) { if (wr == 1) PG8_BAR; }
    }
    PG8_WAIT_V(0);
    if constexpr (!ALIGN_EPI) { if (wr == 0) PG8_BAR; }
    PG8_BAR;
#undef PG8_SA
#undef PG8_SB
#undef PG8_STAGE
#undef PG8_LDA
#undef PG8_LDB
#undef PG8_MMA
#undef PG8_WAIT_V
#undef PG8_WAIT_L
#undef PG8_BAR
#undef PG8_SCHED
#undef PG8_APTR
#undef PG8_BPTR
}
#else
static thread_local float* emu_tile = nullptr;
template <class Epi, class Sched, bool ALIGN_EPI = false, bool SP2 = false>
static void gemm_phase(unsigned char* lds, const Gemm g, const Sched& S, const Epi& E, const int tid_) {
    const int tid = tid_, wid = tid >> 6, lane = tid & 63, wr = wid >> 2, wc = wid & 3, fr = lane & 15, fq = lane >> 4;
    if (!emu_tile) emu_tile = (float*)malloc(256 * 256 * 4);
    Unit u;
    for (int i = 0; S.next(i, u); ++i) {
        const bf16_t* A = g.A + (size_t)u.pm * BM * g.lda + (size_t)u.pn * g.a_col_pn; const bf16_t* Bt = g.Bt + (size_t)u.pn * BM * g.ldb;
        { const int r = tid >> 1, c0 = (tid & 1) * 128; std::vector<float> ar(g.K); for (int k = 0; k < g.K; ++k) ar[k] = bf2f(A[(size_t)r * g.lda + k]);
          for (int c = c0; c < c0 + 128; ++c) { const bf16_t* br = Bt + (size_t)c * g.ldb; float s0 = 0, s1 = 0, s2 = 0, s3 = 0; for (int k = 0; k < g.K; k += 4) { s0 += ar[k] * bf2f(br[k]); s1 += ar[k + 1] * bf2f(br[k + 1]); s2 += ar[k + 2] * bf2f(br[k + 2]); s3 += ar[k + 3] * bf2f(br[k + 3]); } emu_tile[r * 256 + c] = (s0 + s1) + (s2 + s3); } }
        __syncthreads();
        f32x4 acc[2][2][4][2];
        for (int ai = 0; ai < 2; ++ai) for (int bj = 0; bj < 2; ++bj) for (int m = 0; m < 4; ++m) for (int n = 0; n < 2; ++n) for (int e = 0; e < 4; ++e) {
            const int r = 128 * ai + 64 * wr + 16 * m + fr; const int c = Epi::PERM ? (128 * bj + 32 * wc + 8 * fq + 4 * n + e) : (128 * bj + 32 * wc + 16 * n + 4 * fq + e);
            acc[ai][bj][m][n][e] = emu_tile[r * 256 + c]; }
        E(acc, u, wr, wc, fr, fq);
        __syncthreads();
    }
}
#endif
}

constexpr size_t al256(size_t x) { return (x + 255) & ~(size_t)255; }
constexpr size_t WS_CTL = 0, CTL_BYTES = 1u << 20;
constexpr size_t WS_MOD = WS_CTL + CTL_BYTES;
constexpr size_t SZ_MOD = al256((size_t)DEPTH * 3 * 6 * D * 4);
constexpr int ADA_KC = 16;
constexpr size_t WS_ADAP = WS_MOD + SZ_MOD;
constexpr size_t SZ_ADAP = al256((size_t)DEPTH * ADA_KC * 3 * 6 * D * 4);
constexpr size_t WL_WIN = 0, WL_WOUT = WL_WIN + (size_t)INWP * D * 2, WL_WGU = WL_WOUT + (size_t)D * D * 2, WL_WDN = WL_WGU + (size_t)2 * DFF * D * 2,
                 WL_GUP = WL_WDN + (size_t)D * DFF * 2, WL_POOL = WL_GUP + (size_t)RW * GL * 2, WL_DUP = WL_POOL + (size_t)4 * PG * PG * 2,
                 WL_IUP = WL_DUP + (size_t)2 * RW * LORA * 2, WL_SIZE = al256(WL_IUP + (size_t)2 * RW * LORA * 2);
constexpr size_t WS_W = WS_ADAP + SZ_ADAP;
constexpr size_t WS_XN = WS_W + WL_SIZE * DEPTH;
constexpr size_t WS_MIX = WS_XN + (size_t)MR * D * 2;
constexpr size_t WS_CTXH = WS_MIX + (size_t)MR * D * 2;
constexpr size_t WS_SSEG = WS_CTXH + (size_t)MC * D * 4;
constexpr size_t SZ_ST = (size_t)NB * NH * 2 * NSEG * 4096 * 4;
constexpr size_t WS_PSEG = WS_SSEG + SZ_ST, WS_HIN = WS_PSEG + SZ_ST;
constexpr size_t WS_BS = WS_HIN + SZ_ST;
constexpr size_t WS_BIG = al256(WS_BS + (size_t)2 * MR * NH * 4);
constexpr size_t WS_U = WS_BIG;
constexpr size_t WS_YF = WS_U + (size_t)MR * INWP * 2;
constexpr size_t WS_G = WS_YF + (size_t)2 * MR * RW * 4;
constexpr size_t WS_PD = WS_G + (size_t)MR * RW * 2;
constexpr size_t WS_VS = WS_PD + (size_t)MR * PWD * 2;
constexpr size_t WS_BIG_END1 = WS_VS + (size_t)ML * PWD * 2;
constexpr size_t WS_H = WS_BIG;
constexpr size_t WS_BIG_END2 = WS_H + (size_t)MR * DFF * 2;
constexpr size_t WS_END = WS_BIG_END1 > WS_BIG_END2 ? WS_BIG_END1 : WS_BIG_END2;
constexpr int CW_BAR = 4096;

constexpr int IMG = 8192;
constexpr int M_RT = 0, M_AT = 1, M_KB = 2, M_BB = 3, M_KT = 4, M_BT = 5, M_VT = 6, M_AAK = 7, M_AAB = 8, M_ARK = 9, M_ARB = 10, N_IMG = 11;
constexpr int SCR_G = N_IMG * IMG, SCR_AI = SCR_G + 64 * 68 * 4;
constexpr int SC_DIAG = SCR_AI + 64 * 68 * 4;
constexpr int SC_GC = SC_DIAG + 4096;
constexpr int SC_DM = SC_GC + 256;
constexpr int MISC_OFF = (SC_DM + 8 * 2048) > 131072 ? (SC_DM + 8 * 2048) : 131072;
constexpr int LDS_BYTES = MISC_OFF + 256;
static_assert(LDS_BYTES <= 160 * 1024 && pg8::STAGE_BYTES <= MISC_OFF, "LDS");

#define XB_TMO      128
#define XB_XCNT(j)  (256  + 64 * (j))
#define XB_XSUB(j)  (1280 + 64 * (j))
#define XB_XGEN(j)  (2304 + 64 * (j))
#define XB_TOP      3328
#define XB_TOPGEN   3392
#define XCD_BAR_WORDS 3456
#define XB_SPIN_CAP (1u << 18)
#ifndef EMU
__device__ __forceinline__ unsigned xb_ld(unsigned* p)              { return __hip_atomic_load(p, __ATOMIC_RELAXED, __HIP_MEMORY_SCOPE_AGENT); }
__device__ __forceinline__ unsigned xb_add(unsigned* p, unsigned v) { return __hip_atomic_fetch_add(p, v, __ATOMIC_RELAXED, __HIP_MEMORY_SCOPE_AGENT); }
__device__ __forceinline__ unsigned xb_xcc_id() { return (unsigned)__builtin_amdgcn_s_getreg((3 << 11) | 20) & 0xFu; }
#define XB_SPIN(cond, bar) do { unsigned _sp = 0; while (cond) { __builtin_amdgcn_s_sleep(1); \
    if ((++_sp & 255u) == 0u) { if (xb_ld(&(bar)[XB_TMO])) break; if (_sp > XB_SPIN_CAP) { atomicAdd(&(bar)[XB_TMO], 1u); break; } } } } while (0)
struct XcdBarrier { unsigned* bar; unsigned x; volatile LAS unsigned* st; };
__device__ __forceinline__ XcdBarrier xcd_barrier_post(unsigned* bar, volatile LAS unsigned* st) {
    XcdBarrier b; b.bar = bar; b.x = xb_xcc_id(); b.st = st;
    if (threadIdx.x == 0) (void)xb_add(&bar[XB_XCNT(b.x)], 1u);
    return b;
}
__device__ __forceinline__ void xcd_barrier_complete(unsigned* bar, unsigned x, unsigned& nloc, unsigned& nx) {
    const unsigned G = gridDim.x * gridDim.y * gridDim.z;
    unsigned sum, cnt, mine, sp = 0u;
    for (;;) {
        sum = 0u; cnt = 0u; mine = 0u;
#pragma unroll
        for (unsigned j = 0; j < 16; ++j) { const unsigned c = xb_ld(&bar[XB_XCNT(j)]); sum += c; cnt += (c > 0u) ? 1u : 0u; mine = (j == x) ? c : mine; }
        if (sum == G) break;
        __builtin_amdgcn_s_sleep(1);
        if ((++sp & 255u) == 0u) { if (xb_ld(&bar[XB_TMO])) break; if (sp > XB_SPIN_CAP) { atomicAdd(&bar[XB_TMO], 1u); break; } }
    }
    nloc = mine > 0u ? mine : 1u; nx = cnt > 0u ? cnt : 1u;
}
__device__ __forceinline__ void xcd_barrier(const XcdBarrier& b) {
    asm volatile("s_waitcnt vmcnt(0)" ::: "memory");
    __syncthreads();
    if (threadIdx.x == 0) {
        unsigned* bar = b.bar;
        __builtin_amdgcn_s_waitcnt(0);
        unsigned nloc = b.st[0], nx = b.st[1];
        if (nloc == 0u) { xcd_barrier_complete(bar, b.x, nloc, nx); b.st[0] = nloc; b.st[1] = nx; }
        const unsigned old = xb_add(&bar[XB_XSUB(b.x)], 1u);
        const unsigned gen = old / nloc;
        if (old + 1u == (gen + 1u) * nloc) {
            __builtin_amdgcn_fence(__ATOMIC_RELEASE, "agent");
            asm volatile("s_waitcnt vmcnt(0)" ::: "memory");
            const unsigned og = xb_add(&bar[XB_TOP], 1u);
            const unsigned tg = og / nx;
            if (og + 1u == (tg + 1u) * nx) xb_add(&bar[XB_TOPGEN], 1u);
            else XB_SPIN(xb_ld(&bar[XB_TOPGEN]) == tg, bar);
            __builtin_amdgcn_fence(__ATOMIC_ACQUIRE, "agent");
            xb_add(&bar[XB_XGEN(b.x)], 1u);
            asm volatile("s_waitcnt vmcnt(0)" ::: "memory");
        } else {
            XB_SPIN(xb_ld(&bar[XB_XGEN(b.x)]) == gen, bar);
            __builtin_amdgcn_fence(__ATOMIC_ACQUIRE, "agent");
            asm volatile("s_waitcnt vmcnt(0)" ::: "memory");
        }
    }
    __syncthreads();
}
#else
struct XcdBarrier { unsigned* bar; };
static inline void xcd_barrier(const XcdBarrier&) { fprintf(stderr, "EMU: grid barrier not supported (use per-phase launches)\n"); abort(); }
#endif

struct Inputs {
    const float *x, *c, *ctx, *c_ctx, *ada_w, *ada_b, *norm_mix, *norm_ffn, *w_in, *conv_rkv, *decay_bias, *decay_up, *iclr_bias, *iclr_up, *gate_up,
        *k_k, *k_a, *r_k, *gn_w, *gn_b, *pool_w, *pool_scale, *w_out, *ffn_gate, *ffn_up, *ffn_down, *final_norm;
};
struct Args { Inputs in; float* out; unsigned char* ws; int ph_lo, ph_hi; };
struct Frame {
    LAS unsigned char* lds;
    int tid, lane, wave, vcu, G;
    float* out; unsigned char* ws;
};
DI bf16_t* wl_ptr(const Frame& F, int l, size_t off) { return (bf16_t*)(F.ws + WS_W + (size_t)l * WL_SIZE + off); }
DI const float* mod_ptr(const Frame& F, int l, int s, int j) { return (const float*)(F.ws + WS_MOD) + ((size_t)(l * 3 + s) * 6 + j) * D; }
DI int sample_of_row(int row) { return row < ML ? row / SEQ : 2; }

DI void p0_transpose_item(const float* W, int N, bf16_t* WT, int ldo, int dst_row0, LAS float* scr, int k0, int n0, int lane) {
#pragma unroll 8
    for (int i = 0; i < 32; ++i) { const int kk = 2 * i + (lane >> 5); scr[kk * 33 + (lane & 31)] = W[(size_t)(k0 + kk) * N + n0 + (lane & 31)]; }
    LDS_WAIT();
    const int c = lane & 7;
#pragma unroll
    for (int j = 0; j < 4; ++j) { const int n = (lane >> 3) + 8 * j; const LAS float* s = scr + (8 * c) * 33 + n;
        u32x4 o; o.x = pk2(s[0 * 33], s[1 * 33]); o.y = pk2(s[2 * 33], s[3 * 33]); o.z = pk2(s[4 * 33], s[5 * 33]); o.w = pk2(s[6 * 33], s[7 * 33]);
        *(u32x4*)(WT + (size_t)(dst_row0 + n) * ldo + k0 + 8 * c) = o; }
    LDS_WAIT();
}
DI void phase_p0(Frame& F, const CAS Inputs& IN_) {
    LAS float* scr = (LAS float*)(F.lds + F.wave * 16384);
    const int gw = F.vcu * 8 + F.wave, NGW = F.G * 8;
    constexpr int I_WIN = (D / 64) * (INW / 32), I_WOUT = (D / 64) * (D / 32), I_G = (D / 64) * (DFF / 32), I_DN = (DFF / 64) * (D / 32), I_GUP = (GL / 64) * (RW / 32), I_POOL = 4 * (PG / 64) * (PG / 32);
    constexpr int I_LAYER = I_WIN + I_WOUT + 2 * I_G + I_DN + I_GUP + I_POOL;
    for (int it = gw; it < I_LAYER * DEPTH; it += NGW) {
        const int l = it / I_LAYER; int r = it % I_LAYER;
        if (r < I_WIN) { const int nb = INW / 32, kb = r / nb, n0 = 32 * (r % nb); p0_transpose_item(IN_.w_in + (size_t)l * D * INW, INW, wl_ptr(F, l, WL_WIN), D, n0, scr, 64 * kb, n0, F.lane); continue; } r -= I_WIN;
        if (r < I_WOUT) { const int nb = D / 32, kb = r / nb, n0 = 32 * (r % nb); p0_transpose_item(IN_.w_out + (size_t)l * D * D, D, wl_ptr(F, l, WL_WOUT), D, n0, scr, 64 * kb, n0, F.lane); continue; } r -= I_WOUT;
        if (r < 2 * I_G) { const int up = r >= I_G; if (up) r -= I_G; const int nb = DFF / 32, kb = r / nb, n0 = 32 * (r % nb);
            p0_transpose_item((up ? IN_.ffn_up : IN_.ffn_gate) + (size_t)l * D * DFF, DFF, wl_ptr(F, l, WL_WGU), D, (n0 / 128) * 256 + (n0 % 128) + (up ? 128 : 0), scr, 64 * kb, n0, F.lane); continue; } r -= 2 * I_G;
        if (r < I_DN) { const int nb = D / 32, kb = r / nb, n0 = 32 * (r % nb); p0_transpose_item(IN_.ffn_down + (size_t)l * DFF * D, D, wl_ptr(F, l, WL_WDN), DFF, n0, scr, 64 * kb, n0, F.lane); continue; } r -= I_DN;
        if (r < I_GUP) { const int nb = RW / 32, kb = r / nb, n0 = 32 * (r % nb); p0_transpose_item(IN_.gate_up + (size_t)l * GL * RW, RW, wl_ptr(F, l, WL_GUP), GL, n0, scr, 64 * kb, n0, F.lane); continue; } r -= I_GUP;
        { const int gi = r / ((PG / 64) * (PG / 32)); r %= (PG / 64) * (PG / 32); const int nb = PG / 32, kb = r / nb, n0 = 32 * (r % nb);
          p0_transpose_item(IN_.pool_w + ((size_t)l * 4 + gi) * PG * PG, PG, wl_ptr(F, l, WL_POOL) + (size_t)gi * PG * PG, PG, n0, scr, 64 * kb, n0, F.lane); }
    }
    const int gt = F.vcu * 512 + F.tid, NGT = F.G * 512;
    for (int i = gt; i < DEPTH * (INWP - INW) * D / 8; i += NGT) { const int l = i / ((INWP - INW) * D / 8), r = i % ((INWP - INW) * D / 8);
        *(u32x4*)(wl_ptr(F, l, WL_WIN) + (size_t)INW * D + (size_t)r * 8) = (u32x4){0u, 0u, 0u, 0u}; }
    for (int i = gt; i < DEPTH * 2 * 2 * RW * LORA; i += NGT) { int r = i; const int k = r % LORA; r /= LORA; const int n = r % RW; r /= RW; const int d = r % 2; r /= 2; const int which = r % 2; const int l = r / 2;
        const float* src = (which ? IN_.iclr_up : IN_.decay_up) + (((size_t)l * 2 + d) * LORA + k) * RW + n;
        wl_ptr(F, l, which ? WL_IUP : WL_DUP)[((size_t)d * RW + n) * LORA + k] = (bf16_t)f2bf(*src); }
    constexpr int NJB = 6 * D / 256, KCH = D / ADA_KC;
    for (int it = gw; it < DEPTH * NJB * ADA_KC; it += NGW) {
        const int kc = it % ADA_KC, jb = (it / ADA_KC) % NJB, l = it / (ADA_KC * NJB);
        const float* w = IN_.ada_w + ((size_t)l * D + (size_t)kc * KCH) * 6 * D + jb * 256 + 4 * F.lane;
        f32x4 a0 = {0.f, 0.f, 0.f, 0.f}, a1 = a0, a2 = a0;
#pragma unroll 8
        for (int k = 0; k < KCH; ++k) { const int kk = kc * KCH + k; const f32x4 wv = *(const f32x4*)(w + (size_t)k * 6 * D);
            const float c0 = fsilu(IN_.c[kk]), c1 = fsilu(IN_.c[D + kk]), c2 = fsilu(IN_.c_ctx[kk]);
            a0 += wv * c0; a1 += wv * c1; a2 += wv * c2; }
        float* p = (float*)(F.ws + WS_ADAP) + (((size_t)l * ADA_KC + kc) * 3) * 6 * D + jb * 256 + 4 * F.lane;
        *(f32x4*)(p) = a0; *(f32x4*)(p + 6 * D) = a1; *(f32x4*)(p + 12 * D) = a2;
    }
}
DI void phase_p0b(Frame& F, const CAS Inputs& IN_) {
    const int gt = F.vcu * 512 + F.tid, NGT = F.G * 512;
    for (int i = gt; i < DEPTH * 3 * 6 * D; i += NGT) { const int j = i % (6 * D), s = (i / (6 * D)) % 3, l = i / (18 * D);
        float a = IN_.ada_b[(size_t)l * 6 * D + j];
        for (int kc = 0; kc < ADA_KC; ++kc) a += ((const float*)(F.ws + WS_ADAP))[(((size_t)l * ADA_KC + kc) * 3 + s) * 6 * D + j];
        ((float*)(F.ws + WS_MOD))[i] = a; }
}

DI void phase_norm(Frame& F, const CAS Inputs& IN_, int l, bool second, int nrows) {
    const int gw = F.vcu * 8 + F.wave, NGW = F.G * 8;
    const float* gvec = (second ? IN_.norm_ffn : IN_.norm_mix) + (size_t)l * D;
    bf16_t* XN = (bf16_t*)(F.ws + WS_XN);
    for (int row = gw; row < nrows; row += NGW) {
        const float* xr;
        if (row < ML) xr = ((l == 0 && !second) ? IN_.x : F.out) + (size_t)row * D;
        else xr = ((l == 0 && !second) ? IN_.ctx : (const float*)(F.ws + WS_CTXH)) + (size_t)(row - ML) * D;
        const int s = sample_of_row(row);
        const float* sh = mod_ptr(F, l, s, second ? 3 : 0); const float* sc = mod_ptr(F, l, s, second ? 4 : 1);
        f32x4 v[8]; float ss = 0.f;
#pragma unroll
        for (int j = 0; j < 8; ++j) { v[j] = *(const f32x4*)(xr + 4 * (F.lane + 64 * j)); ss += (v[j].x * v[j].x + v[j].y * v[j].y) + (v[j].z * v[j].z + v[j].w * v[j].w); }
        const float rs = frsq(wave_sum(ss) * (1.f / D) + RMS_EPS);
#pragma unroll
        for (int j = 0; j < 8; ++j) { const int c = 4 * (F.lane + 64 * j); const f32x4 g = *(const f32x4*)(gvec + c), a = *(const f32x4*)(sc + c), b = *(const f32x4*)(sh + c);
            const f32x4 o = v[j] * rs * g * (a + 1.0f) + b; u32x2 w; w.x = pk2(o.x, o.y); w.y = pk2(o.z, o.w); *(u32x2*)(XN + (size_t)row * D + c) = w; }
    }
}
DI void phase_final_norm(Frame& F, const CAS Inputs& IN_) {
    const int gw = F.vcu * 8 + F.wave, NGW = F.G * 8;
    for (int row = gw; row < ML; row += NGW) {
        float* xr = F.out + (size_t)row * D; f32x4 v[8]; float ss = 0.f;
#pragma unroll
        for (int j = 0; j < 8; ++j) { v[j] = *(const f32x4*)(xr + 4 * (F.lane + 64 * j)); ss += (v[j].x * v[j].x + v[j].y * v[j].y) + (v[j].z * v[j].z + v[j].w * v[j].w); }
        const float rs = frsq(wave_sum(ss) * (1.f / D) + RMS_EPS);
#pragma unroll
        for (int j = 0; j < 8; ++j) { const int c = 4 * (F.lane + 64 * j); *(f32x4*)(xr + c) = v[j] * rs * *(const f32x4*)(IN_.final_norm + c); }
    }
}

struct EpiU {
    static constexpr bool PERM = true;
    bf16_t* O; int ldc; int act;
    DI void operator()(const f32x4 (&acc)[2][2][4][2], const pg8::Unit& u, int wr, int wc, int fr, int fq) const {
        const int row0 = u.pm * 256 + wr * 64 + fr, col0 = u.pn * 256 + wc * 32 + 8 * fq;
        const bool special = act && (col0 + 128 + 8 > OFF_W) && (col0 < OFF_POOL);
#pragma unroll
        for (int ai = 0; ai < 2; ++ai)
#pragma unroll
            for (int m = 0; m < 4; ++m) { bf16_t* rowp = O + (size_t)(row0 + ai * 128 + m * 16) * ldc + col0;
#pragma unroll
                for (int bj = 0; bj < 2; ++bj) { f32x4 v0 = acc[ai][bj][m][0], v1 = acc[ai][bj][m][1];
                    if (special) { const int c = col0 + bj * 128;
                        if (c >= OFF_W && c < OFF_A) {
#pragma unroll
                            for (int e = 0; e < 4; ++e) { v0[e] = ftanh(v0[e]); v1[e] = ftanh(v1[e]); } }
                        else if (c >= OFF_G && c < OFF_POOL) {
#pragma unroll
                            for (int e = 0; e < 4; ++e) { v0[e] = fsigmoid(v0[e]); v1[e] = fsigmoid(v1[e]); } } }
                    u32x4 w; w.x = pk2(v0[0], v0[1]); w.y = pk2(v0[2], v0[3]); w.z = pk2(v1[0], v1[1]); w.w = pk2(v1[2], v1[3]);
                    *(u32x4*)(rowp + bj * 128) = w; } }
    }
};
struct EpiPool {
    static constexpr bool PERM = true;
    bf16_t* O; const float* scale;
    DI void operator()(const f32x4 (&acc)[2][2][4][2], const pg8::Unit& u, int wr, int wc, int fr, int fq) const {
        const int row0 = u.pm * 256 + wr * 64 + fr, col0 = u.pn * 256 + wc * 32 + 8 * fq;
#pragma unroll
        for (int bj = 0; bj < 2; ++bj) { const f32x4 s0 = *(const f32x4*)(scale + col0 + bj * 128), s1 = *(const f32x4*)(scale + col0 + bj * 128 + 4);
#pragma unroll
            for (int ai = 0; ai < 2; ++ai)
#pragma unroll
                for (int m = 0; m < 4; ++m) { bf16_t* rowp = O + (size_t)(row0 + ai * 128 + m * 16) * D + RW + col0;
                    const f32x4 v0 = acc[ai][bj][m][0] * s0, v1 = acc[ai][bj][m][1] * s1;
                    u32x4 w; w.x = pk2(v0[0], v0[1]); w.y = pk2(v0[2], v0[3]); w.z = pk2(v1[0], v1[1]); w.w = pk2(v1[2], v1[3]);
                    *(u32x4*)(rowp + bj * 128) = w; }
            CFENCE(); }
    }
};
struct EpiSwiglu {
    static constexpr bool PERM = true;
    bf16_t* O;
    DI void operator()(const f32x4 (&acc)[2][2][4][2], const pg8::Unit& u, int wr, int wc, int fr, int fq) const {
        const int row0 = u.pm * 256 + wr * 64 + fr, col0 = u.pn * 128 + wc * 32 + 8 * fq;
#pragma unroll
        for (int ai = 0; ai < 2; ++ai)
#pragma unroll
            for (int m = 0; m < 4; ++m) { f32x4 v0, v1;
#pragma unroll
                for (int e = 0; e < 4; ++e) { v0[e] = fsilu(acc[ai][0][m][0][e]) * acc[ai][1][m][0][e]; v1[e] = fsilu(acc[ai][0][m][1][e]) * acc[ai][1][m][1][e]; }
                u32x4 w; w.x = pk2(v0[0], v0[1]); w.y = pk2(v0[2], v0[3]); w.z = pk2(v1[0], v1[1]); w.w = pk2(v1[2], v1[3]);
                *(u32x4*)(O + (size_t)(row0 + ai * 128 + m * 16) * DFF + col0) = w; }
    }
};
struct EpiRes {
    static constexpr bool PERM = false;
    const float* base_l; float* out_l; long long dbase_c, dout_c; const float* gate0;
    DI void operator()(const f32x4 (&acc)[2][2][4][2], const pg8::Unit& u, int wr, int wc, int fr, int fq) const {
        const bool lat = u.pm < NPM_L; const int prow = lat ? u.pm * 256 : (u.pm - NPM_L) * 256;
        const float* base = (const float*)((const char*)base_l + (lat ? 0ll : dbase_c)); float* out = (float*)((char*)out_l + (lat ? 0ll : dout_c));
        const float* gv = gate0 + (size_t)(lat ? (u.pm * 256) / SEQ : 2) * 6 * D;
        const int row0 = prow + wr * 64 + fr, col0 = u.pn * 256 + wc * 32 + 4 * fq;
        f32x4 g4[2][2];
#pragma unroll
        for (int bj = 0; bj < 2; ++bj)
#pragma unroll
            for (int n = 0; n < 2; ++n) g4[bj][n] = *(const f32x4*)(gv + col0 + bj * 128 + n * 16);
#pragma unroll
        for (int ai = 0; ai < 2; ++ai)
#pragma unroll
            for (int m = 0; m < 4; ++m) { const size_t off = (size_t)(row0 + ai * 128 + m * 16) * D + col0;
#pragma unroll
                for (int bj = 0; bj < 2; ++bj)
#pragma unroll
                    for (int n = 0; n < 2; ++n) { const f32x4 b = *(const f32x4*)(base + off + bj * 128 + n * 16); *(f32x4*)(out + off + bj * 128 + n * 16) = b + g4[bj][n] * acc[ai][bj][m][n]; }
                CFENCE(); }
    }
};

DI int img_off(int r, int c) { return r * 128 + ((((c >> 3) ^ (r & 7)) << 4) | ((c & 7) << 1)); }
DI bf16x8 ldfrag(const LAS unsigned char* img, int r0, int k0, int lane) { const int r = r0 + (lane & 15), c = k0 + 8 * (lane >> 4); return *(const LAS bf16x8*)(img + r * 128 + (((c >> 3) ^ (r & 7)) << 4)); }
template <int KK> DI f32x4 tile_mm(f32x4 acc, const LAS unsigned char* X, int x0, const LAS unsigned char* Y, int y0, int lane) {
#pragma unroll
    for (int ks = 0; ks < KK / 32; ++ks) { const bf16x8 xf = ldfrag(X, x0, 32 * ks, lane), yf = ldfrag(Y, y0, 32 * ks, lane); acc = MFMA16(xf, yf, acc); }
    return acc;
}
DI void st_tile(LAS unsigned char* img, int yrow, int xcol, const f32x4& v) { u32x2 w; w.x = pk2(v[0], v[1]); w.y = pk2(v[2], v[3]); *(LAS u32x2*)(img + img_off(yrow, xcol)) = w; }
DI bf16x4 pack4b(const f32x4& v) { u32x2 w; w.x = pk2(v[0], v[1]); w.y = pk2(v[2], v[3]); return __builtin_bit_cast(bf16x4, w); }
DI f32x4 ld_tile(const LAS unsigned char* img, int yrow, int xcol) { const u32x2 w = *(const LAS u32x2*)(img + img_off(yrow, xcol)); return (f32x4){bflo(w.x), bfhi(w.x), bflo(w.y), bfhi(w.y)}; }

struct ScanItem { int b, h, dir, seg; };
DI int item_index(const ScanItem& it) { return ((it.b * NH + it.h) * 2 + it.dir) * NSEG + it.seg; }
struct SegGeom { int nchunks, seqlen, rowbase, pos0; };
DI SegGeom seg_geom(const ScanItem& it) { SegGeom g; if (it.seg == 0) { g.nchunks = CTX / 64; g.seqlen = CTX; g.rowbase = ML + it.b * CTX; g.pos0 = 0; } else { g.nchunks = SEGLEN / 64; g.seqlen = SEQ; g.rowbase = it.b * SEQ; g.pos0 = (it.seg - 1) * SEGLEN; } return g; }

struct ScanPF { bf16x8 af[4][3]; u32x2 uu[2][3][3]; };
DI void scan_issue(const bf16_t* U, const ScanItem& it, const SegGeom& sg, int c, int mat, int tid, ScanPF& pf) {
    const int lane = tid & 63, q = lane >> 4, l15 = lane & 15; const int qpos0 = sg.pos0 + 64 * c;
#pragma unroll
    for (int mt = 0; mt < 4; ++mt) { const int qq = qpos0 + 16 * mt + l15; const int tau = it.dir ? sg.seqlen - 1 - qq : qq;
        const bf16_t* ur = U + (size_t)(sg.rowbase + tau) * INWP + (mat ? OFF_A : OFF_W) + 8 * q;
#pragma unroll
        for (int ks = 0; ks < 3; ++ks) pf.af[mt][ks] = *(const bf16x8*)(ur + 32 * ks); }
#pragma unroll
    for (int half = 0; half < 2; ++half) { const int p = (tid >> 4) + 32 * half, cg = tid & 15; const int qq = qpos0 + p; const int tau = it.dir ? sg.seqlen - 1 - qq : qq;
        const bf16_t* up = U + (size_t)(sg.rowbase + tau) * INWP + it.h * 64 + 4 * cg;
#pragma unroll
        for (int x = 0; x < 3; ++x) { pf.uu[half][x][0] = *(const u32x2*)(up + x * RW - INWP); pf.uu[half][x][1] = *(const u32x2*)(up + x * RW); pf.uu[half][x][2] = *(const u32x2*)(up + x * RW + INWP); } }
}
template <bool PASS3>
DI void scan_item(Frame& F, const CAS Inputs& IN_, int l, const ScanItem it) {
    LAS unsigned char* L = F.lds;
    const SegGeom sg = seg_geom(it);
    const bf16_t* U = (const bf16_t*)(F.ws + WS_U);
    constexpr int NCB = PASS3 ? 4 : 8;
    f32x4 H[4];
    const size_t st_off = (size_t)item_index(it) * 4096;
    { const int lane = F.lane, cb = F.wave, q = lane >> 4, l15 = lane & 15; const int v = 16 * cb + l15;
#pragma unroll
      for (int kt = 0; kt < 4; ++kt) { const int k = 16 * kt + 4 * q;
        if (PASS3) { H[kt] = (cb < 4) ? *(const f32x4*)((const float*)(F.ws + WS_HIN) + st_off + (size_t)v * 64 + k) : (f32x4){0.f, 0.f, 0.f, 0.f}; }
        else { H[kt] = (f32x4){0.f, 0.f, 0.f, 0.f}; if (v >= 64) {
#pragma unroll
            for (int e = 0; e < 4; ++e) H[kt][e] = (v - 64 == k + e) ? 1.f : 0.f; } } } }
    float* YO = (float*)(F.ws + WS_YF) + (size_t)it.dir * MR * RW;
    float* BS = (float*)(F.ws + WS_BS) + (size_t)it.dir * MR * NH;
    const int mat = F.wave >> 2, ntile = F.wave & 3;
    bf16x8 bfr[3]; float lbias;
    { const int q = F.lane >> 4, l15 = F.lane & 15;
      const bf16_t* Wt = wl_ptr(F, l, mat ? WL_IUP : WL_DUP) + (size_t)it.dir * RW * LORA + (size_t)(it.h * 64 + 16 * ntile + l15) * LORA + 8 * q;
#pragma unroll
      for (int ks = 0; ks < 3; ++ks) bfr[ks] = *(const bf16x8*)(Wt + 32 * ks);
      lbias = (mat ? IN_.iclr_bias : IN_.decay_bias)[((size_t)l * 2 + it.dir) * RW + it.h * 64 + 16 * ntile + l15]; }
    ScanPF pf;
    scan_issue(U, it, sg, 0, mat, F.tid, pf);
    for (int c = 0; c < sg.nchunks; ++c) {
        int tid_o = F.tid; OPAQUE_V(tid_o);
        const int tid = tid_o, lane = tid & 63, wave = RFL(tid >> 6), q = lane >> 4, l15 = lane & 15;
        const int qpos0 = sg.pos0 + 64 * c;
        {
            f32x4 a4[4];
#pragma unroll
            for (int mt = 0; mt < 4; ++mt) { a4[mt] = (f32x4){0.f, 0.f, 0.f, 0.f};
#pragma unroll
                for (int ks = 0; ks < 3; ++ks) a4[mt] = MFMA16(pf.af[mt][ks], bfr[ks], a4[mt]); }
            if (mat == 0) {
                float run = 0.f;
                LAS float* G = (LAS float*)(L + SCR_G);
#pragma unroll
                for (int mt = 0; mt < 4; ++mt) {
                    float c0 = -0.6065306597126334f * fsigmoid(lbias + a4[mt][0]), c1 = -0.6065306597126334f * fsigmoid(lbias + a4[mt][1]), c2 = -0.6065306597126334f * fsigmoid(lbias + a4[mt][2]), c3 = -0.6065306597126334f * fsigmoid(lbias + a4[mt][3]);
                    c1 += c0; c2 += c1; c3 += c2;
                    const float t1 = __shfl(c3, lane - 16), t2 = __shfl(c3, lane - 32), t3 = __shfl(c3, lane - 48);
                    const float off = run + (q >= 1 ? t1 : 0.f) + (q >= 2 ? t2 : 0.f) + (q >= 3 ? t3 : 0.f);
                    const float tot = __shfl(off + c3, 48 + l15);
                    const int p0 = 16 * mt + 4 * q, cc = 16 * ntile + l15;
                    G[(p0 + 0) * 68 + cc] = off + c0; G[(p0 + 1) * 68 + cc] = off + c1; G[(p0 + 2) * 68 + cc] = off + c2; G[(p0 + 3) * 68 + cc] = off + c3;
                    run = tot;
                }
            } else {
                LAS float* AI = (LAS float*)(L + SCR_AI);
#pragma unroll
                for (int mt = 0; mt < 4; ++mt) { const int p0 = 16 * mt + 4 * q, cc = 16 * ntile + l15;
#pragma unroll
                    for (int e = 0; e < 4; ++e) AI[(p0 + e) * 68 + cc] = fsigmoid(lbias + a4[mt][e]); }
            }
        }
        LDS_WAIT(); WG_BAR();
#pragma unroll
        for (int half = 0; half < 2; ++half) {
            const int p = (tid >> 4) + 32 * half, cg = tid & 15, ch0 = it.h * 64 + 4 * cg;
            const int qq = qpos0 + p; const int tau = it.dir ? sg.seqlen - 1 - qq : qq; const size_t row = (size_t)(sg.rowbase + tau);
            const bool hasm = tau > 0, hasp = tau < sg.seqlen - 1;
            float r4[4], k4[4], v4[4];
            {
                const float* cw = IN_.conv_rkv + (size_t)l * 3 * 3 * RW;
#pragma unroll
                for (int x = 0; x < 3; ++x) {
                    float cen[4], lo[4], hi[4];
                    unpack4(pf.uu[half][x][1], cen); unpack4(pf.uu[half][x][0], lo); unpack4(pf.uu[half][x][2], hi);
#pragma unroll
                    for (int j = 0; j < 4; ++j) { lo[j] = hasm ? lo[j] : 0.f; hi[j] = hasp ? hi[j] : 0.f; }
                    const f32x4 w0 = *(const f32x4*)(cw + x * RW + ch0), w1 = *(const f32x4*)(cw + 3 * RW + x * RW + ch0), w2 = *(const f32x4*)(cw + 6 * RW + x * RW + ch0);
                    float* dst = x == 0 ? r4 : (x == 1 ? k4 : v4);
#pragma unroll
                    for (int j = 0; j < 4; ++j) dst[j] = lo[j] * w0[j] + cen[j] * w1[j] + hi[j] * w2[j];
                }
            }
            float kk4[4]; float nn = 0.f;
            { const f32x4 kkp = *(const f32x4*)(IN_.k_k + (size_t)l * RW + ch0);
#pragma unroll
              for (int j = 0; j < 4; ++j) { kk4[j] = k4[j] * kkp[j]; nn += kk4[j] * kk4[j]; } }
            nn += __shfl_xor(nn, 1); nn += __shfl_xor(nn, 2); nn += __shfl_xor(nn, 4); nn += __shfl_xor(nn, 8);
            const float inv = frsq(fmaxf(nn, 1e-24f));
            const LAS float* G = (const LAS float*)(L + SCR_G); const LAS float* AI = (const LAS float*)(L + SCR_AI);
            const f32x4 g4 = *(const LAS f32x4*)(G + p * 68 + 4 * cg), gc4 = *(const LAS f32x4*)(G + 63 * 68 + 4 * cg), a4 = *(const LAS f32x4*)(AI + p * 68 + 4 * cg);
            f32x4 gp4 = {0.f, 0.f, 0.f, 0.f}; if (p > 0) gp4 = *(const LAS f32x4*)(G + (p - 1) * 68 + 4 * cg);
            const f32x4 kap = *(const f32x4*)(IN_.k_a + (size_t)l * RW + ch0), rkp = *(const f32x4*)(IN_.r_k + (size_t)l * RW + ch0);
            float rt[4], at[4], kb[4], bb[4], kt[4], bt[4]; float bsum = 0.f;
#pragma unroll
            for (int j = 0; j < 4; ++j) { const float kkn = kk4[j] * inv; const float kd = k4[j] * (1.0f + (a4[j] - 1.0f) * kap[j]); const float bh = kkn * a4[j];
                const float eg = fexp(g4[j]), egp = fexp(gp4[j]), eng = fexp(-g4[j]), egc = fexp(gc4[j] - g4[j]);
                rt[j] = r4[j] * eg; at[j] = -kkn * egp; kb[j] = kd * eng; bb[j] = bh * eng; kt[j] = kd * egc; bt[j] = bh * egc; bsum += r4[j] * kd * rkp[j]; }
            *(LAS u32x2*)(L + M_RT * IMG + img_off(p, 4 * cg)) = pack4(rt);
            *(LAS u32x2*)(L + M_AT * IMG + img_off(p, 4 * cg)) = pack4(at);
            *(LAS u32x2*)(L + M_KB * IMG + img_off(p, 4 * cg)) = pack4(kb);
            *(LAS u32x2*)(L + M_BB * IMG + img_off(p, 4 * cg)) = pack4(bb);
#pragma unroll
            for (int j = 0; j < 4; ++j) { const int chl = 4 * cg + j;
                *(LAS unsigned short*)(L + M_KT * IMG + img_off(chl, p)) = (unsigned short)f2bf(kt[j]);
                *(LAS unsigned short*)(L + M_BT * IMG + img_off(chl, p)) = (unsigned short)f2bf(bt[j]);
                *(LAS unsigned short*)(L + M_VT * IMG + img_off(chl, p)) = (unsigned short)f2bf(v4[j]); }
            if (p == 63) {
#pragma unroll
                for (int j = 0; j < 4; ++j) ((LAS float*)(L + SC_GC))[4 * cg + j] = fexp(gc4[j]); }
            if (PASS3) { bsum += __shfl_xor(bsum, 1); bsum += __shfl_xor(bsum, 2); bsum += __shfl_xor(bsum, 4); bsum += __shfl_xor(bsum, 8); if (cg == 0) BS[row * NH + it.h] = bsum; }
        }
        if (c + 1 < sg.nchunks) scan_issue(U, it, sg, c + 1, mat, tid, pf);
        LDS_WAIT(); WG_BAR();
        {
            constexpr int NT = PASS3 ? 40 : 20;
            for (int t = wave; t < NT; t += 8) { const int which = t / 10, lt = t % 10;
                const int yt = lt >= 6 ? 3 : (lt >= 3 ? 2 : (lt >= 1 ? 1 : 0)), xt = lt - (yt * (yt + 1)) / 2;
                f32x4 a = {0.f, 0.f, 0.f, 0.f};
                a = tile_mm<64>(a, L + ((which & 1) ? M_BB : M_KB) * IMG, 16 * xt, L + (which < 2 ? M_AT : M_RT) * IMG, 16 * yt, lane);
                if (xt == yt) {
#pragma unroll
                    for (int e = 0; e < 4; ++e) { const bool keep = which < 2 ? (4 * q + e < l15) : (4 * q + e <= l15); if (!keep) a[e] = 0.f; } }
                if (which == 1 && xt == yt) *(LAS f32x4*)(L + SC_DIAG + (yt * 256 + l15 * 16 + 4 * q) * 4) = a;
                else st_tile(L + (M_AAK + which) * IMG, 16 * yt + l15, 16 * xt + 4 * q, a); }
        }
        LDS_WAIT(); WG_BAR();
        if (wave < NCB) {
            const int cb = wave;
            LAS unsigned char* Dw = L + SC_DM + wave * 2048;
            {
                const LAS float* DG = (const LAS float*)(L + SC_DIAG) + q * 256;
                float d[16];
#pragma unroll
                for (int t = 0; t < 16; ++t) { float a = (t == l15) ? 1.f : 0.f;
                    float rowv[16];
#pragma unroll
                    for (int j4 = 0; j4 < 4; ++j4) { if (4 * j4 < t) { const f32x4 x = *(const LAS f32x4*)(DG + t * 16 + 4 * j4); rowv[4 * j4] = x[0]; rowv[4 * j4 + 1] = x[1]; rowv[4 * j4 + 2] = x[2]; rowv[4 * j4 + 3] = x[3]; } }
#pragma unroll
                    for (int j = 0; j < t; ++j) a += rowv[j] * d[j];
                    d[t] = a; }
#pragma unroll
                for (int t = 0; t < 16; ++t) *(LAS unsigned short*)(Dw + q * 512 + t * 32 + l15 * 2) = (unsigned short)f2bf(d[t]);
            }
            LDS_WAIT();
            bf16x4 vb[4], hb[4], ub[4];
#pragma unroll
            for (int pt = 0; pt < 4; ++pt) vb[pt] = (cb < 4) ? *(const LAS bf16x4*)(L + M_VT * IMG + img_off(16 * cb + l15, 16 * pt + 4 * q)) : (bf16x4){0, 0, 0, 0};
#pragma unroll
            for (int kt = 0; kt < 4; ++kt) hb[kt] = pack4b(H[kt]);
#pragma unroll
            for (int i = 0; i < 4; ++i) { f32x4 a = {0.f, 0.f, 0.f, 0.f};
                if (cb < 4) {
#pragma unroll
                    for (int pt = 0; pt <= i; ++pt) a = MFMA16K16(*(const LAS bf16x4*)(L + M_AAK * IMG + img_off(16 * i + l15, 16 * pt + 4 * q)), vb[pt], a); }
#pragma unroll
                for (int kt = 0; kt < 4; ++kt) a = MFMA16K16(*(const LAS bf16x4*)(L + M_AT * IMG + img_off(16 * i + l15, 16 * kt + 4 * q)), hb[kt], a);
#pragma unroll
                for (int j = 0; j < i; ++j) a = MFMA16K16(*(const LAS bf16x4*)(L + M_AAB * IMG + img_off(16 * i + l15, 16 * j + 4 * q)), ub[j], a);
                const bf16x4 ab = pack4b(a);
                const f32x4 u = MFMA16K16(*(const LAS bf16x4*)(Dw + i * 512 + l15 * 32 + q * 8), ab, ((f32x4){0.f, 0.f, 0.f, 0.f}));
                ub[i] = pack4b(u); }
            if (PASS3) {
#pragma unroll
                for (int i = 0; i < 4; ++i) { f32x4 y = {0.f, 0.f, 0.f, 0.f};
#pragma unroll
                    for (int kt = 0; kt < 4; ++kt) y = MFMA16K16(*(const LAS bf16x4*)(L + M_RT * IMG + img_off(16 * i + l15, 16 * kt + 4 * q)), hb[kt], y);
#pragma unroll
                    for (int pt = 0; pt <= i; ++pt) y = MFMA16K16(*(const LAS bf16x4*)(L + M_ARK * IMG + img_off(16 * i + l15, 16 * pt + 4 * q)), vb[pt], y);
#pragma unroll
                    for (int j = 0; j <= i; ++j) y = MFMA16K16(*(const LAS bf16x4*)(L + M_ARB * IMG + img_off(16 * i + l15, 16 * j + 4 * q)), ub[j], y);
#pragma unroll
                    for (int e = 0; e < 4; ++e) { const int qq = qpos0 + 16 * i + 4 * q + e; const int tau = it.dir ? sg.seqlen - 1 - qq : qq;
                        YO[(size_t)(sg.rowbase + tau) * RW + it.h * 64 + 16 * cb + l15] = y[e]; } }
            }
#pragma unroll
            for (int kt = 0; kt < 4; ++kt) { const f32x4 gc = *(const LAS f32x4*)(L + SC_GC + (16 * kt + 4 * q) * 4); f32x4 a = H[kt] * gc;
                if (cb < 4) {
#pragma unroll
                    for (int pt = 0; pt < 4; ++pt) a = MFMA16K16(*(const LAS bf16x4*)(L + M_KT * IMG + img_off(16 * kt + l15, 16 * pt + 4 * q)), vb[pt], a); }
#pragma unroll
                for (int pt = 0; pt < 4; ++pt) a = MFMA16K16(*(const LAS bf16x4*)(L + M_BT * IMG + img_off(16 * kt + l15, 16 * pt + 4 * q)), ub[pt], a);
                H[kt] = a; }
        }
        LDS_WAIT(); WG_BAR();
    }
    if (!PASS3) { const int lane = F.lane, cb = F.wave, q = lane >> 4, l15 = lane & 15;
#pragma unroll
        for (int kt = 0; kt < 4; ++kt) { const int v = 16 * cb + l15, k = 16 * kt + 4 * q;
            float* dst = (v < 64) ? (float*)(F.ws + WS_SSEG) + st_off + (size_t)v * 64 + k : (float*)(F.ws + WS_PSEG) + st_off + (size_t)(v - 64) * 64 + k;
            *(f32x4*)dst = H[kt]; }
    }
}
DI bool scan_item_of(int idx, bool pass3, bool skip_ctx, ScanItem& it) {
    const int nl = pass3 ? NSEGL : NSEGL - 1;
    const int n_lat = NB * NH * 2 * nl, n_ctx = (pass3 && skip_ctx) ? 0 : NB * NH * 2;
    if (idx < n_lat) { it.seg = 1 + idx % nl; int r = idx / nl; it.dir = r & 1; r >>= 1; it.h = r % NH; it.b = r / NH; return true; }
    idx -= n_lat; if (idx >= n_ctx) return false;
    it.seg = 0; it.dir = idx & 1; idx >>= 1; it.h = idx % NH; it.b = idx / NH; return true;
}
DI void phase_chain(Frame& F) {
    LAS float* Sm = (LAS float*)F.lds; LAS float* Pm = Sm + 64 * 65;
    const int v = F.tid >> 3, kg = F.tid & 7;
    for (int ci = F.vcu; ci < NB * NH * 2; ci += F.G) {
        const size_t base = (size_t)ci * NSEG * 4096;
        float s8[8];
#pragma unroll
        for (int j = 0; j < 8; ++j) s8[j] = 0.f;
        for (int seg = 0; seg < NSEG; ++seg) {
            float* hin = (float*)(F.ws + WS_HIN) + base + (size_t)seg * 4096 + v * 64 + 8 * kg;
            *(f32x4*)hin = (f32x4){s8[0], s8[1], s8[2], s8[3]}; *(f32x4*)(hin + 4) = (f32x4){s8[4], s8[5], s8[6], s8[7]};
            if (seg == NSEG - 1) break;
            const float* pp = (const float*)(F.ws + WS_PSEG) + base + (size_t)seg * 4096 + v * 64 + 8 * kg;
            const float* sp = (const float*)(F.ws + WS_SSEG) + base + (size_t)seg * 4096 + v * 64 + 8 * kg;
            WG_BAR();
#pragma unroll
            for (int j = 0; j < 8; ++j) { Sm[v * 65 + 8 * kg + j] = s8[j]; Pm[v * 64 + 8 * kg + j] = pp[j]; }
            float o8[8];
#pragma unroll
            for (int j = 0; j < 8; ++j) o8[j] = sp[j];
            LDS_WAIT(); WG_BAR();
            for (int j = 0; j < 64; ++j) { const float sv = Sm[v * 65 + j]; const f32x4 p0 = *(const LAS f32x4*)(Pm + j * 64 + 8 * kg), p1 = *(const LAS f32x4*)(Pm + j * 64 + 8 * kg + 4);
                o8[0] += sv * p0[0]; o8[1] += sv * p0[1]; o8[2] += sv * p0[2]; o8[3] += sv * p0[3]; o8[4] += sv * p1[0]; o8[5] += sv * p1[1]; o8[6] += sv * p1[2]; o8[7] += sv * p1[3]; }
#pragma unroll
            for (int j = 0; j < 8; ++j) s8[j] = o8[j];
        }
        WG_BAR();
    }
}

DI void phase_poolv(Frame& F, int start, int stride) {
    const bf16_t* U = (const bf16_t*)(F.ws + WS_U); bf16_t* VS = (bf16_t*)(F.ws + WS_VS);
    for (int i = start; i < ML * 128; i += stride) { const int row = i >> 7, ck = i & 127; const int half = 1 << (ck >> 5);
        const int b = row / SEQ, t = row % SEQ, y = t / GW; const int ylo = y - half < 0 ? 0 : y - half, yhi = y + half > GROWS ? GROWS : y + half;
        float s[8];
#pragma unroll
        for (int j = 0; j < 8; ++j) s[j] = 0.f;
        for (int yy = ylo; yy < yhi; ++yy) { float f[8]; unpack8(*(const u32x4*)(U + (size_t)(b * SEQ + yy * GW + (t % GW)) * INWP + OFF_POOL + 8 * ck), f);
#pragma unroll
            for (int j = 0; j < 8; ++j) s[j] += f[j]; }
        *(u32x4*)(VS + (size_t)row * PWD + 8 * ck) = pack8(s); }
}
DI void phase_poolh(Frame& F, int start, int stride) {
    const bf16_t* U = (const bf16_t*)(F.ws + WS_U); const bf16_t* VS = (const bf16_t*)(F.ws + WS_VS); bf16_t* PD = (bf16_t*)(F.ws + WS_PD);
    for (int i = start; i < MR * 128; i += stride) { const int row = i >> 7, ck = i & 127; const int half = 1 << (ck >> 5);
        float s[8], f[8];
#pragma unroll
        for (int j = 0; j < 8; ++j) s[j] = 0.f;
        float cnt;
        if (row < ML) { const int t = row % SEQ, y = t / GW, x = t % GW; const int xlo = x - half < 0 ? 0 : x - half, xhi = x + half > GW ? GW : x + half;
            const int ylo = y - half < 0 ? 0 : y - half, yhi = y + half > GROWS ? GROWS : y + half;
            for (int xx = xlo; xx < xhi; ++xx) { unpack8(*(const u32x4*)(VS + (size_t)(row - x + xx) * PWD + 8 * ck), f);
#pragma unroll
                for (int j = 0; j < 8; ++j) s[j] += f[j]; }
            cnt = (float)((xhi - xlo) * (yhi - ylo));
        } else { const int t = (row - ML) % CTX; const int lo = t - half < 0 ? 0 : t - half, hi = t + half > CTX ? CTX : t + half;
            for (int tt = lo; tt < hi; ++tt) { unpack8(*(const u32x4*)(U + (size_t)(row - t + tt) * INWP + OFF_POOL + 8 * ck), f);
#pragma unroll
                for (int j = 0; j < 8; ++j) s[j] += f[j]; }
            cnt = (float)(hi - lo); }
        unpack8(*(const u32x4*)(U + (size_t)row * INWP + OFF_POOL + 8 * ck), f);
        const float ic = 1.0f / cnt;
#pragma unroll
        for (int j = 0; j < 8; ++j) s[j] = s[j] * ic - f[j];
        *(u32x4*)(PD + (size_t)row * PWD + 8 * ck) = pack8(s); }
}

DI void phase_finish(Frame& F, const CAS Inputs& IN_, int l, int nrows) {
    const bf16_t* U = (const bf16_t*)(F.ws + WS_U); const bf16_t* Gt = (const bf16_t*)(F.ws + WS_G); bf16_t* MIX = (bf16_t*)(F.ws + WS_MIX);
    const float* YF = (const float*)(F.ws + WS_YF); const float* YB = YF + (size_t)MR * RW; const float* BS0 = (const float*)(F.ws + WS_BS); const float* BS1 = BS0 + (size_t)MR * NH;
    const float* cw = IN_.conv_rkv + (size_t)l * 9 * RW + 2 * RW;
    const int gt = F.vcu * 512 + F.tid, NGT = F.G * 512;
    for (int i = gt; i < nrows * 128; i += NGT) { const int row = i >> 7, cg = i & 127, h = cg >> 3, ch = 8 * cg;
        int tau, len; if (row < ML) { tau = row % SEQ; len = SEQ; } else { tau = (row - ML) % CTX; len = CTX; }
        float y[8];
        { const f32x4 a0 = *(const f32x4*)(YF + (size_t)row * RW + ch), a1 = *(const f32x4*)(YF + (size_t)row * RW + ch + 4), b0 = *(const f32x4*)(YB + (size_t)row * RW + ch), b1 = *(const f32x4*)(YB + (size_t)row * RW + ch + 4);
#pragma unroll
          for (int e = 0; e < 4; ++e) { y[e] = a0[e] + b0[e]; y[4 + e] = a1[e] + b1[e]; } }
        float s = 0.f;
#pragma unroll
        for (int j = 0; j < 8; ++j) s += y[j];
        s += __shfl_xor(s, 1); s += __shfl_xor(s, 2); s += __shfl_xor(s, 4);
        const float mu = s * (1.f / 64.f); float vq = 0.f;
#pragma unroll
        for (int j = 0; j < 8; ++j) { y[j] -= mu; vq += y[j] * y[j]; }
        vq += __shfl_xor(vq, 1); vq += __shfl_xor(vq, 2); vq += __shfl_xor(vq, 4);
        const float rstd = frsq(vq * (1.f / 64.f) + GN_EPS);
        float cen[8], lo[8], hi[8], g8[8];
        const bf16_t* up = U + (size_t)row * INWP + OFF_V + ch;
        unpack8(*(const u32x4*)up, cen);
        if (tau > 0) unpack8(*(const u32x4*)(up - INWP), lo); else {
#pragma unroll
            for (int j = 0; j < 8; ++j) lo[j] = 0.f; }
        if (tau < len - 1) unpack8(*(const u32x4*)(up + INWP), hi); else {
#pragma unroll
            for (int j = 0; j < 8; ++j) hi[j] = 0.f; }
        unpack8(*(const u32x4*)(Gt + (size_t)row * RW + ch), g8);
        const float bsum = BS0[(size_t)row * NH + h] + BS1[(size_t)row * NH + h];
        const float* gw = IN_.gn_w + (size_t)l * RW + ch; const float* gb = IN_.gn_b + (size_t)l * RW + ch;
        float o[8];
#pragma unroll
        for (int j = 0; j < 8; ++j) { const float v = lo[j] * cw[ch + j] + cen[j] * cw[3 * RW + ch + j] + hi[j] * cw[6 * RW + ch + j];
            o[j] = (y[j] * rstd * gw[j] + gb[j] + bsum * v) * g8[j]; }
        *(u32x4*)(MIX + (size_t)row * D + ch) = pack8(o); }
}

constexpr int PH_P0 = 0, PH_P0B = 1, PH_L0 = 2, PH_PER_LAYER = 11, PH_FINAL = PH_L0 + PH_PER_LAYER * DEPTH, NPHASES = PH_FINAL + 1;
#define IN(k) (lo <= (k) && (k) < hi)
#define REP(k) for (int rep_ = 0; rep_ < (((PROBE_MASK) >> (k)) & 1) + 1; ++rep_)
#define PHASE_BEGIN() const CAS Args* AP = kargs; OPAQUE_S(AP); do { F.ws = AP->ws; F.out = AP->out; F.wave = wave_id; OPAQUE_S(F.wave); F.lane = LANE_ID(); OPAQUE_V(F.lane); F.tid = F.wave * 64 + F.lane; } while (0)
#ifdef EMU
#define SEAM(k) do { if (IN(k) && IN((k) + 1)) xcd_barrier(bar); } while (0)
#else
#define SEAM(k) do { if (IN(k) && IN((k) + 1)) { XcdBarrier bb_ = bar; { const CAS Args* ap_ = kargs; OPAQUE_S(ap_); bb_.bar = (unsigned*)(ap_->ws + WS_CTL) + CW_BAR; } OPAQUE_S(bb_.bar); xcd_barrier(bb_); } } while (0)
#endif
template <int l> DI void run_layer(Frame F, const CAS Args* const kargs, const int lo, const int hi, const XcdBarrier bar, const int wave_id) {

        const int pb = PH_L0 + PH_PER_LAYER * l; const bool last = (l == DEPTH - 1);
        const int npm = last ? NPM_L : NPM;
        if (IN(pb + 0)) REP(0) { PHASE_BEGIN(); phase_norm(F, AP->in, l, false, MR); }
        SEAM(pb + 0);
        if (IN(pb + 1)) REP(1) { PHASE_BEGIN(); pg8::Gemm g{(const bf16_t*)(F.ws + WS_XN), wl_ptr(F, l, WL_WIN), D, D, D, 0}; pg8::StaticOrder S; S.init(NPM, INWP / 256, F.G, (int)blockIdx.x);
            EpiU E{(bf16_t*)(F.ws + WS_U), INWP, 1}; pg8::gemm_phase<EpiU, pg8::StaticOrder, true, true>(F.lds, g, S, E, F.tid); }
        SEAM(pb + 1);
        if (IN(pb + 2)) REP(2) { PHASE_BEGIN(); ScanItem it; for (int i = F.vcu; scan_item_of(i, false, false, it); i += F.G) scan_item<false>(F, AP->in, l, it);
            phase_poolv(F, F.vcu * 512 + F.tid, F.G * 512); }
        SEAM(pb + 2);
        if (IN(pb + 3)) REP(3) { PHASE_BEGIN(); phase_chain(F); phase_poolh(F, F.vcu * 512 + F.tid, F.G * 512); }
        SEAM(pb + 3);
        if (IN(pb + 4)) REP(4) { PHASE_BEGIN(); ScanItem it; for (int i = F.vcu; scan_item_of(i, true, last, it); i += F.G) scan_item<true>(F, AP->in, l, it); }
        SEAM(pb + 4);
        if (IN(pb + 5)) REP(5) { PHASE_BEGIN();
            { pg8::Gemm g{(const bf16_t*)(F.ws + WS_U) + OFF_G, wl_ptr(F, l, WL_GUP), INWP, GL, GL, 0}; pg8::StaticOrder S; S.init(npm, RW / 256, F.G, (int)blockIdx.x);
              EpiU E{(bf16_t*)(F.ws + WS_G), RW, 0}; pg8::gemm_phase<EpiU, pg8::StaticOrder, true, true>(F.lds, g, S, E, F.tid); }
            { pg8::Gemm g{(const bf16_t*)(F.ws + WS_PD), wl_ptr(F, l, WL_POOL), PWD, PG, PG, 256}; pg8::StaticOrder S; S.init(npm, 4, F.G, (int)blockIdx.x);
              EpiPool E{(bf16_t*)(F.ws + WS_MIX), AP->in.pool_scale + (size_t)l * PWD}; pg8::gemm_phase<EpiPool, pg8::StaticOrder, true, true>(F.lds, g, S, E, F.tid); }
        }
        SEAM(pb + 5);
        if (IN(pb + 6)) REP(6) { PHASE_BEGIN(); phase_finish(F, AP->in, l, npm * 256); }
        SEAM(pb + 6);
        if (IN(pb + 7)) { PHASE_BEGIN(); pg8::Gemm g{(const bf16_t*)(F.ws + WS_MIX), wl_ptr(F, l, WL_WOUT), D, D, D, 0}; pg8::StaticOrder S; S.init(npm, D / 256, F.G, (int)blockIdx.x);
            const float* bl = l == 0 ? AP->in.x : (const float*)F.out; const float* bc = l == 0 ? AP->in.ctx : (const float*)(F.ws + WS_CTXH);
            EpiRes E{bl, F.out, (long long)((const char*)bc - (const char*)bl), (long long)((const char*)(F.ws + WS_CTXH) - (const char*)F.out), mod_ptr(F, l, 0, 2)};
            pg8::gemm_phase<EpiRes, pg8::StaticOrder, true, true>(F.lds, g, S, E, F.tid); }
        SEAM(pb + 7);
        if (IN(pb + 8)) REP(8) { PHASE_BEGIN(); phase_norm(F, AP->in, l, true, npm * 256); }
        SEAM(pb + 8);
        if (IN(pb + 9)) REP(9) { PHASE_BEGIN(); pg8::Gemm g{(const bf16_t*)(F.ws + WS_XN), wl_ptr(F, l, WL_WGU), D, D, D, 0}; pg8::StaticOrder S; S.init(npm, 2 * DFF / 256, F.G, (int)blockIdx.x);
            EpiSwiglu E{(bf16_t*)(F.ws + WS_H)}; pg8::gemm_phase<EpiSwiglu, pg8::StaticOrder, true, true>(F.lds, g, S, E, F.tid); }
        SEAM(pb + 9);
        if (IN(pb + 10)) { PHASE_BEGIN(); pg8::Gemm g{(const bf16_t*)(F.ws + WS_H), wl_ptr(F, l, WL_WDN), DFF, DFF, DFF, 0}; pg8::StaticOrder S; S.init(npm, D / 256, F.G, (int)blockIdx.x);
            const long long dc = (long long)((const char*)(F.ws + WS_CTXH) - (const char*)F.out);
            EpiRes E{F.out, F.out, dc, dc, mod_ptr(F, l, 0, 5)};
            pg8::gemm_phase<EpiRes, pg8::StaticOrder, true, true>(F.lds, g, S, E, F.tid); }
        SEAM(pb + 10);
    }
__global__ void __launch_bounds__(512, 2) fwd_kernel(Args args) {
#ifdef EMU
    unsigned char* lds = emu_blk->lds;
#else
    extern __shared__ __attribute__((aligned(16))) unsigned char lds[];
#endif
    Frame F;
    F.lds = (LAS unsigned char*)lds;
    F.tid = threadIdx.x; F.lane = F.tid & 63; F.wave = RFL(F.tid >> 6);
    const int wave_id = F.wave;
    F.G = gridDim.x; { const int bx = blockIdx.x; F.vcu = (F.G % 8 == 0) ? (bx % 8) * (F.G / 8) + bx / 8 : bx; }
#ifdef EMU
    const Args* const kargs = &args;
#else
    const CAS Args* const kargs = (const CAS Args*)__builtin_amdgcn_kernarg_segment_ptr();
#endif
    F.out = kargs->out; F.ws = kargs->ws;
    const int lo = args.ph_lo, hi = args.ph_hi;
#ifndef EMU
    volatile LAS unsigned* MISC = (volatile LAS unsigned*)(F.lds + MISC_OFF);
    if (F.tid < 64) MISC[F.tid] = 0u;
    __syncthreads();
    XcdBarrier bar; bar.bar = (unsigned*)(F.ws + WS_CTL) + CW_BAR; bar.x = 0; bar.st = nullptr;
    if (hi - lo > 1) bar = xcd_barrier_post((unsigned*)(F.ws + WS_CTL) + CW_BAR, MISC + 8);
#else
    XcdBarrier bar; bar.bar = nullptr;
#endif
    if (IN(PH_P0)) REP(11) { PHASE_BEGIN(); phase_p0(F, AP->in); }
    SEAM(PH_P0);
    if (IN(PH_P0B)) { PHASE_BEGIN(); phase_p0b(F, AP->in); }
    SEAM(PH_P0B);
    run_layer<0>(F, kargs, lo, hi, bar, wave_id);
    if constexpr (DEPTH > 1) run_layer<1>(F, kargs, lo, hi, bar, wave_id);
    if constexpr (DEPTH > 2) run_layer<2>(F, kargs, lo, hi, bar, wave_id);
    if constexpr (DEPTH > 3) run_layer<3>(F, kargs, lo, hi, bar, wave_id);
    static_assert(DEPTH <= 4, "layers");
    if (IN(PH_FINAL)) { PHASE_BEGIN(); phase_final_norm(F, AP->in); }
#undef IN
#undef SEAM
}

extern "C" void kernel_launch(void* const* d_in, const int* in_sizes, int n_in, void* d_out, int out_size, void* d_ws, size_t ws_size, hipStream_t stream) {
    static int grid = 0;
    if (grid == 0) {
        if (n_in != 27 || in_sizes[0] != ML * D || out_size != ML * D || ws_size < WS_END) {
            fprintf(stderr, "kernel_launch: shape/workspace mismatch: n_in %d in0 %d out %d ws %zu (need %zu)\n", n_in, n_in > 0 ? in_sizes[0] : -1, out_size, ws_size, (size_t)WS_END); grid = -1; return; }
        int dev = 0, cus = 0, per_cu = 0;
        if (hipGetDevice(&dev) != hipSuccess || hipDeviceGetAttribute(&cus, hipDeviceAttributeMultiprocessorCount, dev) != hipSuccess) { grid = -1; return; }
        if (hipFuncSetAttribute((const void*)fwd_kernel, hipFuncAttributeMaxDynamicSharedMemorySize, LDS_BYTES) != hipSuccess) { fprintf(stderr, "kernel_launch: hipFuncSetAttribute failed\n"); grid = -1; return; }
        if (hipOccupancyMaxActiveBlocksPerMultiprocessor(&per_cu, (const void*)fwd_kernel, 512, LDS_BYTES) != hipSuccess || per_cu < 1) fprintf(stderr, "kernel_launch: occupancy query reports %d\n", per_cu);
        (void)hipGetLastError();
        grid = cus;
    }
    if (grid < 0) return;
    (void)hipMemsetAsync((char*)d_ws + WS_CTL, 0, CTL_BYTES, stream);
    Args a{};
    const float** ip = (const float**)&a.in;
    for (int i = 0; i < 27; ++i) ip[i] = (const float*)d_in[i];
    a.out = (float*)d_out; a.ws = (unsigned char*)d_ws;
#if MK_ONE_LAUNCH
    a.ph_lo = 0; a.ph_hi = NPHASES;
    hipLaunchKernelGGL(fwd_kernel, dim3(grid), dim3(512), LDS_BYTES, stream, a);
#else
    for (int ph = 0; ph < NPHASES; ++ph) {
#ifdef EMU
        extern int emu_stop_phase; if (emu_stop_phase >= 0 && ph >= emu_stop_phase) break; fprintf(stderr, "phase %d\n", ph);
#endif
        a.ph_lo = ph; a.ph_hi = ph + 1; hipLaunchKernelGGL(fwd_kernel, dim3(grid), dim3(512), LDS_BYTES, stream, a); }
#endif
}
```

```cpp
#ifndef EMU
#include <hip/hip_runtime.h>
#endif
#include <cstdio>
#include <cstdint>
#include <cstddef>

#ifndef CFG_SEQ
#define CFG_SEQ 16384
#endif
#ifndef CFG_CTX
#define CFG_CTX 256
#endif
#ifndef CFG_DEPTH
#define CFG_DEPTH 4
#endif
#ifndef CFG_NSEG
#define CFG_NSEG 4
#endif
#ifndef PROBE_MASK
#define PROBE_MASK 0
#endif
#ifndef PROBE_T
#define PROBE_T 0
#endif
#ifndef PROBE_TA
#define PROBE_TA 0
#endif
#ifndef PROBE_TB
#define PROBE_TB 1
#endif
#ifndef SCAN_PRIO
#define SCAN_PRIO 2
#endif
#ifndef SCAN_REP
#define SCAN_REP 0
#endif
#ifndef MK_ONE_LAUNCH
#define MK_ONE_LAUNCH 1
#endif
constexpr int D = 2048, NB = 2, SEQ = CFG_SEQ, DEPTH = CFG_DEPTH, CTX = CFG_CTX, GW = 64, HS = 64, RW = 1024, NH = 16, PWD = 1024;
constexpr int PG = 256, LORA = 96, GL = 256, DFF = 5632;
constexpr int OFF_R = 0, OFF_K = 1024, OFF_V = 2048, OFF_W = 3072, OFF_A = 3168, OFF_G = 3264, OFF_POOL = 3520, INW = 4544, INWP = 4608;
constexpr int ML = NB * SEQ, MC = NB * CTX, MR = ML + MC;
constexpr int NSEG = CFG_NSEG, TCH = (CTX + SEQ) / 64, SEG_BASE = TCH / NSEG, SEG_REM = TCH % NSEG, SEG_STEP = SEG_REM ? NSEG / SEG_REM + 1 : 1;
__host__ __device__ constexpr int seg_start(int sg) { return sg * SEG_BASE + ((sg + SEG_STEP - 1) / SEG_STEP < SEG_REM ? (sg + SEG_STEP - 1) / SEG_STEP : SEG_REM); }
static_assert(seg_start(NSEG) == TCH && seg_start(1) >= 1, "segments");
constexpr int GROWS = SEQ / GW;
constexpr float RMS_EPS = 1e-6f, GN_EPS = 64e-5f;
static_assert(ML % 256 == 0 && MR % 256 == 0 && SEQ % 256 == 0 && CTX % 64 == 0, "shape");
constexpr int NPM = MR / 256, NPM_L = ML / 256;

typedef unsigned short bf16_t;
typedef short bf16x8 __attribute__((ext_vector_type(8)));
typedef short bf16x4 __attribute__((ext_vector_type(4)));
typedef float f32x4 __attribute__((ext_vector_type(4)));
typedef float f32x2 __attribute__((ext_vector_type(2)));
typedef unsigned u32x4 __attribute__((ext_vector_type(4)));
typedef unsigned u32x2 __attribute__((ext_vector_type(2)));
#define DI __device__ __forceinline__
#ifdef EMU
#define LAS
#define GAS
#define CAS
#define MFMA16(a, b, c) emu_mfma16((a), (b), (c))
#define MFMA16K16(a, b, c) emu_mfma16k16((a), (b), (c))
#define LDS_TR16(p) emu_ds_read_tr16_b64((const void*)(p))
#define BPERM(v, src) __shfl((v), (src))
#define RFL(x) (x)
#define LDS_WAIT() emu_wave_sync()
#define VM_WAIT() do {} while (0)
#define WG_BAR() __syncthreads()
#define CFENCE() do {} while (0)
#define OPAQUE_S(x) do {} while (0)
#define OPAQUE_V(x) do {} while (0)
#define LANE_ID() ((int)(threadIdx.x & 63))
static inline float fexp(float x) { return expf(x); }
static inline float fexp2(float x) { return exp2f(x); }
static inline float frcp(float x) { return 1.0f / x; }
static inline float frsq(float x) { return 1.0f / sqrtf(x); }
#else
#define LAS __attribute__((address_space(3)))
#define GAS __attribute__((address_space(1)))
#define CAS __attribute__((address_space(4)))
#define MFMA16(a, b, c) __builtin_amdgcn_mfma_f32_16x16x32_bf16((a), (b), (c), 0, 0, 0)
#define MFMA16K16(a, b, c) __builtin_amdgcn_mfma_f32_16x16x16bf16_1k((a), (b), (c), 0, 0, 0)
#define LDS_TR16(p) __builtin_amdgcn_ds_read_tr16_b64_v4i16((LAS bf16x4*)(p))
#define BPERM(v, src) __builtin_bit_cast(float, __builtin_amdgcn_ds_bpermute(((src) & 63) << 2, __builtin_bit_cast(int, (v))))
#define RFL(x) __builtin_amdgcn_readfirstlane(x)
#define LDS_WAIT() asm volatile("s_waitcnt lgkmcnt(0)" ::: "memory")
#define VM_WAIT() asm volatile("s_waitcnt vmcnt(0)" ::: "memory")
#define WG_BAR() __syncthreads()
#define CFENCE() asm volatile("" ::: "memory")
#define OPAQUE_S(x) asm volatile("" : "+s"(x))
#define OPAQUE_V(x) asm volatile("" : "+v"(x))
DI int lane_id_volatile() { int l; asm volatile("v_mbcnt_lo_u32_b32 %0, -1, 0\n\tv_mbcnt_hi_u32_b32 %0, -1, %0" : "=v"(l)); return l; }
#define LANE_ID() lane_id_volatile()
DI float fexp(float x) { return __expf(x); }
DI float fexp2(float x) { return __builtin_amdgcn_exp2f(x); }
DI float frcp(float x) { return __builtin_amdgcn_rcpf(x); }
DI float frsq(float x) { return __builtin_amdgcn_rsqf(x); }
#endif
DI unsigned f2bf(float f) { unsigned u = __builtin_bit_cast(unsigned, f); return (u + 0x7fffu + ((u >> 16) & 1u)) >> 16; }
#ifdef EMU
DI unsigned pk2(float lo, float hi) { return f2bf(lo) | (f2bf(hi) << 16); }
#define SCHED_BAR() do {} while (0)
#else
typedef __bf16 nbf16x2 __attribute__((ext_vector_type(2)));
DI unsigned pk2(float lo, float hi) { return __builtin_bit_cast(unsigned, __builtin_convertvector((f32x2){lo, hi}, nbf16x2)); }
#define SCHED_BAR() __builtin_amdgcn_sched_barrier(0)
#endif
DI float bf2f(unsigned h) { return __builtin_bit_cast(float, h << 16); }
DI float bflo(unsigned w) { return __builtin_bit_cast(float, w << 16); }
DI float bfhi(unsigned w) { return __builtin_bit_cast(float, w & 0xffff0000u); }
DI float fsigmoid(float x) { return frcp(1.0f + fexp(-x)); }
DI float ftanh(float x) { return 1.0f - 2.0f * frcp(fexp(2.0f * x) + 1.0f); }
DI float fsilu(float x) { return x * fsigmoid(x); }
DI void unpack8(const u32x4& w, float (&f)[8]) { f[0] = bflo(w.x); f[1] = bfhi(w.x); f[2] = bflo(w.y); f[3] = bfhi(w.y); f[4] = bflo(w.z); f[5] = bfhi(w.z); f[6] = bflo(w.w); f[7] = bfhi(w.w); }
DI u32x4 pack8(const float (&f)[8]) { u32x4 w; w.x = pk2(f[0], f[1]); w.y = pk2(f[2], f[3]); w.z = pk2(f[4], f[5]); w.w = pk2(f[6], f[7]); return w; }
DI void unpack4(const u32x2& w, float (&f)[4]) { f[0] = bflo(w.x); f[1] = bfhi(w.x); f[2] = bflo(w.y); f[3] = bfhi(w.y); }
DI u32x2 pack4(const float (&f)[4]) { u32x2 w; w.x = pk2(f[0], f[1]); w.y = pk2(f[2], f[3]); return w; }
#ifdef EMU
DI float dpp_f(float x, int ctrl) { const int lane = threadIdx.x & 63; int src;
    if (ctrl == 0x141) src = (lane & ~7) | (7 - (lane & 7)); else if (ctrl == 0x140) src = (lane & ~15) | (15 - (lane & 15)); else src = (lane & ~3) | ((ctrl >> (2 * (lane & 3))) & 3);
    return __shfl(x, src); }
#else
DI float dpp_f(float x, int ctrl) { return x; }
#define dpp_f(x, ctrl) __builtin_bit_cast(float, __builtin_amdgcn_update_dpp(0, __builtin_bit_cast(int, (x)), (ctrl), 0xF, 0xF, true))
#endif
DI float row16_sum(float x) { x += dpp_f(x, 0xB1); x += dpp_f(x, 0x4E); x += dpp_f(x, 0x141); x += dpp_f(x, 0x140); return x; }
DI float wave_sum(float v) {
#pragma unroll
    for (int o = 1; o < 64; o <<= 1) v += __shfl_xor(v, o);
    return v;
}

namespace pg8 {
constexpr int BM = 256, BK = 64, HALF = 128, HTB = HALF * BK * 2, STAGE_BYTES = 8 * HTB, NXCD = 8, WGM = 4;
__host__ __device__ __forceinline__ int lds_byte(int r, int c) { const int st = (r >> 4) * 2 + (c >> 5), rr = r & 15, cc = c & 31, ob = rr * 64 + cc * 2; return st * 1024 + (ob ^ (((ob >> 9) & 1) << 5)); }
__host__ __device__ __forceinline__ void stage_rc(int b, int& R, int& C) { const int st = b / 1024, sb = b % 1024, swz = sb ^ (((sb >> 9) & 1) << 5); R = (st >> 1) * 16 + swz / 64; C = (st & 1) * 32 + (swz % 64) / 2; }
__host__ __device__ __forceinline__ int perm32(int rho) { const int n = rho >> 4, i = rho & 15; return 8 * (i >> 2) + 4 * n + (i & 3); }
struct Unit { int pm, pn, ks; };
struct Gemm { const bf16_t* A; const bf16_t* Bt; int lda, ldb, K, a_col_pn; };
struct StaticOrder {
    int nM, nN, nwg, G, c, base, limit;
    __host__ __device__ void init(int nM_, int nN_, int G_, int c_) { nM = nM_; nN = nN_; nwg = nM * nN; G = G_; c = c_; base = 0; limit = nwg; }
    __host__ __device__ void range(int base_, int limit_) { base = base_; limit = limit_; }
    __host__ __device__ bool next(int i, Unit& u) const {
        const long L = base + (long)i * G + c; if (L >= limit) return false;
        int wgid = (int)L; { const int q = nwg / NXCD, r = nwg % NXCD, xcd = wgid % NXCD, off = wgid / NXCD; wgid = (xcd < r ? xcd * (q + 1) : r * (q + 1) + (xcd - r) * q) + off; }
        const int nig = WGM * nN, gid = wgid / nig, fm = gid * WGM, gsz = (nM - fm) < WGM ? (nM - fm) : WGM;
        u.pm = fm + ((wgid % nig) % gsz); u.pn = (wgid % nig) / gsz; u.ks = 0; return true;
    }
};
struct FoldOrder {
    int nL, ksl, G, c;
    __host__ __device__ void init(int nL_, int ksl_, int G_, int c_) { nL = nL_; ksl = ksl_; G = G_; c = c_; }
    __host__ __device__ bool next(int i, Unit& u) const { const long L = (long)i * G + c; if (L >= (long)nL * 32) return false; const int r = (int)(L % 32); u.pm = r % 8; u.pn = r / 8; u.ks = (int)(L / 32) * ksl; return true; }
};
struct SplitKOrder {
    int nM, nN, nS, G, c;
    __host__ __device__ void init(int nM_, int nN_, int nS_, int G_, int c_) { nM = nM_; nN = nN_; nS = nS_; G = G_; c = c_; }
    __host__ __device__ bool next(int i, Unit& u) const { const long L = (long)i * G + c; if (L >= (long)nM * nN * nS) return false; u.ks = (int)(L % nS); u.pn = (int)((L / nS) % nN); u.pm = (int)(L / ((long)nS * nN)); return true; }
};
#ifndef EMU
#define PG8_LAS __attribute__((address_space(3)))
template <class Epi, class Sched, bool ALIGN_EPI = false, bool SP2 = false>
__device__ __forceinline__ void gemm_phase(PG8_LAS unsigned char* lds, const Gemm g, const Sched& S, const Epi& E, const int tid_) {
    const int tid = tid_, wid = __builtin_amdgcn_readfirstlane(tid >> 6), lane = tid & 63, wr = wid >> 2, wc = wid & 3, fr = lane & 15, fq = lane >> 4;
    const int K = g.K, nt = K / BK;
    unsigned voffA[2], voffB[2];
#pragma unroll
    for (int i = 0; i < 2; ++i) { int R, C; stage_rc(tid * 16 + i * 8192, R, C); const int Rb = Epi::PERM ? ((R & ~31) + perm32(R & 31)) : R;
        voffA[i] = (unsigned)(R * g.lda + C) * 2u; voffB[i] = (unsigned)(Rb * g.ldb + C) * 2u; }
    const size_t kstep = (size_t)(BK * 2);
    const size_t hstepA = (size_t)HALF * g.lda * 2, hstepB = (size_t)HALF * g.ldb * 2;
    const unsigned ldsw = (unsigned)wid * 1024u;
    const int aoff = lds_byte(wr * 64 + fr, fq * 8), boff = lds_byte(wc * 32 + fr, fq * 8);
#define PG8_SA(b, h) (((b) * 2 + (h)) * HTB)
#define PG8_SB(b, h) ((4 + (b) * 2 + (h)) * HTB)
#define PG8_STAGE(bufoff, gbase, voff) do { _Pragma("unroll") for (int _i = 0; _i < 2; ++_i) \
        __builtin_amdgcn_global_load_lds((const unsigned*)((const char*)(gbase) + (voff)[_i]), (PG8_LAS unsigned*)(lds + (bufoff) + ldsw + _i * 8192), 16, 0, 0); } while (0)
#define PG8_LDA(dst, b, h) do { _Pragma("unroll") for (int m = 0; m < 4; ++m) _Pragma("unroll") for (int k = 0; k < 2; ++k) dst[m][k] = *(const PG8_LAS bf16x8*)(lds + PG8_SA(b, h) + aoff + m * 2048 + k * 1024); } while (0)
#define PG8_LDB(dst, b, h) do { _Pragma("unroll") for (int n = 0; n < 2; ++n) _Pragma("unroll") for (int k = 0; k < 2; ++k) dst[n][k] = *(const PG8_LAS bf16x8*)(lds + PG8_SB(b, h) + boff + n * 2048 + k * 1024); } while (0)
#define PG8_MMA(ai, bj, At, Bt) do { __builtin_amdgcn_s_setprio(1); _Pragma("unroll") for (int m = 0; m < 4; ++m) _Pragma("unroll") for (int n = 0; n < 2; ++n) _Pragma("unroll") for (int k = 0; k < 2; ++k) \
        acc[ai][bj][m][n] = __builtin_amdgcn_mfma_f32_16x16x32_bf16(Bt[n][k], At[m][k], acc[ai][bj][m][n], 0, 0, 0); __builtin_amdgcn_s_setprio(0); } while (0)
#define PG8_WAIT_V(n) asm volatile("s_waitcnt vmcnt(" #n ")" ::: "memory")
#define PG8_WAIT_L(n) asm volatile("s_waitcnt lgkmcnt(" #n ")" ::: "memory")
#define PG8_BAR __builtin_amdgcn_s_barrier()
#define PG8_SCHED __builtin_amdgcn_sched_barrier(0)
#define PG8_APTR(u) ((const char*)g.A + ((size_t)(u).pm * BM * g.lda + (size_t)(u).pn * g.a_col_pn + (size_t)(u).ks * g.K) * 2)
#define PG8_BPTR(u) ((const char*)g.Bt + ((size_t)(u).pn * BM * g.ldb + (size_t)(u).ks * g.K) * 2)
    Unit cur, nxt; int ui = 0;
    if (!S.next(0, cur)) return;
    f32x4 acc[2][2][4][2];
#pragma unroll
    for (int a = 0; a < 2; ++a)
#pragma unroll
        for (int b = 0; b < 2; ++b)
#pragma unroll
            for (int m = 0; m < 4; ++m)
#pragma unroll
                for (int n = 0; n < 2; ++n) acc[a][b][m][n] = (f32x4){0.f, 0.f, 0.f, 0.f};
    bf16x8 At[4][2], B0[2][2], B1[2][2];
    const char* cA = PG8_APTR(cur); const char* cB = PG8_BPTR(cur);
    if constexpr (SP2) {
        PG8_STAGE(PG8_SB(0, 0), cB, voffB); PG8_STAGE(PG8_SB(0, 1), cB + hstepB, voffB); PG8_STAGE(PG8_SA(0, 0), cA, voffA); PG8_STAGE(PG8_SA(0, 1), cA + hstepA, voffA);
        if (wr == 1) PG8_BAR;
        PG8_WAIT_V(2); PG8_BAR;
        PG8_STAGE(PG8_SB(1, 0), cB + kstep, voffB); PG8_STAGE(PG8_SA(1, 0), cA + kstep, voffA); PG8_STAGE(PG8_SB(1, 1), cB + hstepB + kstep, voffB);
        PG8_WAIT_V(6); PG8_BAR;
    } else {
        PG8_STAGE(PG8_SB(0, 0), cB, voffB); PG8_STAGE(PG8_SA(0, 0), cA, voffA); PG8_STAGE(PG8_SB(0, 1), cB + hstepB, voffB); PG8_STAGE(PG8_SA(0, 1), cA + hstepA, voffA);
        if (wr == 1) PG8_BAR;
        PG8_WAIT_V(4); PG8_BAR;
        PG8_STAGE(PG8_SB(1, 0), cB + kstep, voffB); PG8_STAGE(PG8_SA(1, 0), cA + kstep, voffA); PG8_STAGE(PG8_SB(1, 1), cB + hstepB + kstep, voffB);
        PG8_WAIT_V(6); PG8_BAR;
    }
    for (;;) {
        const bool has_next = S.next(ui + 1, nxt);
        const char* nA = has_next ? PG8_APTR(nxt) : cA; const char* nB = has_next ? PG8_BPTR(nxt) : cB;
#pragma unroll 1
        for (int t = 0; t < nt; t += 2) {
            const bool last = (t == nt - 2);
            const char* a1 = cA + (size_t)(t + 1) * kstep;
            const char* a2 = last ? nA : cA + (size_t)(t + 2) * kstep; const char* b2 = last ? nB : cB + (size_t)(t + 2) * kstep;
            const char* a3 = a2 + kstep; const char* b3 = b2 + kstep;
            if constexpr (SP2) {
            PG8_LDB(B0, 0, 0); PG8_LDB(B1, 0, 1); PG8_SCHED; PG8_LDA(At, 0, 0); PG8_STAGE(PG8_SA(1, 1), a1 + hstepA, voffA);
            PG8_WAIT_V(8); PG8_WAIT_L(0); PG8_BAR; PG8_MMA(0, 0, At, B0); PG8_MMA(0, 1, At, B1); PG8_BAR; PG8_SCHED;
            PG8_LDA(At, 0, 1); PG8_STAGE(PG8_SB(0, 0), b2, voffB); PG8_STAGE(PG8_SB(0, 1), b2 + hstepB, voffB); PG8_STAGE(PG8_SA(0, 0), a2, voffA);
            PG8_WAIT_V(8); PG8_WAIT_L(0); PG8_BAR; PG8_MMA(1, 0, At, B0); PG8_MMA(1, 1, At, B1); PG8_BAR; PG8_SCHED;
            PG8_LDB(B0, 1, 0); PG8_LDB(B1, 1, 1); PG8_SCHED; PG8_LDA(At, 1, 0); PG8_STAGE(PG8_SA(0, 1), a2 + hstepA, voffA);
            PG8_WAIT_V(8); PG8_WAIT_L(0); PG8_BAR; PG8_MMA(0, 0, At, B0); PG8_MMA(0, 1, At, B1); PG8_BAR; PG8_SCHED;
            PG8_LDA(At, 1, 1); PG8_STAGE(PG8_SB(1, 0), b3, voffB); PG8_STAGE(PG8_SB(1, 1), b3 + hstepB, voffB); PG8_STAGE(PG8_SA(1, 0), a3, voffA);
            PG8_WAIT_V(8); PG8_WAIT_L(0); PG8_BAR; PG8_MMA(1, 0, At, B0); PG8_MMA(1, 1, At, B1); PG8_BAR; PG8_SCHED;
            } else {
            PG8_LDB(B0, 0, 0); PG8_SCHED; PG8_LDA(At, 0, 0); PG8_STAGE(PG8_SA(1, 1), a1 + hstepA, voffA);
            PG8_WAIT_L(8); PG8_BAR; PG8_WAIT_L(0); PG8_MMA(0, 0, At, B0); PG8_BAR; PG8_SCHED;
            PG8_LDB(B1, 0, 1); PG8_STAGE(PG8_SB(0, 0), b2, voffB);
            PG8_BAR; PG8_WAIT_L(0); PG8_MMA(0, 1, At, B1); PG8_BAR;
            PG8_LDA(At, 0, 1); PG8_STAGE(PG8_SA(0, 0), a2, voffA);
            PG8_BAR; PG8_WAIT_L(0); PG8_MMA(1, 0, At, B0); PG8_BAR; PG8_SCHED;
            PG8_STAGE(PG8_SB(0, 1), b2 + hstepB, voffB);
            PG8_WAIT_V(6); PG8_BAR; PG8_MMA(1, 1, At, B1); PG8_BAR;
            PG8_LDB(B0, 1, 0); PG8_SCHED; PG8_LDA(At, 1, 0); PG8_STAGE(PG8_SA(0, 1), a2 + hstepA, voffA);
            PG8_WAIT_L(8); PG8_BAR; PG8_WAIT_L(0); PG8_MMA(0, 0, At, B0); PG8_BAR; PG8_SCHED;
            PG8_LDB(B1, 1, 1); PG8_STAGE(PG8_SB(1, 0), b3, voffB);
            PG8_BAR; PG8_WAIT_L(0); PG8_MMA(0, 1, At, B1); PG8_BAR;
            PG8_LDA(At, 1, 1); PG8_STAGE(PG8_SA(1, 0), a3, voffA);
            PG8_BAR; PG8_WAIT_L(0); PG8_MMA(1, 0, At, B0); PG8_BAR; PG8_SCHED;
            PG8_STAGE(PG8_SB(1, 1), b3 + hstepB, voffB);
            PG8_WAIT_V(6); PG8_BAR; PG8_MMA(1, 1, At, B1); PG8_BAR;
            }
        }
        if constexpr (ALIGN_EPI) { if (wr == 0) PG8_BAR; }
        E(acc, cur, wr, wc, fr, fq);
        if (!has_next) break;
#pragma unroll
        for (int a = 0; a < 2; ++a)
#pragma unroll
            for (int b = 0; b < 2; ++b)
#pragma unroll
                for (int m = 0; m < 4; ++m)
#pragma unroll
                    for (int n = 0; n < 2; ++n) acc[a][b][m][n] = (f32x4){0.f, 0.f, 0.f, 0.f};
        cur = nxt; cA = nA; cB = nB; ++ui;
        if constexpr (ALIGN_EPI) { if (wr == 1) PG8_BAR; }
    }
    PG8_WAIT_V(0);
    if constexpr (!ALIGN_EPI) { if (wr == 0) PG8_BAR; }
    PG8_BAR;
#undef PG8_SA
#undef PG8_SB
#undef PG8_STAGE
#undef PG8_LDA
#undef PG8_LDB
#undef PG8_MMA
#undef PG8_WAIT_V
#undef PG8_WAIT_L
#undef PG8_BAR
#undef PG8_SCHED
#undef PG8_APTR
#undef PG8_BPTR
}
#else
static thread_local float* emu_tile = nullptr;
template <class Epi, class Sched, bool ALIGN_EPI = false, bool SP2 = false>
static void gemm_phase(unsigned char* lds, const Gemm g, const Sched& S, const Epi& E, const int tid_) {
    const int tid = tid_, wid = tid >> 6, lane = tid & 63, wr = wid >> 2, wc = wid & 3, fr = lane & 15, fq = lane >> 4;
    if (!emu_tile) emu_tile = (float*)malloc(256 * 256 * 4);
    Unit u;
    for (int i = 0; S.next(i, u); ++i) {
        const bf16_t* A = g.A + (size_t)u.pm * BM * g.lda + (size_t)u.pn * g.a_col_pn + (size_t)u.ks * g.K; const bf16_t* Bt = g.Bt + (size_t)u.pn * BM * g.ldb + (size_t)u.ks * g.K;
        { const int r = tid >> 1, c0 = (tid & 1) * 128; std::vector<float> ar(g.K); for (int k = 0; k < g.K; ++k) ar[k] = bf2f(A[(size_t)r * g.lda + k]);
          for (int c = c0; c < c0 + 128; ++c) { const bf16_t* br = Bt + (size_t)c * g.ldb; float s0 = 0, s1 = 0, s2 = 0, s3 = 0; for (int k = 0; k < g.K; k += 4) { s0 += ar[k] * bf2f(br[k]); s1 += ar[k + 1] * bf2f(br[k + 1]); s2 += ar[k + 2] * bf2f(br[k + 2]); s3 += ar[k + 3] * bf2f(br[k + 3]); } emu_tile[r * 256 + c] = (s0 + s1) + (s2 + s3); } }
        __syncthreads();
        f32x4 acc[2][2][4][2];
        for (int ai = 0; ai < 2; ++ai) for (int bj = 0; bj < 2; ++bj) for (int m = 0; m < 4; ++m) for (int n = 0; n < 2; ++n) for (int e = 0; e < 4; ++e) {
            const int r = 128 * ai + 64 * wr + 16 * m + fr; const int c = Epi::PERM ? (128 * bj + 32 * wc + 8 * fq + 4 * n + e) : (128 * bj + 32 * wc + 16 * n + 4 * fq + e);
            acc[ai][bj][m][n][e] = emu_tile[r * 256 + c]; }
        E(acc, u, wr, wc, fr, fq);
        __syncthreads();
    }
}
#endif
}

constexpr size_t al256(size_t x) { return (x + 255) & ~(size_t)255; }
constexpr size_t WS_CTL = 0, CTL_BYTES = 1u << 15;
constexpr size_t WS_MOD = WS_CTL + CTL_BYTES;
constexpr size_t SZ_MOD = al256((size_t)DEPTH * 3 * 6 * D * 4);
constexpr int ADA_KC = 16;
constexpr size_t WS_ADAP = WS_MOD + SZ_MOD;
constexpr size_t SZ_ADAP = al256((size_t)DEPTH * ADA_KC * 3 * 6 * D * 4);
constexpr size_t WL_WIN = 0, WL_WOUT = WL_WIN + (size_t)INWP * D * 2, WL_WGU = WL_WOUT + (size_t)D * D * 2, WL_WDN = WL_WGU + (size_t)2 * DFF * D * 2,
                 WL_GUP = WL_WDN + (size_t)D * DFF * 2, WL_POOL = WL_GUP + (size_t)RW * GL * 2, WL_DUP = WL_POOL + (size_t)4 * PG * PG * 2,
                 WL_IUP = WL_DUP + (size_t)2 * RW * LORA * 2, WL_SIZE = al256(WL_IUP + (size_t)2 * RW * LORA * 2);
constexpr size_t WS_W = WS_ADAP + SZ_ADAP;
constexpr size_t WS_XN = WS_W + WL_SIZE * DEPTH;
constexpr size_t WS_MIX = WS_XN + (size_t)MR * D * 2;
constexpr size_t WS_CTXH = WS_MIX + (size_t)MR * D * 2;
constexpr size_t WS_SSEG = WS_CTXH + (size_t)MC * D * 4;
constexpr size_t SZ_ST = (size_t)NB * NH * 2 * NSEG * 4096 * 4;
constexpr size_t WS_PSEG = WS_SSEG + SZ_ST, WS_HIN = WS_PSEG + SZ_ST;
constexpr size_t WS_BS = WS_HIN + SZ_ST;
constexpr size_t WS_BIG = al256(WS_BS + (size_t)2 * MR * NH * 4);
constexpr size_t WS_U = WS_BIG;
constexpr size_t WS_YF = WS_U + (size_t)MR * INWP * 2;
constexpr size_t WS_XB = WS_YF + (size_t)2 * MR * RW * 2;
static_assert((size_t)ML * D * 2 <= (size_t)2 * MR * RW * 2 && WS_XB >= WS_U + (size_t)MR * DFF * 2, "XB placement");
constexpr size_t WS_G = WS_YF + (size_t)2 * MR * RW * 4;
constexpr size_t WS_PD = WS_G + (size_t)MR * RW * 2;
constexpr size_t WS_VS = WS_PD + (size_t)MR * PWD * 2;
constexpr int KSPLIT = 512, NPART_DN = DFF / KSPLIT, NPART_WO = D / KSPLIT;
constexpr size_t WS_PART = WS_VS + (size_t)ML * PWD * 2;
constexpr size_t WS_BIG_END1 = WS_PART + (size_t)NPART_DN * MC * D * 4;
static_assert(DFF % KSPLIT == 0 && D % KSPLIT == 0, "split-K slices");
constexpr size_t WS_H = WS_BIG;
constexpr size_t WS_BIG_END2 = WS_H + (size_t)MR * DFF * 2;
constexpr size_t WS_END = WS_BIG_END1 > WS_BIG_END2 ? WS_BIG_END1 : WS_BIG_END2;
constexpr int CW_BAR = 4096;

constexpr int IMG = 8192;
constexpr int M_RT = 0, M_AT = 1, M_KB = 2, M_BB = 3, M_VT = 4, N_IMG = 5;
constexpr int SET_BYTES = N_IMG * IMG;
constexpr int SCR_G = 2 * SET_BYTES, SCR_AI = SCR_G + 64 * 64 * 4;
constexpr int SC_GC = SCR_AI + 64 * 64 * 4;
constexpr int SC_PAR = SC_GC + 512;
constexpr int SC_SH = SC_PAR + 3072;
constexpr int MISC_OFF = (SC_SH + 16384) > 131072 ? (SC_SH + 16384) : 131072;
constexpr int LDS_BYTES = MISC_OFF + 512;
static_assert(LDS_BYTES <= 160 * 1024 && pg8::STAGE_BYTES <= MISC_OFF, "LDS");

#define XB_TMO      128
#define XB_XCNT(j)  (256  + 64 * (j))
#define XB_XSUB(j)  (1280 + 64 * (j))
#define XB_XGEN(j)  (2304 + 64 * (j))
#define XB_TOP      3328
#define XB_TOPGEN   3392
#define XCD_BAR_WORDS 3456
#define XB_SPIN_CAP (1u << 18)
#ifndef EMU
__device__ __forceinline__ unsigned xb_ld(unsigned* p)              { return __hip_atomic_load(p, __ATOMIC_RELAXED, __HIP_MEMORY_SCOPE_AGENT); }
__device__ __forceinline__ unsigned xb_add(unsigned* p, unsigned v) { return __hip_atomic_fetch_add(p, v, __ATOMIC_RELAXED, __HIP_MEMORY_SCOPE_AGENT); }
__device__ __forceinline__ unsigned xb_xcc_id() { return (unsigned)__builtin_amdgcn_s_getreg((3 << 11) | 20) & 0xFu; }
#define XB_SPIN(cond, bar) do { unsigned _sp = 0; while (cond) { __builtin_amdgcn_s_sleep(1); \
    if ((++_sp & 255u) == 0u) { if (xb_ld(&(bar)[XB_TMO])) break; if (_sp > XB_SPIN_CAP) { atomicAdd(&(bar)[XB_TMO], 1u); break; } } } } while (0)
struct XcdBarrier { unsigned* bar; unsigned x; volatile LAS unsigned* st; };
__device__ __forceinline__ XcdBarrier xcd_barrier_post(unsigned* bar, volatile LAS unsigned* st) {
    XcdBarrier b; b.bar = bar; b.x = xb_xcc_id(); b.st = st;
    if (threadIdx.x == 0) (void)xb_add(&bar[XB_XCNT(b.x)], 1u);
    return b;
}
__device__ __forceinline__ void xcd_barrier_complete(unsigned* bar, unsigned x, unsigned& nloc, unsigned& nx) {
    const unsigned G = gridDim.x * gridDim.y * gridDim.z;
    unsigned sum, cnt, mine, sp = 0u;
    for (;;) {
        sum = 0u; cnt = 0u; mine = 0u;
#pragma unroll
        for (unsigned j = 0; j < 16; ++j) { const unsigned c = xb_ld(&bar[XB_XCNT(j)]); sum += c; cnt += (c > 0u) ? 1u : 0u; mine = (j == x) ? c : mine; }
        if (sum == G) break;
        __builtin_amdgcn_s_sleep(1);
        if ((++sp & 255u) == 0u) { if (xb_ld(&bar[XB_TMO])) break; if (sp > XB_SPIN_CAP) { atomicAdd(&bar[XB_TMO], 1u); break; } }
    }
    nloc = mine > 0u ? mine : 1u; nx = cnt > 0u ? cnt : 1u;
}
__device__ __forceinline__ void xcd_barrier(const XcdBarrier& b, const bool t0) {
    asm volatile("s_waitcnt vmcnt(0)" ::: "memory");
    __syncthreads();
    if (t0) {
        unsigned* bar = b.bar;
        __builtin_amdgcn_s_waitcnt(0);
        unsigned nloc = b.st[0], nx = b.st[1];
        if (nloc == 0u) { xcd_barrier_complete(bar, b.x, nloc, nx); b.st[0] = nloc; b.st[1] = nx; }
        const unsigned old = xb_add(&bar[XB_XSUB(b.x)], 1u);
        const unsigned gen = old / nloc;
        if (old + 1u == (gen + 1u) * nloc) {
            __builtin_amdgcn_fence(__ATOMIC_RELEASE, "agent");
            asm volatile("s_waitcnt vmcnt(0)" ::: "memory");
            const unsigned og = xb_add(&bar[XB_TOP], 1u);
            const unsigned tg = og / nx;
            if (og + 1u == (tg + 1u) * nx) xb_add(&bar[XB_TOPGEN], 1u);
            else XB_SPIN(xb_ld(&bar[XB_TOPGEN]) == tg, bar);
            __builtin_amdgcn_fence(__ATOMIC_ACQUIRE, "agent");
            xb_add(&bar[XB_XGEN(b.x)], 1u);
            asm volatile("s_waitcnt vmcnt(0)" ::: "memory");
        } else {
            XB_SPIN(xb_ld(&bar[XB_XGEN(b.x)]) == gen, bar);
            __builtin_amdgcn_fence(__ATOMIC_ACQUIRE, "agent");
            asm volatile("s_waitcnt vmcnt(0)" ::: "memory");
        }
    }
    __syncthreads();
}
#else
struct XcdBarrier { unsigned* bar; };
static inline void xcd_barrier(const XcdBarrier&) { fprintf(stderr, "EMU: grid barrier not supported (use per-phase launches)\n"); abort(); }
#endif

struct Inputs {
    const float *x, *c, *ctx, *c_ctx, *ada_w, *ada_b, *norm_mix, *norm_ffn, *w_in, *conv_rkv, *decay_bias, *decay_up, *iclr_bias, *iclr_up, *gate_up,
        *k_k, *k_a, *r_k, *gn_w, *gn_b, *pool_w, *pool_scale, *w_out, *ffn_gate, *ffn_up, *ffn_down, *final_norm;
};
struct Args { Inputs in; float* out; unsigned char* ws; int ph_lo, ph_hi; };
struct Frame {
    LAS unsigned char* lds;
    int tid, lane, wave, vcu, G;
    float* out; unsigned char* ws;
};
DI bf16_t* wl_ptr(const Frame& F, int l, size_t off) { return (bf16_t*)(F.ws + WS_W + (size_t)l * WL_SIZE + off); }
DI const float* mod_ptr(const Frame& F, int l, int s, int j) { return (const float*)(F.ws + WS_MOD) + ((size_t)(l * 3 + s) * 6 + j) * D; }
DI int sample_of_row(int row) { return row < ML ? row / SEQ : 2; }

struct P0Desc { const float* W; bf16_t* WT; int N, ldo, dst_row0, k0, n0; };
DI void p0_load(const P0Desc& d, const int lane, float (&v)[32]) {
#pragma unroll
    for (int i = 0; i < 32; ++i) { const int kk = 2 * i + (lane >> 5); v[i] = d.W[(size_t)(d.k0 + kk) * d.N + d.n0 + (lane & 31)]; }
}
DI void p0_store(const P0Desc& d, const int lane, const float (&v)[32], LAS float* scr) {
#pragma unroll
    for (int i = 0; i < 32; ++i) { const int kk = 2 * i + (lane >> 5); scr[kk * 33 + (lane & 31)] = v[i]; }
    LDS_WAIT();
    const int c = lane & 7;
#pragma unroll
    for (int j = 0; j < 4; ++j) { const int n = (lane >> 3) + 8 * j; const LAS float* s = scr + (8 * c) * 33 + n;
        u32x4 o; o.x = pk2(s[0 * 33], s[1 * 33]); o.y = pk2(s[2 * 33], s[3 * 33]); o.z = pk2(s[4 * 33], s[5 * 33]); o.w = pk2(s[6 * 33], s[7 * 33]);
        *(u32x4*)(d.WT + (size_t)(d.dst_row0 + n) * d.ldo + d.k0 + 8 * c) = o; }
    LDS_WAIT();
}
constexpr int P0_I_WIN = (D / 64) * (INW / 32), P0_I_WOUT = (D / 64) * (D / 32), P0_I_G = (D / 64) * (DFF / 32), P0_I_DN = (DFF / 64) * (D / 32), P0_I_GUP = (GL / 64) * (RW / 32), P0_I_POOL = 4 * (PG / 64) * (PG / 32);
constexpr int P0_I_T = P0_I_WIN + P0_I_WOUT + 2 * P0_I_G + P0_I_DN + P0_I_GUP;
DI void p0_desc(const Frame& F, const CAS Inputs& IN_, const int it, P0Desc& d) {
    const int l = it / P0_I_T; int r = it % P0_I_T;
    if (r < P0_I_WIN) { const int nb = INW / 32, kb = r / nb, n0 = 32 * (r % nb); d = P0Desc{IN_.w_in + (size_t)l * D * INW, wl_ptr(F, l, WL_WIN), INW, D, n0, 64 * kb, n0}; return; } r -= P0_I_WIN;
    if (r < P0_I_WOUT) { const int nb = D / 32, kb = r / nb, n0 = 32 * (r % nb); d = P0Desc{IN_.w_out + (size_t)l * D * D, wl_ptr(F, l, WL_WOUT), D, D, n0, 64 * kb, n0}; return; } r -= P0_I_WOUT;
    if (r < 2 * P0_I_G) { const int up = r >= P0_I_G; if (up) r -= P0_I_G; const int nb = DFF / 32, kb = r / nb, n0 = 32 * (r % nb);
        d = P0Desc{(up ? IN_.ffn_up : IN_.ffn_gate) + (size_t)l * D * DFF, wl_ptr(F, l, WL_WGU), DFF, D, (n0 / 128) * 256 + (n0 % 128) + (up ? 128 : 0), 64 * kb, n0}; return; } r -= 2 * P0_I_G;
    if (r < P0_I_DN) { const int nb = D / 32, kb = r / nb, n0 = 32 * (r % nb); d = P0Desc{IN_.ffn_down + (size_t)l * DFF * D, wl_ptr(F, l, WL_WDN), D, DFF, n0, 64 * kb, n0}; return; } r -= P0_I_DN;
    { const int nb = RW / 32, kb = r / nb, n0 = 32 * (r % nb); d = P0Desc{IN_.gate_up + (size_t)l * GL * RW, wl_ptr(F, l, WL_GUP), RW, GL, n0, 64 * kb, n0}; }
}
DI void p0_convert_span(Frame& F, const CAS Inputs& IN_, const int l, const int r_lo, const int r_hi, const int w, const int NW) {
    LAS float* scr = (LAS float*)(F.lds + F.wave * 16384);
    const int end = l * P0_I_T + r_hi; int it0 = l * P0_I_T + r_lo + w, it1 = it0 + NW; P0Desc d0, d1; float v0[32], v1[32];
    if (it0 < end) { p0_desc(F, IN_, it0, d0); p0_load(d0, F.lane, v0); }
    d1 = d0;
    if (it1 < end) { p0_desc(F, IN_, it1, d1); p0_load(d1, F.lane, v1); }
    while (it0 < end) { const int it2 = it1 + NW; const bool h2 = it2 < end; P0Desc d2 = d1; float v2[32];
        if (h2) { p0_desc(F, IN_, it2, d2); p0_load(d2, F.lane, v2); }
        p0_store(d0, F.lane, v0, scr);
        d0 = d1;
#pragma unroll
        for (int i = 0; i < 32; ++i) v0[i] = v1[i];
        if (h2) { d1 = d2;
#pragma unroll
            for (int i = 0; i < 32; ++i) v1[i] = v2[i]; }
        it0 = it1; it1 = it2; }
}
constexpr int P0_R_WOUT0 = P0_I_WIN, P0_R_WOUT1 = P0_I_WIN + P0_I_WOUT, P0_R_A1 = P0_R_WOUT1 + P0_I_G;
#ifndef P0_DEFER
#define P0_DEFER 1
#endif
DI int conv_in(int G) { return (P0_DEFER && G % 8 == 0 && G >= 32) ? G / 16 : 0; }
DI int conv_up(int G) { return (P0_DEFER && G % 8 == 0 && G >= 32) ? G / 32 : 0; }
DI void phase_p0(Frame& F, const CAS Inputs& IN_) {
    const int gw = F.vcu * 8 + F.wave, NGW = F.G * 8;
    { const bool defer = conv_in(F.G) > 0;
      p0_convert_span(F, IN_, 0, 0, P0_I_T, gw, NGW);
      for (int l = 1; l < DEPTH; ++l) { if (defer) p0_convert_span(F, IN_, l, P0_R_WOUT0, P0_R_WOUT1, gw, NGW); else p0_convert_span(F, IN_, l, 0, P0_I_T, gw, NGW); } }
    for (int it = gw; it < P0_I_POOL * DEPTH; it += NGW) { const int l = it / P0_I_POOL; int r = it % P0_I_POOL;
        const int gi = r / ((PG / 64) * (PG / 32)); r %= (PG / 64) * (PG / 32); const int nb = PG / 32, kb = r / nb, n0 = 32 * (r % nb);
        const float* src = IN_.pool_w + ((size_t)l * 4 + gi) * PG * PG; bf16_t* dst = wl_ptr(F, l, WL_POOL) + (size_t)gi * PG * PG; const int co = n0 + (F.lane & 31); const float sc = IN_.pool_scale[(size_t)l * PWD + gi * PG + co];
#pragma unroll 8
        for (int i = 0; i < 32; ++i) { const int ci = 64 * kb + 2 * i + (F.lane >> 5); dst[(size_t)ci * PG + co] = (bf16_t)f2bf(src[(size_t)ci * PG + co] * sc); } }
    const int gt = F.vcu * 512 + F.tid, NGT = F.G * 512;
    for (int i = gt; i < DEPTH * (INWP - INW) * D / 8; i += NGT) { const int l = i / ((INWP - INW) * D / 8), r = i % ((INWP - INW) * D / 8);
        *(u32x4*)(wl_ptr(F, l, WL_WIN) + (size_t)INW * D + (size_t)r * 8) = (u32x4){0u, 0u, 0u, 0u}; }
    for (int i = gt; i < DEPTH * 2 * 2 * RW * LORA; i += NGT) { int r = i; const int k = r % LORA; r /= LORA; const int n = r % RW; r /= RW; const int d = r % 2; r /= 2; const int which = r % 2; const int l = r / 2;
        const float* src = (which ? IN_.iclr_up : IN_.decay_up) + (((size_t)l * 2 + d) * LORA + k) * RW + n;
        wl_ptr(F, l, which ? WL_IUP : WL_DUP)[((size_t)d * RW + n) * LORA + k] = (bf16_t)f2bf(*src); }
    constexpr int NJB = 6 * D / 256, KCH = D / ADA_KC;
    for (int it = gw; it < DEPTH * NJB * ADA_KC; it += NGW) {
        const int kc = it % ADA_KC, jb = (it / ADA_KC) % NJB, l = it / (ADA_KC * NJB);
        const float* w = IN_.ada_w + ((size_t)l * D + (size_t)kc * KCH) * 6 * D + jb * 256 + 4 * F.lane;
        f32x4 a0 = {0.f, 0.f, 0.f, 0.f}, a1 = a0, a2 = a0;
#pragma unroll 8
        for (int k = 0; k < KCH; ++k) { const int kk = kc * KCH + k; const f32x4 wv = *(const f32x4*)(w + (size_t)k * 6 * D);
            const float c0 = fsilu(IN_.c[kk]), c1 = fsilu(IN_.c[D + kk]), c2 = fsilu(IN_.c_ctx[kk]);
            a0 += wv * c0; a1 += wv * c1; a2 += wv * c2; }
        float* p = (float*)(F.ws + WS_ADAP) + (((size_t)l * ADA_KC + kc) * 3) * 6 * D + jb * 256 + 4 * F.lane;
        *(f32x4*)(p) = a0; *(f32x4*)(p + 6 * D) = a1; *(f32x4*)(p + 12 * D) = a2;
    }
}
DI void phase_p0b(Frame& F, const CAS Inputs& IN_) {
    const int gt = F.vcu * 512 + F.tid, NGT = F.G * 512;
    for (int i = gt; i < DEPTH * 3 * 6 * D; i += NGT) { const int j = i % (6 * D), s = (i / (6 * D)) % 3, l = i / (18 * D);
        float a = IN_.ada_b[(size_t)l * 6 * D + j];
        for (int kc = 0; kc < ADA_KC; ++kc) a += ((const float*)(F.ws + WS_ADAP))[(((size_t)l * ADA_KC + kc) * 3 + s) * 6 * D + j];
        ((float*)(F.ws + WS_MOD))[i] = a; }
}

DI void phase_norm(Frame& F, const CAS Inputs& IN_, int l, bool second, int nrows, const int nparts, const float* cbase, const float* cgate) {
    const int gw = F.vcu * 8 + F.wave, NGW = F.G * 8;
    const float* gvec = (second ? IN_.norm_ffn : IN_.norm_mix) + (size_t)l * D;
    bf16_t* XN = (bf16_t*)(F.ws + WS_XN);
    int row_first = gw;
    if (!(l == 0 && !second)) {
        const bf16_t* XB = (const bf16_t*)(F.ws + WS_XB);
        for (int row = gw; row < ML; row += 2 * NGW) {
            const int row1 = row + NGW; const bool has1 = row1 < ML;
            u32x4 w0[4], w1[4];
#pragma unroll
            for (int j2 = 0; j2 < 4; ++j2) { w0[j2] = *(const u32x4*)(XB + (size_t)row * D + 8 * (F.lane + 64 * j2)); w1[j2] = has1 ? *(const u32x4*)(XB + (size_t)row1 * D + 8 * (F.lane + 64 * j2)) : (u32x4){0u, 0u, 0u, 0u}; }
            float f0[4][8], f1[4][8]; float s0 = 0.f, s1 = 0.f;
#pragma unroll
            for (int j2 = 0; j2 < 4; ++j2) { unpack8(w0[j2], f0[j2]); unpack8(w1[j2], f1[j2]);
#pragma unroll
                for (int e = 0; e < 8; ++e) { s0 += f0[j2][e] * f0[j2][e]; s1 += f1[j2][e] * f1[j2][e]; } }
#pragma unroll
            for (int o = 1; o < 64; o <<= 1) { s0 += __shfl_xor(s0, o); s1 += __shfl_xor(s1, o); }
            const float rs0 = frsq(s0 * (1.f / D) + RMS_EPS), rs1 = frsq(s1 * (1.f / D) + RMS_EPS);
            const int sa = row / SEQ, sb = has1 ? row1 / SEQ : sa;
            const float* sh0 = mod_ptr(F, l, sa, second ? 3 : 0); const float* sc0 = mod_ptr(F, l, sa, second ? 4 : 1);
            const float* sh1 = mod_ptr(F, l, sb, second ? 3 : 0); const float* sc1 = mod_ptr(F, l, sb, second ? 4 : 1);
#pragma unroll
            for (int j2 = 0; j2 < 4; ++j2) { const int c = 8 * (F.lane + 64 * j2); float g8[8], o0[8], o1[8];
                { const f32x4 ga = *(const f32x4*)(gvec + c), gb = *(const f32x4*)(gvec + c + 4); g8[0] = ga[0]; g8[1] = ga[1]; g8[2] = ga[2]; g8[3] = ga[3]; g8[4] = gb[0]; g8[5] = gb[1]; g8[6] = gb[2]; g8[7] = gb[3]; }
                { const f32x4 a0 = *(const f32x4*)(sc0 + c), a1 = *(const f32x4*)(sc0 + c + 4), b0 = *(const f32x4*)(sh0 + c), b1 = *(const f32x4*)(sh0 + c + 4);
#pragma unroll
                  for (int e = 0; e < 4; ++e) { o0[e] = f0[j2][e] * rs0 * g8[e] * (a0[e] + 1.0f) + b0[e]; o0[4 + e] = f0[j2][4 + e] * rs0 * g8[4 + e] * (a1[e] + 1.0f) + b1[e]; } }
                *(u32x4*)(XN + (size_t)row * D + c) = pack8(o0);
                if (has1) { const f32x4 a0 = *(const f32x4*)(sc1 + c), a1 = *(const f32x4*)(sc1 + c + 4), b0 = *(const f32x4*)(sh1 + c), b1 = *(const f32x4*)(sh1 + c + 4);
#pragma unroll
                  for (int e = 0; e < 4; ++e) { o1[e] = f1[j2][e] * rs1 * g8[e] * (a0[e] + 1.0f) + b0[e]; o1[4 + e] = f1[j2][4 + e] * rs1 * g8[4 + e] * (a1[e] + 1.0f) + b1[e]; }
                  *(u32x4*)(XN + (size_t)row1 * D + c) = pack8(o1); } }
        }
        row_first = ML + gw;
    }
    for (int row = row_first; row < nrows; row += NGW) {
        const float* xr;
        const bool lat_bf = row < ML && !(l == 0 && !second);
        if (row < ML) xr = IN_.x + (size_t)row * D;
        else xr = (nparts > 0 ? cbase : ((l == 0 && !second) ? IN_.ctx : (const float*)(F.ws + WS_CTXH))) + (size_t)(row - ML) * D;
        const int s = sample_of_row(row);
        const float* sh = mod_ptr(F, l, s, second ? 3 : 0); const float* sc = mod_ptr(F, l, s, second ? 4 : 1);
        f32x4 v[8]; float ss = 0.f;
        if (lat_bf) { const bf16_t* xb = (const bf16_t*)(F.ws + WS_XB) + (size_t)row * D;
#pragma unroll
            for (int j2 = 0; j2 < 4; ++j2) { float f[8]; unpack8(*(const u32x4*)(xb + 8 * (F.lane + 64 * j2)), f); v[2 * j2] = (f32x4){f[0], f[1], f[2], f[3]}; v[2 * j2 + 1] = (f32x4){f[4], f[5], f[6], f[7]}; }
        } else {
#pragma unroll
            for (int j = 0; j < 8; ++j) v[j] = *(const f32x4*)(xr + 4 * (F.lane + 64 * j)); }
        if (row >= ML && nparts > 0) {
            const float* pp = (const float*)(F.ws + WS_PART) + (size_t)(row - ML) * D; float* xo = (float*)(F.ws + WS_CTXH) + (size_t)(row - ML) * D;
#pragma unroll
            for (int j = 0; j < 8; ++j) { const int c = 4 * (F.lane + 64 * j); f32x4 a = {0.f, 0.f, 0.f, 0.f};
                for (int k = 0; k < nparts; ++k) a += *(const f32x4*)(pp + (size_t)k * MC * D + c);
                v[j] += *(const f32x4*)(cgate + c) * a; *(f32x4*)(xo + c) = v[j]; }
        }
#pragma unroll
        for (int j = 0; j < 8; ++j) ss += (v[j].x * v[j].x + v[j].y * v[j].y) + (v[j].z * v[j].z + v[j].w * v[j].w);
        const float rs = frsq(wave_sum(ss) * (1.f / D) + RMS_EPS);
#pragma unroll
        for (int j = 0; j < 8; ++j) { const int c = lat_bf ? 8 * (F.lane + 64 * (j >> 1)) + 4 * (j & 1) : 4 * (F.lane + 64 * j); const f32x4 g = *(const f32x4*)(gvec + c), a = *(const f32x4*)(sc + c), b = *(const f32x4*)(sh + c);
            const f32x4 o = v[j] * rs * g * (a + 1.0f) + b; u32x2 w; w.x = pk2(o.x, o.y); w.y = pk2(o.z, o.w); *(u32x2*)(XN + (size_t)row * D + c) = w; }
    }
}
DI void phase_final_norm(Frame& F, const CAS Inputs& IN_) {
    const int gw = F.vcu * 8 + F.wave, NGW = F.G * 8;
    const bf16_t* XB = (const bf16_t*)(F.ws + WS_XB);
    for (int row0 = gw; row0 < ML; row0 += 4 * NGW) {
        u32x4 w[4][4];
#pragma unroll
        for (int r = 0; r < 4; ++r) { const int row = row0 + r * NGW; const bool ok = row < ML;
#pragma unroll
            for (int j2 = 0; j2 < 4; ++j2) w[r][j2] = ok ? *(const u32x4*)(XB + (size_t)row * D + 8 * (F.lane + 64 * j2)) : (u32x4){0u, 0u, 0u, 0u}; }
#pragma unroll
        for (int r = 0; r < 4; ++r) { const int row = row0 + r * NGW; if (row >= ML) break;
            float* xr = F.out + (size_t)row * D; f32x4 v[8]; float ss = 0.f;
#pragma unroll
            for (int j2 = 0; j2 < 4; ++j2) { float f[8]; unpack8(w[r][j2], f); v[2 * j2] = (f32x4){f[0], f[1], f[2], f[3]}; v[2 * j2 + 1] = (f32x4){f[4], f[5], f[6], f[7]}; }
#pragma unroll
            for (int j = 0; j < 8; ++j) ss += (v[j].x * v[j].x + v[j].y * v[j].y) + (v[j].z * v[j].z + v[j].w * v[j].w);
            const float rs = frsq(wave_sum(ss) * (1.f / D) + RMS_EPS);
#pragma unroll
            for (int j = 0; j < 8; ++j) { const int c = 8 * (F.lane + 64 * (j >> 1)) + 4 * (j & 1); *(f32x4*)(xr + c) = v[j] * rs * *(const f32x4*)(IN_.final_norm + c); }
        }
    }
}

struct EpiU {
    static constexpr bool PERM = true;
    bf16_t* O; int ldc; int act;
    DI void operator()(const f32x4 (&acc)[2][2][4][2], const pg8::Unit& u, int wr, int wc, int fr, int fq) const {
        const int row0 = u.pm * 256 + wr * 64 + fr, col0 = u.pn * 256 + wc * 32 + 8 * fq;
        const bool special = act && (col0 + 128 + 8 > OFF_W) && (col0 < OFF_POOL);
#pragma unroll
        for (int ai = 0; ai < 2; ++ai)
#pragma unroll
            for (int m = 0; m < 4; ++m) { bf16_t* rowp = O + (size_t)(row0 + ai * 128 + m * 16) * ldc + col0;
#pragma unroll
                for (int bj = 0; bj < 2; ++bj) { f32x4 v0 = acc[ai][bj][m][0], v1 = acc[ai][bj][m][1];
                    if (special) { const int c = col0 + bj * 128;
                        if (c >= OFF_W && c < OFF_A) {
#pragma unroll
                            for (int e = 0; e < 4; ++e) { v0[e] = ftanh(v0[e]); v1[e] = ftanh(v1[e]); } }
                        else if (c >= OFF_G && c < OFF_POOL) {
#pragma unroll
                            for (int e = 0; e < 4; ++e) { v0[e] = fsigmoid(v0[e]); v1[e] = fsigmoid(v1[e]); } } }
                    u32x4 w; w.x = pk2(v0[0], v0[1]); w.y = pk2(v0[2], v0[3]); w.z = pk2(v1[0], v1[1]); w.w = pk2(v1[2], v1[3]);
                    *(u32x4*)(rowp + bj * 128) = w; } }
    }
};
struct EpiFold {
    static constexpr bool PERM = true;
    bf16_t* O;
    DI void operator()(const f32x4 (&acc)[2][2][4][2], const pg8::Unit& u, int wr, int wc, int fr, int fq) const {
        const int row0 = u.pm * 256 + wr * 64 + fr, col0 = u.pn * 256 + wc * 32 + 8 * fq; bf16_t* Ol = O + (size_t)u.ks * PG;
#pragma unroll
        for (int ai = 0; ai < 2; ++ai)
#pragma unroll
            for (int m = 0; m < 4; ++m)
#pragma unroll
                for (int bj = 0; bj < 2; ++bj) { const f32x4 v0 = acc[ai][bj][m][0], v1 = acc[ai][bj][m][1];
                    u32x4 w; w.x = pk2(v0[0], v0[1]); w.y = pk2(v0[2], v0[3]); w.z = pk2(v1[0], v1[1]); w.w = pk2(v1[2], v1[3]);
                    *(u32x4*)(Ol + (size_t)(row0 + ai * 128 + m * 16) * D + col0 + bj * 128) = w; }
    }
};
struct EpiPool {
    static constexpr bool PERM = true;
    bf16_t* O; const float* scale;
    DI void operator()(const f32x4 (&acc)[2][2][4][2], const pg8::Unit& u, int wr, int wc, int fr, int fq) const {
        const int row0 = u.pm * 256 + wr * 64 + fr, col0 = u.pn * 256 + wc * 32 + 8 * fq;
#pragma unroll
        for (int bj = 0; bj < 2; ++bj) { const f32x4 s0 = *(const f32x4*)(scale + col0 + bj * 128), s1 = *(const f32x4*)(scale + col0 + bj * 128 + 4);
#pragma unroll
            for (int ai = 0; ai < 2; ++ai)
#pragma unroll
                for (int m = 0; m < 4; ++m) { bf16_t* rowp = O + (size_t)(row0 + ai * 128 + m * 16) * D + RW + col0;
                    const f32x4 v0 = acc[ai][bj][m][0] * s0, v1 = acc[ai][bj][m][1] * s1;
                    u32x4 w; w.x = pk2(v0[0], v0[1]); w.y = pk2(v0[2], v0[3]); w.z = pk2(v1[0], v1[1]); w.w = pk2(v1[2], v1[3]);
                    *(u32x4*)(rowp + bj * 128) = w; }
            CFENCE(); }
    }
};
struct EpiSwiglu {
    static constexpr bool PERM = true;
    bf16_t* O;
    DI void operator()(const f32x4 (&acc)[2][2][4][2], const pg8::Unit& u, int wr, int wc, int fr, int fq) const {
        const int row0 = u.pm * 256 + wr * 64 + fr, col0 = u.pn * 128 + wc * 32 + 8 * fq;
#pragma unroll
        for (int ai = 0; ai < 2; ++ai)
#pragma unroll
            for (int m = 0; m < 4; ++m) { f32x4 v0, v1;
#pragma unroll
                for (int e = 0; e < 4; ++e) { v0[e] = fsilu(acc[ai][0][m][0][e]) * acc[ai][1][m][0][e]; v1[e] = fsilu(acc[ai][0][m][1][e]) * acc[ai][1][m][1][e]; }
                u32x4 w; w.x = pk2(v0[0], v0[1]); w.y = pk2(v0[2], v0[3]); w.z = pk2(v1[0], v1[1]); w.w = pk2(v1[2], v1[3]);
                *(u32x4*)(O + (size_t)(row0 + ai * 128 + m * 16) * DFF + col0) = w; }
    }
};
struct EpiRes {
    static constexpr bool PERM = false;
    const float* base_l; float* out_l; long long dbase_c, dout_c; const float* gate0;
    DI void operator()(const f32x4 (&acc)[2][2][4][2], const pg8::Unit& u, int wr, int wc, int fr, int fq) const {
        const bool lat = u.pm < NPM_L; const int prow = lat ? u.pm * 256 : (u.pm - NPM_L) * 256;
        const float* base = (const float*)((const char*)base_l + (lat ? 0ll : dbase_c)); float* out = (float*)((char*)out_l + (lat ? 0ll : dout_c));
        const float* gv = gate0 + (size_t)(lat ? (u.pm * 256) / SEQ : 2) * 6 * D;
        const int row0 = prow + wr * 64 + fr, col0 = u.pn * 256 + wc * 32 + 4 * fq;
        f32x4 g4[2][2];
#pragma unroll
        for (int bj = 0; bj < 2; ++bj)
#pragma unroll
            for (int n = 0; n < 2; ++n) g4[bj][n] = *(const f32x4*)(gv + col0 + bj * 128 + n * 16);
#pragma unroll
        for (int ai = 0; ai < 2; ++ai)
#pragma unroll
            for (int m = 0; m < 4; ++m) { const size_t off = (size_t)(row0 + ai * 128 + m * 16) * D + col0;
#pragma unroll
                for (int bj = 0; bj < 2; ++bj)
#pragma unroll
                    for (int n = 0; n < 2; ++n) { const f32x4 b = *(const f32x4*)(base + off + bj * 128 + n * 16); *(f32x4*)(out + off + bj * 128 + n * 16) = b + g4[bj][n] * acc[ai][bj][m][n]; }
                CFENCE(); }
    }
};

#if PROBE_T && !defined(EMU)
#define TSTAMP(k) do { if (tid == 0) { volatile LAS unsigned* M_ = (volatile LAS unsigned*)(F.lds + MISC_OFF); const unsigned long long n_ = __builtin_amdgcn_s_memtime(); \
    const unsigned long long p_ = ((unsigned long long)M_[31] << 32) | M_[30]; if ((k) >= 0) M_[32 + ((k) < 0 ? 0 : (k))] += (unsigned)((n_ - p_) >> 4); M_[30] = (unsigned)n_; M_[31] = (unsigned)(n_ >> 32); } } while (0)
#else
#define TSTAMP(k) do {} while (0)
#endif
struct EpiResB {
    static constexpr bool PERM = true;
    const void* base; int base_f32; bf16_t* out; const float* gate0;
    DI void operator()(const f32x4 (&acc)[2][2][4][2], const pg8::Unit& u, int wr, int wc, int fr, int fq) const {
        const float* gv = gate0 + (size_t)((u.pm * 256) / SEQ) * 6 * D;
        const int row0 = u.pm * 256 + wr * 64 + fr, col0 = u.pn * 256 + wc * 32 + 8 * fq;
#pragma unroll
        for (int bj = 0; bj < 2; ++bj) { const f32x4 g0 = *(const f32x4*)(gv + col0 + bj * 128), g1 = *(const f32x4*)(gv + col0 + bj * 128 + 4);
#pragma unroll
            for (int ai = 0; ai < 2; ++ai)
#pragma unroll
                for (int m = 0; m < 4; ++m) { const size_t off = (size_t)(row0 + ai * 128 + m * 16) * D + col0 + bj * 128; float b[8];
                    if (base_f32) { const f32x4 b0 = *(const f32x4*)((const float*)base + off), b1 = *(const f32x4*)((const float*)base + off + 4); b[0] = b0[0]; b[1] = b0[1]; b[2] = b0[2]; b[3] = b0[3]; b[4] = b1[0]; b[5] = b1[1]; b[6] = b1[2]; b[7] = b1[3]; }
                    else unpack8(*(const u32x4*)((const bf16_t*)base + off), b);
                    const f32x4 v0 = acc[ai][bj][m][0] * g0, v1 = acc[ai][bj][m][1] * g1;
                    float o[8] = {b[0] + v0[0], b[1] + v0[1], b[2] + v0[2], b[3] + v0[3], b[4] + v1[0], b[5] + v1[1], b[6] + v1[2], b[7] + v1[3]};
                    *(u32x4*)(out + off) = pack8(o); }
            CFENCE(); }
    }
};
struct EpiPart {
    static constexpr bool PERM = false;
    float* P;
    DI void operator()(const f32x4 (&acc)[2][2][4][2], const pg8::Unit& u, int wr, int wc, int fr, int fq) const {
        const int row0 = u.pm * 256 + wr * 64 + fr, col0 = u.pn * 256 + wc * 32 + 4 * fq; float* base = P + (size_t)u.ks * MC * D;
#pragma unroll
        for (int ai = 0; ai < 2; ++ai)
#pragma unroll
            for (int m = 0; m < 4; ++m) { float* rowp = base + (size_t)(row0 + ai * 128 + m * 16) * D + col0;
#pragma unroll
                for (int bj = 0; bj < 2; ++bj)
#pragma unroll
                    for (int n = 0; n < 2; ++n) *(f32x4*)(rowp + bj * 128 + n * 16) = acc[ai][bj][m][n]; }
    }
};
DI int img_off(int r, int c) { return r * 128 + ((((c >> 3) ^ (r & 7)) << 4) | ((c & 7) << 1)); }
DI bf16x8 ldfrag(const LAS unsigned char* img, int r0, int k0, int lane) { const int r = r0 + (lane & 15), c = k0 + 8 * (lane >> 4); return *(const LAS bf16x8*)(img + r * 128 + (((c >> 3) ^ (r & 7)) << 4)); }
template <int KK> DI f32x4 tile_mm(f32x4 acc, const LAS unsigned char* X, int x0, const LAS unsigned char* Y, int y0, int lane) {
#pragma unroll
    for (int ks = 0; ks < KK / 32; ++ks) { const bf16x8 xf = ldfrag(X, x0, 32 * ks, lane), yf = ldfrag(Y, y0, 32 * ks, lane); acc = MFMA16(xf, yf, acc); }
    return acc;
}
DI void st_tile(LAS unsigned char* img, int yrow, int xcol, const f32x4& v) { u32x2 w; w.x = pk2(v[0], v[1]); w.y = pk2(v[2], v[3]); *(LAS u32x2*)(img + img_off(yrow, xcol)) = w; }
DI bf16x4 pack4b(const f32x4& v) { u32x2 w; w.x = pk2(v[0], v[1]); w.y = pk2(v[2], v[3]); return __builtin_bit_cast(bf16x4, w); }
DI f32x4 ld_tile(const LAS unsigned char* img, int yrow, int xcol) { const u32x2 w = *(const LAS u32x2*)(img + img_off(yrow, xcol)); return (f32x4){bflo(w.x), bfhi(w.x), bflo(w.y), bfhi(w.y)}; }

struct ScanItem { int b, h, dir, seg; };
DI int item_index(const ScanItem& it) { return ((it.b * NH + it.h) * 2 + it.dir) * NSEG + it.seg; }
struct SegGeom { int seqlen, rowbase, pos0; };
DI SegGeom chunk_geom(const ScanItem& it, int gch) { SegGeom g; if (gch < CTX / 64) { g.seqlen = CTX; g.rowbase = ML + it.b * CTX; g.pos0 = 64 * gch; } else { g.seqlen = SEQ; g.rowbase = it.b * SEQ; g.pos0 = 64 * (gch - CTX / 64); } return g; }

struct ScanAF { bf16x8 af[4][3]; };
struct ScanWB { bf16x8 bfr[2][3]; float lb[2]; };
DI void scan_issue_af(const bf16_t* U, const ScanItem& it, const SegGeom& sg, const int mat, const int lane, ScanAF& A) {
    const int q = lane >> 4, l15 = lane & 15;
#pragma unroll
    for (int mt = 0; mt < 4; ++mt) { const int qq = sg.pos0 + 16 * mt + l15; const int tau = it.dir ? sg.seqlen - 1 - qq : qq;
        const bf16_t* ur = U + (size_t)(sg.rowbase + tau) * INWP + (mat ? OFF_A : OFF_W) + 8 * q;
#pragma unroll
        for (int ks = 0; ks < 3; ++ks) A.af[mt][ks] = *(const bf16x8*)(ur + 32 * ks); }
}
DI void scan_load_wb(const bf16_t* Wl, const float* bias, const ScanItem& it, const int nt0, const int lane, ScanWB& W) {
    const int q = lane >> 4, l15 = lane & 15;
#pragma unroll
    for (int n2 = 0; n2 < 2; ++n2) { const int chn = it.h * 64 + 16 * (nt0 + n2) + l15;
#pragma unroll
        for (int ks = 0; ks < 3; ++ks) W.bfr[n2][ks] = *(const bf16x8*)(Wl + (size_t)chn * LORA + 8 * q + 32 * ks);
        W.lb[n2] = bias[chn]; }
}
DI void scan_stage0(LAS unsigned char* L, LAS float* GCo, const ScanAF& A, const ScanWB& W, const int mat, const int nt0, const int lane) {
    const int q = lane >> 4, l15 = lane & 15;
#pragma unroll
    for (int n2 = 0; n2 < 2; ++n2) {
        f32x4 a4[4];
#pragma unroll
        for (int mt = 0; mt < 4; ++mt) { a4[mt] = (f32x4){0.f, 0.f, 0.f, 0.f};
#pragma unroll
            for (int ks = 0; ks < 3; ++ks) a4[mt] = MFMA16(A.af[mt][ks], W.bfr[n2][ks], a4[mt]); }
        const int cc = 16 * (nt0 + n2) + l15;
        if (mat == 0) {
            LAS float* G = (LAS float*)(L + SCR_G);
            float cs[4][4], t1[4], t2[4], t3[4];
#pragma unroll
            for (int mt = 0; mt < 4; ++mt) {
#pragma unroll
                for (int e = 0; e < 4; ++e) cs[mt][e] = -0.8750387749145276f * fsigmoid(W.lb[n2] + a4[mt][e]);
                cs[mt][1] += cs[mt][0]; cs[mt][2] += cs[mt][1]; cs[mt][3] += cs[mt][2];
                t1[mt] = BPERM(cs[mt][3], lane - 16); t2[mt] = BPERM(cs[mt][3], lane - 32); t3[mt] = BPERM(cs[mt][3], lane - 48); }
            float run = 0.f;
#pragma unroll
            for (int mt = 0; mt < 4; ++mt) { const float off = run + (q >= 1 ? t1[mt] : 0.f) + (q >= 2 ? t2[mt] : 0.f) + (q >= 3 ? t3[mt] : 0.f);
                const int p0 = 16 * mt + 4 * q;
#pragma unroll
                for (int e = 0; e < 4; ++e) G[(p0 + e) * 64 + cc] = off + cs[mt][e];
                run += (cs[mt][3] + t1[mt]) + (t2[mt] + t3[mt]); }
            if (q == 0) GCo[cc] = fexp2(run);
        } else {
            LAS float* AI = (LAS float*)(L + SCR_AI);
#pragma unroll
            for (int mt = 0; mt < 4; ++mt) { const int p0 = 16 * mt + 4 * q;
#pragma unroll
                for (int e = 0; e < 4; ++e) AI[(p0 + e) * 64 + cc] = fsigmoid(W.lb[n2] + a4[mt][e]); }
        }
    }
}
struct ScanPF { u32x2 w[3][6]; };
DI void scan_issue_uu(const bf16_t* U, const ScanItem& it, const SegGeom& sg, int tidp, ScanPF& pf) {
    const int pg = tidp >> 4, cg = tidp & 15; const int qq0 = sg.pos0 + 4 * pg - 1;
#pragma unroll
    for (int t = 0; t < 6; ++t) { const int qq = qq0 + t; const int tau = it.dir ? sg.seqlen - 1 - qq : qq;
        const bf16_t* up = U + (long long)(sg.rowbase + tau) * INWP + it.h * 64 + 4 * cg;
#pragma unroll
        for (int x = 0; x < 3; ++x) pf.w[x][t] = *(const u32x2*)(up + x * RW); }
}
#ifndef PAIR_K16
#define PAIR_K16 0
#endif
DI bf16x8 cat8(const bf16x4& a, const bf16x4& b) { return __builtin_shufflevector(a, b, 0, 1, 2, 3, 4, 5, 6, 7); }
DI f32x4 tile_xy(const bf16x8 (&xf)[2], const bf16x8 (&yf)[2]) { f32x4 a = {0.f, 0.f, 0.f, 0.f}; a = MFMA16(xf[0], yf[0], a); a = MFMA16(xf[1], yf[1], a); return a; }
DI f32x4 mm_pair(const bf16x4& a0, const bf16x4& a1, const bf16x4& b0, const bf16x4& b1, f32x4 c) {
#if PAIR_K16
    c = MFMA16K16(a0, b0, c); return MFMA16K16(a1, b1, c);
#else
    return MFMA16(cat8(a0, a1), cat8(b0, b1), c);
#endif
}
DI bf16x4 lo4(const bf16x8& v) { return __builtin_shufflevector(v, v, 0, 1, 2, 3); }
DI bf16x4 hi4(const bf16x8& v) { return __builtin_shufflevector(v, v, 4, 5, 6, 7); }
DI f32x4 mm_pair_a8(const bf16x8& a, const bf16x4& b0, const bf16x4& b1, f32x4 c) {
#if PAIR_K16
    c = MFMA16K16(lo4(a), b0, c); return MFMA16K16(hi4(a), b1, c);
#else
    return MFMA16(a, cat8(b0, b1), c);
#endif
}
DI f32x4 mm_pair_b8(const bf16x4& a0, const bf16x4& a1, const bf16x8& b, f32x4 c) {
#if PAIR_K16
    c = MFMA16K16(a0, lo4(b), c); return MFMA16K16(a1, hi4(b), c);
#else
    return MFMA16(cat8(a0, a1), b, c);
#endif
}
DI void scan_stage1(LAS unsigned char* L, LAS unsigned char* S, LAS unsigned char* SH, const ScanItem& it, const SegGeom& sg, const int tidp, const ScanPF& pf, float* BS) {
    const int pg = tidp >> 4, cg = tidp & 15, p0 = 4 * pg; const int qq0 = sg.pos0 + p0;
    const bool lo_ok = qq0 > 0, hi_ok = qq0 + 4 < sg.seqlen;
    const bool edge = (sg.pos0 == 0) || (sg.pos0 + 64 >= sg.seqlen);
    const int ccol = 4 * ((cg & 8) | ((cg & 3) << 1) | ((cg >> 2) & 1));
    const LAS float* PAR = (const LAS float*)(L + SC_PAR) + 4 * cg;
    const LAS float* G = (const LAS float*)(L + SCR_G) + 4 * cg; const LAS float* AI = (const LAS float*)(L + SCR_AI) + 4 * cg;
    f32x4 egp;
    { f32x4 gp = {0.f, 0.f, 0.f, 0.f}; if (p0 > 0) gp = *(const LAS f32x4*)(G + (p0 - 1) * 64);
#pragma unroll
      for (int e = 0; e < 4; ++e) egp[e] = fexp2(gp[e]); }
    f32x4 par[12];
#pragma unroll
    for (int i = 0; i < 12; ++i) par[i] = *(const LAS f32x4*)(PAR + i * 64);
    const f32x4 kkp = par[9], kap = par[10], rkp = par[11];
#pragma unroll
    for (int j = 0; j < 4; ++j) {
        const int p = p0 + j; const int qq = qq0 + j; const int tau = it.dir ? sg.seqlen - 1 - qq : qq; const size_t row = (size_t)(sg.rowbase + tau);
        float r4[4], k4[4], v4[4];
#pragma unroll
        for (int x = 0; x < 3; ++x) {
            float a[4], b[4], c[4];
            unpack4(pf.w[x][j], a); unpack4(pf.w[x][j + 1], b); unpack4(pf.w[x][j + 2], c);
            if (edge) {
                if (j == 0) {
#pragma unroll
                    for (int e = 0; e < 4; ++e) a[e] = lo_ok ? a[e] : 0.f; }
                if (j == 3) {
#pragma unroll
                    for (int e = 0; e < 4; ++e) c[e] = hi_ok ? c[e] : 0.f; } }
            const f32x4 w0 = par[3 * x + 0], w1 = par[3 * x + 1], w2 = par[3 * x + 2];
            float* dst = x == 0 ? r4 : (x == 1 ? k4 : v4);
#pragma unroll
            for (int e = 0; e < 4; ++e) dst[e] = a[e] * w0[e] + b[e] * w1[e] + c[e] * w2[e];
        }
        float kk4[4]; float nn = 0.f;
#pragma unroll
        for (int e = 0; e < 4; ++e) { kk4[e] = k4[e] * kkp[e]; nn += kk4[e] * kk4[e]; }
        nn = row16_sum(nn);
        const float inv = frsq(fmaxf(nn, 1e-24f));
        const f32x4 g4 = *(const LAS f32x4*)(G + p * 64), a4 = *(const LAS f32x4*)(AI + p * 64);
        float rt[4], at[4], kb[4], bb[4]; float bsum = 0.f;
#pragma unroll
        for (int e = 0; e < 4; ++e) { const float kkn = kk4[e] * inv; const float kd = k4[e] * (1.0f + (a4[e] - 1.0f) * kap[e]); const float bh = kkn * a4[e];
            const float eg = fexp2(g4[e]), eng = fexp2(-g4[e]);
            rt[e] = r4[e] * eg; at[e] = -kkn * egp[e]; kb[e] = kd * eng; bb[e] = bh * eng; bsum += r4[e] * kd * rkp[e]; egp[e] = eg; }
        *(LAS u32x2*)(S + M_RT * IMG + img_off(p, ccol)) = pack4(rt);
        *(LAS u32x2*)(S + M_AT * IMG + img_off(p, ccol)) = pack4(at);
        *(LAS u32x2*)(S + M_KB * IMG + img_off(p, ccol)) = pack4(kb);
        *(LAS u32x2*)(S + M_BB * IMG + img_off(p, ccol)) = pack4(bb);
        *(LAS u32x2*)(S + M_VT * IMG + img_off(p, 4 * cg)) = pack4(v4);
        bsum = row16_sum(bsum); if (cg == 0) BS[row * NH + it.h] = bsum;
    }
    LDS_WAIT();
    { const int w = RFL(tidp >> 6), lane = tidp & 63, q = lane >> 4, l15 = lane & 15;
      bf16x8 at8[2], rt8[2], kb8[2], bb8[2];
#pragma unroll
      for (int ks = 0; ks < 2; ++ks) { at8[ks] = ldfrag(S + M_AT * IMG, 16 * w, 32 * ks, lane); rt8[ks] = ldfrag(S + M_RT * IMG, 16 * w, 32 * ks, lane); kb8[ks] = ldfrag(S + M_KB * IMG, 16 * w, 32 * ks, lane); bb8[ks] = ldfrag(S + M_BB * IMG, 16 * w, 32 * ks, lane); }
      f32x4 s_a = tile_xy(bb8, at8), s_b = tile_xy(at8, bb8), tak = tile_xy(kb8, at8), trk = tile_xy(kb8, rt8), trb = tile_xy(bb8, rt8);
#pragma unroll
      for (int e = 0; e < 4; ++e) { const bool st = 4 * q + e < l15, in = 4 * q + e <= l15; s_a[e] = st ? s_a[e] : 0.f; s_b[e] = (l15 < 4 * q + e) ? s_b[e] : 0.f; tak[e] = st ? tak[e] : 0.f; trk[e] = in ? trk[e] : 0.f; trb[e] = in ? trb[e] : 0.f; }
      LAS unsigned char* o = SH + w * 512 + lane * 8;
      *(LAS bf16x4*)(o + 1 * 2048) = pack4b(tak); *(LAS bf16x4*)(o + 2 * 2048) = pack4b(trk); *(LAS bf16x4*)(o + 3 * 2048) = pack4b(trb);
      const bf16x4 pa = pack4b(s_a), pb = pack4b(s_b); const f32x4 z4 = {0.f, 0.f, 0.f, 0.f};
#pragma unroll
      for (int e = 0; e < 4; ++e) { const float id = (4 * q + e == l15) ? 1.f : 0.f; s_a[e] += id; s_b[e] += id; }
      const f32x4 a2b = MFMA16K16(pa, pb, z4), a2a = MFMA16K16(pb, pa, z4);
      const bf16x4 p2b = pack4b(a2b), p2a = pack4b(a2a);
      { const bf16x4 sa = pack4b(s_a); s_b = MFMA16K16(sa, p2b, s_b); s_a = MFMA16K16(p2b, sa, s_a); }
      const f32x4 a4b = MFMA16K16(p2a, p2b, z4), a4a = MFMA16K16(p2b, p2a, z4);
      const bf16x4 p4b = pack4b(a4b), p4a = pack4b(a4a);
      { const bf16x4 sa = pack4b(s_a); s_b = MFMA16K16(sa, p4b, s_b); s_a = MFMA16K16(p4b, sa, s_a); }
      const bf16x4 p8b = pack4b(MFMA16K16(p4a, p4b, z4));
      s_a = MFMA16K16(p8b, pack4b(s_a), s_a);
      *(LAS bf16x4*)o = pack4b(s_a); (void)s_b; }
}
DI int lane_of(int tid) { return tid & 63; }
DI void scan_item(Frame& F, const CAS Inputs& IN_, int l, const ScanItem it) {
    int tid_i = F.tid; OPAQUE_V(tid_i);
    const int wave_i = RFL(tid_i >> 6);
    LAS unsigned char* L = F.lds;
    const int ch0 = seg_start(it.seg), nchunks = seg_start(it.seg + 1) - ch0;
    const bf16_t* U = (const bf16_t*)(F.ws + WS_U);
    if (tid_i < 192) { const int kx = tid_i >> 4, c4 = tid_i & 15; const float* src;
        if (kx < 9) { const int tap = kx % 3; src = IN_.conv_rkv + (size_t)l * 9 * RW + (size_t)(it.dir ? 2 - tap : tap) * 3 * RW + (kx / 3) * RW + it.h * 64 + 4 * c4; }
        else src = (kx == 9 ? IN_.k_k : (kx == 10 ? IN_.k_a : IN_.r_k)) + (size_t)l * RW + it.h * 64 + 4 * c4;
        *(LAS f32x4*)(L + SC_PAR + (kx * 64 + 4 * c4) * 4) = *(const f32x4*)src; }
    if (wave_i >= 4) {
        const int mat = (wave_i >> 1) & 1, nt0 = 2 * (wave_i & 1);
        const bf16_t* Wl = wl_ptr(F, l, mat ? WL_IUP : WL_DUP) + (size_t)it.dir * RW * LORA;
        const float* lbias = (mat ? IN_.iclr_bias : IN_.decay_bias) + ((size_t)l * 2 + it.dir) * RW;
        float* BS = (float*)(F.ws + WS_BS) + (size_t)it.dir * MR * NH;
        ScanPF pf; ScanAF af; ScanWB wb;
        scan_load_wb(Wl, lbias, it, nt0, lane_of(tid_i), wb);
        { const SegGeom sg0 = chunk_geom(it, ch0); scan_issue_af(U, it, sg0, mat, lane_of(tid_i), af); }
#if SCAN_PRIO == 2 && !defined(EMU)
        __builtin_amdgcn_s_setprio(1);
#endif
        for (int k = 0; k <= nchunks; ++k) {
            int tid_o = F.tid; OPAQUE_V(tid_o);
            const int tidp = tid_o - 256, lane = tid_o & 63;
            const bool cur = k < nchunks, nxt = k + 1 < nchunks;
            const SegGeom sg = chunk_geom(it, ch0 + k);
            if (cur) { scan_issue_uu(U, it, sg, tidp, pf);
                scan_stage0(L, (LAS float*)(L + SC_GC) + 64 * (k & 1), af, wb, mat, nt0, lane); }
            LDS_WAIT(); WG_BAR();
            if (nxt) { const SegGeom sgn = chunk_geom(it, ch0 + k + 1); scan_issue_af(U, it, sgn, mat, lane, af); }
            if (cur) scan_stage1(L, L + (k & 1) * SET_BYTES, L + SC_SH + (k & 1) * 8192, it, sg, tidp, pf, BS);
            LDS_WAIT(); WG_BAR();
        }
#if SCAN_PRIO == 2 && !defined(EMU)
        __builtin_amdgcn_s_setprio(0);
#endif
        return;
    }
    const int lane_i = tid_i & 63;
    f32x4 H[2][4];
    const size_t st_off = (size_t)item_index(it) * 4096;
    { const int q = lane_i >> 4, l15 = lane_i & 15;
#pragma unroll
      for (int kt = 0; kt < 4; ++kt) { H[0][kt] = (f32x4){0.f, 0.f, 0.f, 0.f};
#pragma unroll
        for (int e = 0; e < 4; ++e) H[1][kt][e] = (16 * wave_i + l15 == 16 * kt + 4 * q + e) ? 1.f : 0.f; } }
    bf16_t* YO = (bf16_t*)(F.ws + WS_YF) + (size_t)it.dir * MR * RW;
    bf16_t* MCo = (bf16_t*)(F.ws + WS_XN) + (size_t)it.dir * MR * RW;
    LDS_WAIT(); WG_BAR();
    LDS_WAIT(); WG_BAR();
#if SCAN_PRIO == 1 && !defined(EMU)
    __builtin_amdgcn_s_setprio(1);
#endif
    for (int c = 0; c < nchunks; ++c) {
        const SegGeom sg = chunk_geom(it, ch0 + c);
        int tid_o = F.tid; OPAQUE_V(tid_o);
        const int lane = tid_o & 63, cb = RFL(tid_o >> 6), q = lane >> 4, l15 = lane & 15;
        const int qpos0 = sg.pos0;
        const LAS unsigned char* S = L + (c & 1) * SET_BYTES;
        const LAS unsigned char* SH = L + SC_SH + (c & 1) * 8192;
        bf16x4 vb[4], hb[2][4], ub[2][4];
        {
            bf16x8 at8[4][2], kb8[4][2], bb8[4][2]; bf16x4 aakf[10], aabf[6], df[4];
#pragma unroll
            for (int pt = 0; pt < 4; ++pt) vb[pt] = LDS_TR16(S + M_VT * IMG + img_off(16 * pt + 4 * q + (l15 >> 2), 16 * cb + 4 * (l15 & 3)));
#pragma unroll
            for (int i = 0; i < 4; ++i)
#pragma unroll
                for (int ks = 0; ks < 2; ++ks) { at8[i][ks] = ldfrag(S + M_AT * IMG, 16 * i, 32 * ks, lane); kb8[i][ks] = ldfrag(S + M_KB * IMG, 16 * i, 32 * ks, lane); bb8[i][ks] = ldfrag(S + M_BB * IMG, 16 * i, 32 * ks, lane); }
#pragma unroll
            for (int i = 0; i < 4; ++i) { aakf[(i * (i + 1)) / 2 + i] = *(const LAS bf16x4*)(SH + 1 * 2048 + i * 512 + lane * 8); df[i] = *(const LAS bf16x4*)(SH + i * 512 + lane * 8); }
#pragma unroll
            for (int b2 = 0; b2 < 2; ++b2)
#pragma unroll
                for (int kt = 0; kt < 4; ++kt) hb[b2][kt] = pack4b(H[b2][kt]);
            LDS_WAIT(); SCHED_BAR();
#pragma unroll
            for (int i = 1; i < 4; ++i)
#pragma unroll
                for (int jt = 0; jt < i; ++jt) { aakf[(i * (i + 1)) / 2 + jt] = pack4b(tile_xy(kb8[jt], at8[i])); aabf[(i * (i - 1)) / 2 + jt] = pack4b(tile_xy(bb8[jt], at8[i])); }
            SCHED_BAR();
#pragma unroll
            for (int i = 0; i < 4; ++i) {
#pragma unroll
                for (int b2 = 0; b2 < 2; ++b2) { f32x4 a = {0.f, 0.f, 0.f, 0.f}, t = {0.f, 0.f, 0.f, 0.f};
                    if (b2 == 0) {
#pragma unroll
                        for (int pt = 0; pt + 1 <= i; pt += 2) a = mm_pair(aakf[(i * (i + 1)) / 2 + pt], aakf[(i * (i + 1)) / 2 + pt + 1], vb[pt], vb[pt + 1], a);
                        if (!(i & 1)) t = MFMA16K16(aakf[(i * (i + 1)) / 2 + i], vb[i], t); }
#pragma unroll
                    for (int ks = 0; ks < 2; ++ks) a = mm_pair_a8(at8[i][ks], hb[b2][2 * ks], hb[b2][2 * ks + 1], a);
#pragma unroll
                    for (int j = 0; j + 1 < i; j += 2) a = mm_pair(aabf[(i * (i - 1)) / 2 + j], aabf[(i * (i - 1)) / 2 + j + 1], ub[b2][j], ub[b2][j + 1], a);
                    if (i & 1) t = MFMA16K16(aabf[(i * (i - 1)) / 2 + i - 1], ub[b2][i - 1], t);
                    if (b2 == 0 || (i & 1)) a = a + t;
                    const bf16x4 ab = pack4b(a);
                    const f32x4 u = MFMA16K16(df[i], ab, ((f32x4){0.f, 0.f, 0.f, 0.f}));
                    ub[b2][i] = pack4b(u); } }
        }
        LDS_WAIT(); WG_BAR();
        {
            bf16x8 rt8[4][2]; bf16x4 arkf[10], arbf[10];
            {
                bf16x8 kb8[4][2], bb8[4][2];
#pragma unroll
                for (int i = 0; i < 4; ++i)
#pragma unroll
                    for (int ks = 0; ks < 2; ++ks) { rt8[i][ks] = ldfrag(S + M_RT * IMG, 16 * i, 32 * ks, lane); kb8[i][ks] = ldfrag(S + M_KB * IMG, 16 * i, 32 * ks, lane); bb8[i][ks] = ldfrag(S + M_BB * IMG, 16 * i, 32 * ks, lane); }
#pragma unroll
                for (int i = 0; i < 4; ++i) { arkf[(i * (i + 1)) / 2 + i] = *(const LAS bf16x4*)(SH + 2 * 2048 + i * 512 + lane * 8); arbf[(i * (i + 1)) / 2 + i] = *(const LAS bf16x4*)(SH + 3 * 2048 + i * 512 + lane * 8); }
                LDS_WAIT(); SCHED_BAR();
#pragma unroll
                for (int i = 1; i < 4; ++i)
#pragma unroll
                    for (int jt = 0; jt < i; ++jt) { arkf[(i * (i + 1)) / 2 + jt] = pack4b(tile_xy(kb8[jt], rt8[i])); arbf[(i * (i + 1)) / 2 + jt] = pack4b(tile_xy(bb8[jt], rt8[i])); }
            }
            SCHED_BAR();
#pragma unroll
            for (int i = 0; i < 4; ++i) { const int qq = qpos0 + 16 * i + l15; const int tau = it.dir ? sg.seqlen - 1 - qq : qq; const size_t o = (size_t)(sg.rowbase + tau) * RW + it.h * 64 + 16 * cb + 4 * q;
#pragma unroll
                for (int b2 = 0; b2 < 2; ++b2) { f32x4 y = {0.f, 0.f, 0.f, 0.f}, t = {0.f, 0.f, 0.f, 0.f};
#pragma unroll
                    for (int ks = 0; ks < 2; ++ks) y = mm_pair_b8(hb[b2][2 * ks], hb[b2][2 * ks + 1], rt8[i][ks], y);
                    if (b2 == 0) {
#pragma unroll
                        for (int pt = 0; pt + 1 <= i; pt += 2) y = mm_pair(vb[pt], vb[pt + 1], arkf[(i * (i + 1)) / 2 + pt], arkf[(i * (i + 1)) / 2 + pt + 1], y);
                        if (!(i & 1)) t = MFMA16K16(vb[i], arkf[(i * (i + 1)) / 2 + i], t); }
#pragma unroll
                    for (int j = 0; j + 1 <= i; j += 2) y = mm_pair(ub[b2][j], ub[b2][j + 1], arbf[(i * (i + 1)) / 2 + j], arbf[(i * (i + 1)) / 2 + j + 1], y);
                    if (!(i & 1)) { t = MFMA16K16(ub[b2][i], arbf[(i * (i + 1)) / 2 + i], t); y = y + t; }
                    u32x2 w; w.x = pk2(y[0], y[1]); w.y = pk2(y[2], y[3]);
                    *(u32x2*)((b2 == 0 ? YO : MCo) + o) = w; } }
            SCHED_BAR();
        }
        {
            bf16x4 ktf[4][4], btf[4][4];
#pragma unroll
            for (int kt = 0; kt < 4; ++kt)
#pragma unroll
                for (int pt = 0; pt < 4; ++pt) { const int col = 32 * (kt >> 1) + 8 * (l15 & 3) + 4 * (kt & 1);
                    ktf[kt][pt] = LDS_TR16(S + M_KB * IMG + img_off(16 * pt + 4 * q + (l15 >> 2), col));
                    btf[kt][pt] = LDS_TR16(S + M_BB * IMG + img_off(16 * pt + 4 * q + (l15 >> 2), col)); }
            LDS_WAIT(); SCHED_BAR();
#pragma unroll
            for (int kt = 0; kt < 4; ++kt) { const f32x4 gc = *(const LAS f32x4*)(L + SC_GC + (64 * (c & 1) + 16 * kt + 4 * q) * 4);
#pragma unroll
                for (int b2 = 0; b2 < 2; ++b2) { f32x4 a = H[b2][kt];
                    if (b2 == 0) {
#pragma unroll
                        for (int pp = 0; pp < 2; ++pp) a = mm_pair(ktf[kt][2 * pp], ktf[kt][2 * pp + 1], vb[2 * pp], vb[2 * pp + 1], a); }
#pragma unroll
                    for (int pp = 0; pp < 2; ++pp) a = mm_pair(btf[kt][2 * pp], btf[kt][2 * pp + 1], ub[b2][2 * pp], ub[b2][2 * pp + 1], a);
                    H[b2][kt] = a * gc; } }
        }
        LDS_WAIT(); WG_BAR();
    }
#if SCAN_PRIO == 1 && !defined(EMU)
    __builtin_amdgcn_s_setprio(0);
#endif
    { const int q = lane_i >> 4, l15 = lane_i & 15; const int v = 16 * wave_i + l15;
#pragma unroll
      for (int kt = 0; kt < 4; ++kt) { const int k = 16 * kt + 4 * q;
          *(f32x4*)((float*)(F.ws + WS_SSEG) + st_off + (size_t)v * 64 + k) = H[0][kt]; *(f32x4*)((float*)(F.ws + WS_PSEG) + st_off + (size_t)v * 64 + k) = H[1][kt]; }
    }
}
DI bool scan_item_of(int idx, ScanItem& it) {
    constexpr int NCHN = NB * NH * 2; if (idx >= NCHN * NSEG) return false;
    const int chain = idx % NCHN; it.seg = idx / NCHN; it.dir = chain & 1; it.h = (chain >> 1) % NH; it.b = (chain >> 1) / NH; return true;
}
DI void phase_chain(Frame& F) {
    LAS float* Sm = (LAS float*)F.lds; LAS float* Pm = Sm + 64 * 65;
    const int v = F.tid >> 3, kg = F.tid & 7;
    for (int ci = F.vcu; ci < NB * NH * 2; ci += F.G) {
        const size_t base = (size_t)ci * NSEG * 4096;
        float s8[8];
#pragma unroll
        for (int j = 0; j < 8; ++j) s8[j] = 0.f;
        for (int seg = 0; seg < NSEG; ++seg) {
            float* hin = (float*)(F.ws + WS_HIN) + base + (size_t)seg * 4096 + v * 64 + 8 * kg;
            *(f32x4*)hin = (f32x4){s8[0], s8[1], s8[2], s8[3]}; *(f32x4*)(hin + 4) = (f32x4){s8[4], s8[5], s8[6], s8[7]};
            if (seg == NSEG - 1) break;
            const float* pp = (const float*)(F.ws + WS_PSEG) + base + (size_t)seg * 4096 + v * 64 + 8 * kg;
            const float* sp = (const float*)(F.ws + WS_SSEG) + base + (size_t)seg * 4096 + v * 64 + 8 * kg;
            WG_BAR();
#pragma unroll
            for (int j = 0; j < 8; ++j) { Sm[v * 65 + 8 * kg + j] = s8[j]; Pm[v * 64 + 8 * kg + j] = pp[j]; }
            float o8[8];
#pragma unroll
            for (int j = 0; j < 8; ++j) o8[j] = sp[j];
            LDS_WAIT(); WG_BAR();
            for (int j = 0; j < 64; ++j) { const float sv = Sm[v * 65 + j]; const f32x4 p0 = *(const LAS f32x4*)(Pm + j * 64 + 8 * kg), p1 = *(const LAS f32x4*)(Pm + j * 64 + 8 * kg + 4);
                o8[0] += sv * p0[0]; o8[1] += sv * p0[1]; o8[2] += sv * p0[2]; o8[3] += sv * p0[3]; o8[4] += sv * p1[0]; o8[5] += sv * p1[1]; o8[6] += sv * p1[2]; o8[7] += sv * p1[3]; }
#pragma unroll
            for (int j = 0; j < 8; ++j) s8[j] = o8[j];
        }
        WG_BAR();
    }
}

DI void ld8(const bf16_t* p, float (&f)[8]) { unpack8(*(const u32x4*)p, f); }
constexpr int PBAND = GROWS < 32 ? GROWS : 32;
DI void phase_poolv(Frame& F, int start, int stride) {
    const bf16_t* U = (const bf16_t*)(F.ws + WS_U); bf16_t* VS = (bf16_t*)(F.ws + WS_VS);
    constexpr int NBAND = GROWS / PBAND;
    for (int i = start; i < NB * NBAND * GW * 128; i += stride) { const int ck = i & 127, x = (i >> 7) % GW, band = ((i >> 7) / GW) % NBAND, b = (i >> 7) / (GW * NBAND); const int half = 1 << (ck >> 5);
        const bf16_t* ub = U + ((size_t)b * SEQ + x) * INWP + OFF_POOL + 8 * ck; bf16_t* vb = VS + ((size_t)b * SEQ + x) * PWD + 8 * ck;
        const int y0 = band * PBAND; float s[8], f[8];
#pragma unroll
        for (int j = 0; j < 8; ++j) s[j] = 0.f;
        for (int yy = (y0 - half < 0 ? 0 : y0 - half); yy < (y0 + half > GROWS ? GROWS : y0 + half); ++yy) { ld8(ub + (size_t)yy * GW * INWP, f);
#pragma unroll
            for (int j = 0; j < 8; ++j) s[j] += f[j]; }
#pragma unroll 4
        for (int y = y0; y < y0 + PBAND; ++y) { *(u32x4*)(vb + (size_t)y * GW * PWD) = pack8(s);
            if (y + half < GROWS) { ld8(ub + (size_t)(y + half) * GW * INWP, f);
#pragma unroll
                for (int j = 0; j < 8; ++j) s[j] += f[j]; }
            if (y - half >= 0) { ld8(ub + (size_t)(y - half) * GW * INWP, f);
#pragma unroll
                for (int j = 0; j < 8; ++j) s[j] -= f[j]; } }
    }
}
constexpr int PCB = 4;
DI void phase_poolh(Frame& F, int start, int stride, const bool with_ctx) {
    const bf16_t* U = (const bf16_t*)(F.ws + WS_U); const bf16_t* VS = (const bf16_t*)(F.ws + WS_VS); bf16_t* PD = (bf16_t*)(F.ws + WS_MIX) + RW;
    constexpr int NLAT = NB * GROWS * 2 * 128, NCTXI = NB * (CTX / PCB) * 128;
    for (int i = start; i < NLAT + (with_ctx ? NCTXI : 0); i += stride) {
        float s[8], f[8], c8[8];
#pragma unroll
        for (int j = 0; j < 8; ++j) s[j] = 0.f;
        if (i < NLAT) { const int ck = i & 127, xh = (i >> 7) & 1, gy = (i >> 8) % GROWS, b = (i >> 8) / GROWS; const int half = 1 << (ck >> 5);
            const size_t rowb = (size_t)b * SEQ + (size_t)gy * GW; const bf16_t* vs = VS + rowb * PWD + 8 * ck; const bf16_t* uc = U + rowb * INWP + OFF_POOL + 8 * ck; bf16_t* pd = PD + rowb * D + 8 * ck;
            const int ylo = gy - half < 0 ? 0 : gy - half, yhi = gy + half > GROWS ? GROWS : gy + half; const float ny = (float)(yhi - ylo);
            const int x0 = xh * 32;
            for (int xx = (x0 - half < 0 ? 0 : x0 - half); xx < (x0 + half > GW ? GW : x0 + half); ++xx) { ld8(vs + (size_t)xx * PWD, f);
#pragma unroll
                for (int j = 0; j < 8; ++j) s[j] += f[j]; }
#pragma unroll 4
            for (int x = x0; x < x0 + 32; ++x) { const int xlo = x - half < 0 ? 0 : x - half, xhi = x + half > GW ? GW : x + half; const float ic = 1.0f / (ny * (float)(xhi - xlo));
                ld8(uc + (size_t)x * INWP, c8); float o[8];
#pragma unroll
                for (int j = 0; j < 8; ++j) o[j] = s[j] * ic - c8[j];
                *(u32x4*)(pd + (size_t)x * D) = pack8(o);
                if (x + half < GW) { ld8(vs + (size_t)(x + half) * PWD, f);
#pragma unroll
                    for (int j = 0; j < 8; ++j) s[j] += f[j]; }
                if (x - half >= 0) { ld8(vs + (size_t)(x - half) * PWD, f);
#pragma unroll
                    for (int j = 0; j < 8; ++j) s[j] -= f[j]; } }
        } else { const int i2 = i - NLAT; const int ck = i2 & 127, band = (i2 >> 7) % (CTX / PCB), b = (i2 >> 7) / (CTX / PCB); const int half = 1 << (ck >> 5);
            const size_t rowb = (size_t)ML + (size_t)b * CTX; const bf16_t* uc = U + rowb * INWP + OFF_POOL + 8 * ck; bf16_t* pd = PD + rowb * D + 8 * ck;
            const int t0 = band * PCB;
            for (int tt = (t0 - half < 0 ? 0 : t0 - half); tt < (t0 + half > CTX ? CTX : t0 + half); ++tt) { ld8(uc + (size_t)tt * INWP, f);
#pragma unroll
                for (int j = 0; j < 8; ++j) s[j] += f[j]; }
#pragma unroll 4
            for (int t = t0; t < t0 + PCB; ++t) { const int lo = t - half < 0 ? 0 : t - half, hi = t + half > CTX ? CTX : t + half; const float ic = 1.0f / (float)(hi - lo);
                ld8(uc + (size_t)t * INWP, c8); float o[8];
#pragma unroll
                for (int j = 0; j < 8; ++j) o[j] = s[j] * ic - c8[j];
                *(u32x4*)(pd + (size_t)t * D) = pack8(o);
                if (t + half < CTX) { ld8(uc + (size_t)(t + half) * INWP, f);
#pragma unroll
                    for (int j = 0; j < 8; ++j) s[j] += f[j]; }
                if (t - half >= 0) { ld8(uc + (size_t)(t - half) * INWP, f);
#pragma unroll
                    for (int j = 0; j < 8; ++j) s[j] -= f[j]; } }
        }
    }
}

template <int MT> DI void finish_item(Frame& F, const CAS Inputs& IN_, const int l, const int row0, const int h) {
    const bf16_t* U = (const bf16_t*)(F.ws + WS_U); const bf16_t* Gt = (const bf16_t*)(F.ws + WS_G); bf16_t* MIX = (bf16_t*)(F.ws + WS_MIX);
    const bf16_t* YL = (const bf16_t*)(F.ws + WS_YF); const bf16_t* MCb = (const bf16_t*)(F.ws + WS_XN);
    const float* BS0 = (const float*)(F.ws + WS_BS); const float* BS1 = BS0 + (size_t)MR * NH;
    const float* cw = IN_.conv_rkv + (size_t)l * 9 * RW + 2 * RW;
    const int lane = F.lane, q = lane >> 4, l15 = lane & 15;
    const bool lat = row0 < ML;
    f32x4 acc[MT][4];
#pragma unroll
    for (int mt = 0; mt < MT; ++mt)
#pragma unroll
        for (int j = 0; j < 2; ++j) { const size_t o = (size_t)(row0 + 16 * mt + l15) * RW + h * 64 + 32 * j + 8 * q; float a[8], b[8];
            unpack8(*(const u32x4*)(YL + o), a); unpack8(*(const u32x4*)(YL + (size_t)MR * RW + o), b);
            acc[mt][2 * j] = (f32x4){a[0] + b[0], a[1] + b[1], a[2] + b[2], a[3] + b[3]}; acc[mt][2 * j + 1] = (f32x4){a[4] + b[4], a[5] + b[5], a[6] + b[6], a[7] + b[7]}; }
    {
        const int r64 = row0 & ~63; const int bb = lat ? r64 / SEQ : (r64 - ML) / CTX, t0 = lat ? r64 % SEQ : (r64 - ML) % CTX;
#pragma unroll
        for (int dir = 0; dir < 2; ++dir) {
            const int gch = lat ? CTX / 64 + (dir ? (SEQ - 64 - t0) / 64 : t0 / 64) : (dir ? (CTX - 64 - t0) / 64 : t0 / 64);
            int seg = 0; for (int sx = 1; sx < NSEG; ++sx) seg = (seg_start(sx) <= gch) ? sx : seg;
            if (seg == 0) continue;
            const float* Hin = (const float*)(F.ws + WS_HIN) + (size_t)((((bb * NH + h) * 2 + dir) * NSEG) + seg) * 4096;
            const bf16_t* Mc = MCb + (size_t)dir * MR * RW + (size_t)row0 * RW + h * 64;
            bf16x8 hf[4][2];
#pragma unroll
            for (int vt = 0; vt < 4; ++vt)
#pragma unroll
                for (int ks = 0; ks < 2; ++ks) { const int v = 32 * (vt >> 1) + 8 * (l15 >> 2) + 4 * (vt & 1) + (l15 & 3);
                    const float* hp = Hin + (size_t)v * 64 + 32 * ks + 8 * q; const f32x4 x0 = *(const f32x4*)hp, x1 = *(const f32x4*)(hp + 4);
                    u32x4 w; w.x = pk2(x0[0], x0[1]); w.y = pk2(x0[2], x0[3]); w.z = pk2(x1[0], x1[1]); w.w = pk2(x1[2], x1[3]); hf[vt][ks] = __builtin_bit_cast(bf16x8, w); }
#pragma unroll
            for (int mt = 0; mt < MT; ++mt) { bf16x8 mf[2];
#pragma unroll
                for (int ks = 0; ks < 2; ++ks) mf[ks] = *(const bf16x8*)(Mc + (size_t)(16 * mt + l15) * RW + 32 * ks + 8 * q);
#pragma unroll
                for (int vt = 0; vt < 4; ++vt) { acc[mt][vt] = MFMA16(hf[vt][0], mf[0], acc[mt][vt]); acc[mt][vt] = MFMA16(hf[vt][1], mf[1], acc[mt][vt]); } }
        }
    }
#pragma unroll
    for (int mt = 0; mt < MT; ++mt) { const int row = row0 + 16 * mt + l15;
        int tau, len; if (row < ML) { tau = row % SEQ; len = SEQ; } else { tau = (row - ML) % CTX; len = CTX; }
        float sm = 0.f;
#pragma unroll
        for (int vt = 0; vt < 4; ++vt) sm += (acc[mt][vt][0] + acc[mt][vt][1]) + (acc[mt][vt][2] + acc[mt][vt][3]);
        sm += __shfl_xor(sm, 16); sm += __shfl_xor(sm, 32);
        const float mu = sm * (1.f / 64.f); float vq = 0.f;
#pragma unroll
        for (int vt = 0; vt < 4; ++vt)
#pragma unroll
            for (int e = 0; e < 4; ++e) { const float d = acc[mt][vt][e] - mu; acc[mt][vt][e] = d; vq += d * d; }
        vq += __shfl_xor(vq, 16); vq += __shfl_xor(vq, 32);
        const float rstd = frsq(vq * (1.f / 64.f) + GN_EPS);
        const float bsum = BS0[(size_t)row * NH + h] + BS1[(size_t)row * NH + h];
        const bool hasm = tau > 0, hasp = tau < len - 1;
#pragma unroll
        for (int j = 0; j < 2; ++j) { const int ch = h * 64 + 32 * j + 8 * q;
            const bf16_t* up = U + (size_t)row * INWP + OFF_V + ch; float cen[8], lo[8], hi[8], g8[8];
            unpack8(*(const u32x4*)up, cen); unpack8(*(const u32x4*)(up - INWP), lo); unpack8(*(const u32x4*)(up + INWP), hi);
            unpack8(*(const u32x4*)(Gt + (size_t)row * RW + ch), g8);
            float o[8];
#pragma unroll
            for (int hh = 0; hh < 2; ++hh) { const int c4 = ch + 4 * hh;
                const f32x4 w0 = *(const f32x4*)(cw + c4), w1 = *(const f32x4*)(cw + 3 * RW + c4), w2 = *(const f32x4*)(cw + 6 * RW + c4);
                const f32x4 gw4 = *(const f32x4*)(IN_.gn_w + (size_t)l * RW + c4), gb4 = *(const f32x4*)(IN_.gn_b + (size_t)l * RW + c4);
#pragma unroll
                for (int e = 0; e < 4; ++e) { const float v = (hasm ? lo[4 * hh + e] : 0.f) * w0[e] + cen[4 * hh + e] * w1[e] + (hasp ? hi[4 * hh + e] : 0.f) * w2[e];
                    o[4 * hh + e] = (acc[mt][2 * j + hh][e] * rstd * gw4[e] + gb4[e] + bsum * v) * g8[4 * hh + e]; } }
            *(u32x4*)(MIX + (size_t)row * D + ch) = pack8(o); }
    }
}
DI void phase_finish(Frame& F, const CAS Inputs& IN_, int l, int nrows) {
    const int gw = F.vcu * 8 + F.wave, NGW = F.G * 8;
    for (int itx = gw; itx < (ML / 64) * NH; itx += NGW) finish_item<4>(F, IN_, l, (itx / NH) * 64, itx % NH);
    for (int itx = gw; itx < ((nrows - ML) / 16) * NH; itx += NGW) finish_item<1>(F, IN_, l, ML + (itx / NH) * 16, itx % NH);
}

constexpr int PH_P0 = 0, PH_P0B = 1, PH_L0 = 2, PH_PER_LAYER = 11, PH_FINAL = PH_L0 + PH_PER_LAYER * DEPTH, NPHASES = PH_FINAL + 1;
#define IN(k) (lo <= (k) && (k) < hi)
#define REP(k) for (int rep_ = 0; rep_ < (((PROBE_MASK) >> (k)) & 1) + 1; ++rep_)
#define PHASE_BEGIN() const CAS Args* AP = kargs; OPAQUE_S(AP); do { F.ws = AP->ws; F.out = AP->out; F.wave = wave_id; OPAQUE_S(F.wave); F.lane = LANE_ID(); OPAQUE_V(F.lane); F.tid = F.wave * 64 + F.lane; } while (0)
#ifdef EMU
#define SEAM(k) do { if (IN(k) && IN((k) + 1)) xcd_barrier(bar); } while (0)
#else
#define SEAM(k) do { if (IN(k) && IN((k) + 1)) { XcdBarrier bb_ = bar; { const CAS Args* ap_ = kargs; OPAQUE_S(ap_); bb_.bar = (unsigned*)(ap_->ws + WS_CTL) + CW_BAR; } OPAQUE_S(bb_.bar); xcd_barrier(bb_, (lane_id_volatile() == 0) && (wave_id == 0)); } } while (0)
#endif
template <int l> DI void run_layer(Frame F, const CAS Args* const kargs, const int lo, const int hi, const XcdBarrier bar, const int wave_id) {

        const int pb = PH_L0 + PH_PER_LAYER * l; const bool last = (l == DEPTH - 1);
        const int npm = last ? NPM_L : NPM;
        if (IN(pb + 0)) REP(0) { PHASE_BEGIN(); phase_norm(F, AP->in, l, false, MR, l > 0 ? NPART_DN : 0, (const float*)(F.ws + WS_CTXH), mod_ptr(F, l > 0 ? l - 1 : 0, 2, 5)); }
        SEAM(pb + 0);
        if (IN(pb + 1)) REP(1) { PHASE_BEGIN(); const int nc = (l + 1 < DEPTH) ? conv_in(F.G) : 0; const int c = (int)blockIdx.x;
            if (c >= F.G - nc) { const int w = (c - (F.G - nc)) * 8 + F.wave, NW = nc * 8;
                p0_convert_span(F, AP->in, l + 1, 0, P0_I_WIN, w, NW); p0_convert_span(F, AP->in, l + 1, P0_R_WOUT1, P0_R_A1, w, NW); }
            else { pg8::Gemm g{(const bf16_t*)(F.ws + WS_XN), wl_ptr(F, l, WL_WIN), D, D, D, 0}; pg8::StaticOrder S; S.init(NPM, INWP / 256, F.G - nc, c);
                EpiU E{(bf16_t*)(F.ws + WS_U), INWP, 1}; pg8::gemm_phase<EpiU, pg8::StaticOrder, true, true>(F.lds, g, S, E, F.tid); } }
        SEAM(pb + 1);
        if (IN(pb + 2)) REP(2) { PHASE_BEGIN(); ScanItem it; for (int i = F.vcu; scan_item_of(i, it); i += F.G) scan_item(F, AP->in, l, it); }
        SEAM(pb + 2);
        if (IN(pb + 3)) REP(3) { PHASE_BEGIN(); constexpr int NCH = NB * NH * 2;
            if (F.G <= NCH) phase_chain(F);
            phase_poolv(F, F.vcu * 512 + F.tid, F.G * 512); }
        SEAM(pb + 3);
        if (IN(pb + 4)) REP(4) { PHASE_BEGIN(); phase_poolh(F, F.vcu * 512 + F.tid, F.G * 512, !last); }
        SEAM(pb + 4);
        if (IN(pb + 5)) REP(5) { PHASE_BEGIN();
            { constexpr int NCH = NB * NH * 2; const bool split = F.G > NCH;
              if (split && F.vcu < NCH) { phase_chain(F); WG_BAR(); }
              else { pg8::Gemm g{(const bf16_t*)(F.ws + WS_U) + OFF_G, wl_ptr(F, l, WL_GUP), INWP, GL, GL, 0}; pg8::StaticOrder S; S.init(npm, RW / 256, split ? F.G - NCH : F.G, split ? F.vcu - NCH : (int)blockIdx.x);
                EpiU E{(bf16_t*)(F.ws + WS_G), RW, 0}; pg8::gemm_phase<EpiU, pg8::StaticOrder, false, false>(F.lds, g, S, E, F.tid); } }
        }
        SEAM(pb + 5);
        if (IN(pb + 6)) REP(6) { PHASE_BEGIN(); phase_finish(F, AP->in, l, npm * 256); }
        SEAM(pb + 6);
        if (IN(pb + 7)) { PHASE_BEGIN();
            if (!last) {
                pg8::Gemm g{(const bf16_t*)(F.ws + WS_MIX) + (size_t)ML * D, wl_ptr(F, l, WL_WOUT), D, D, KSPLIT, 0}; pg8::SplitKOrder S; S.init(MC / 256, D / 256, NPART_WO, F.G, (int)blockIdx.x);
                EpiPart E{(float*)(F.ws + WS_PART)};
                pg8::gemm_phase<EpiPart, pg8::SplitKOrder, true, true>(F.lds, g, S, E, F.tid); }
            { pg8::Gemm g{(const bf16_t*)(F.ws + WS_MIX), wl_ptr(F, l, WL_WOUT), D, D, D, 0}; pg8::StaticOrder S; S.init(NPM_L, D / 256, F.G, (int)blockIdx.x);
              EpiResB E{l == 0 ? (const void*)AP->in.x : (const void*)(F.ws + WS_XB), l == 0 ? 1 : 0, (bf16_t*)(F.ws + WS_XB), mod_ptr(F, l, 0, 2)};
              pg8::gemm_phase<EpiResB, pg8::StaticOrder, true, true>(F.lds, g, S, E, F.tid); }
        }
        SEAM(pb + 7);
        if (IN(pb + 8)) REP(8) { PHASE_BEGIN(); phase_norm(F, AP->in, l, true, npm * 256, last ? 0 : NPART_WO, l == 0 ? AP->in.ctx : (const float*)(F.ws + WS_CTXH), mod_ptr(F, l, 2, 2)); }
        SEAM(pb + 8);
        if (IN(pb + 9)) REP(9) { PHASE_BEGIN(); const int nc = (l + 1 < DEPTH) ? conv_up(F.G) : 0; const int c = (int)blockIdx.x; const int Gp = F.G - nc;
            const int nunits = npm * (2 * DFF / 256), nfull = (nunits / Gp) * Gp; const int lim = (nc > 0 && nunits - nfull <= 4 * nc) ? nfull : nunits;
            pg8::Gemm g{(const bf16_t*)(F.ws + WS_XN), wl_ptr(F, l, WL_WGU), D, D, D, 0}; EpiSwiglu E{(bf16_t*)(F.ws + WS_H)}; pg8::StaticOrder S;
            if (c >= Gp) { const int ci = c - Gp; const int w = ci * 8 + F.wave, NW = nc * 8;
                p0_convert_span(F, AP->in, l + 1, P0_R_A1, P0_I_T, w, NW); WG_BAR();
                S.init(npm, 2 * DFF / 256, nc, ci); S.range(lim, nunits); }
            else { S.init(npm, 2 * DFF / 256, Gp, c); S.range(0, lim); }
            pg8::gemm_phase<EpiSwiglu, pg8::StaticOrder, true, true>(F.lds, g, S, E, F.tid); }
        SEAM(pb + 9);
        if (IN(pb + 10)) { PHASE_BEGIN();
            if (!last) {
                pg8::Gemm g{(const bf16_t*)(F.ws + WS_H) + (size_t)ML * DFF, wl_ptr(F, l, WL_WDN), DFF, DFF, KSPLIT, 0}; pg8::SplitKOrder S; S.init(MC / 256, D / 256, NPART_DN, F.G, (int)blockIdx.x);
                EpiPart E{(float*)(F.ws + WS_PART)};
                pg8::gemm_phase<EpiPart, pg8::SplitKOrder, true, true>(F.lds, g, S, E, F.tid); }
            { pg8::Gemm g{(const bf16_t*)(F.ws + WS_H), wl_ptr(F, l, WL_WDN), DFF, DFF, DFF, 0}; pg8::StaticOrder S; S.init(NPM_L, D / 256, F.G, (int)blockIdx.x);
              EpiResB E{(const void*)(F.ws + WS_XB), 0, (bf16_t*)(F.ws + WS_XB), mod_ptr(F, l, 0, 5)};
              pg8::gemm_phase<EpiResB, pg8::StaticOrder, true, true>(F.lds, g, S, E, F.tid); }
        }
        SEAM(pb + 10);
    }
__global__ void __launch_bounds__(512, 2) fwd_kernel(Args args) {
#ifdef EMU
    unsigned char* lds = emu_blk->lds;
#else
    extern __shared__ __attribute__((aligned(16))) unsigned char lds[];
#endif
    Frame F;
    F.lds = (LAS unsigned char*)lds;
    F.tid = threadIdx.x; F.lane = F.tid & 63; F.wave = RFL(F.tid >> 6);
    const int wave_id = F.wave;
    F.G = gridDim.x; { const int bx = blockIdx.x; F.vcu = (F.G % 8 == 0) ? (bx % 8) * (F.G / 8) + bx / 8 : bx; }
#ifdef EMU
    const Args* const kargs = &args;
#else
    const CAS Args* const kargs = (const CAS Args*)__builtin_amdgcn_kernarg_segment_ptr();
#endif
    F.out = kargs->out; F.ws = kargs->ws;
    const int lo = args.ph_lo, hi = args.ph_hi;
#ifndef EMU
    volatile LAS unsigned* MISC = (volatile LAS unsigned*)(F.lds + MISC_OFF);
    if (F.tid < 128) MISC[F.tid] = 0u;
    __syncthreads();
    XcdBarrier bar; bar.bar = (unsigned*)(F.ws + WS_CTL) + CW_BAR; bar.x = 0; bar.st = nullptr;
    if (hi - lo > 1) bar = xcd_barrier_post((unsigned*)(F.ws + WS_CTL) + CW_BAR, MISC + 8);
#else
    XcdBarrier bar; bar.bar = nullptr;
#endif
    if (IN(PH_P0)) REP(11) { PHASE_BEGIN(); phase_p0(F, AP->in); }
    SEAM(PH_P0);
    if (IN(PH_P0B)) { PHASE_BEGIN(); phase_p0b(F, AP->in);
        { static_assert(WL_SIZE % (2 * PG) == 0, "layer stride"); WG_BAR();
          pg8::Gemm g{wl_ptr(F, 0, WL_WOUT) + RW, wl_ptr(F, 0, WL_POOL), D, PG, PG, 256}; pg8::FoldOrder S; S.init(DEPTH, (int)(WL_SIZE / (2 * PG)), F.G, (int)blockIdx.x);
          EpiFold E{wl_ptr(F, 0, WL_WOUT) + RW}; pg8::gemm_phase<EpiFold, pg8::FoldOrder, true, true>(F.lds, g, S, E, F.tid); } }
    SEAM(PH_P0B);
    run_layer<0>(F, kargs, lo, hi, bar, wave_id);
    if constexpr (DEPTH > 1) run_layer<1>(F, kargs, lo, hi, bar, wave_id);
    if constexpr (DEPTH > 2) run_layer<2>(F, kargs, lo, hi, bar, wave_id);
    if constexpr (DEPTH > 3) run_layer<3>(F, kargs, lo, hi, bar, wave_id);
    static_assert(DEPTH <= 4, "layers");
    if (IN(PH_FINAL)) { PHASE_BEGIN(); phase_final_norm(F, AP->in);
#if PROBE_T && !defined(EMU)
        __syncthreads(); if (blockIdx.x == 0 && F.tid == 0) { volatile LAS unsigned* M_ = (volatile LAS unsigned*)(F.lds + MISC_OFF); F.out[0] = (float)M_[32 + PROBE_TA] * (16.0f / 1000.0f); F.out[1] = (float)M_[32 + PROBE_TB] * (16.0f / 1000.0f); }
#endif
    }
#undef IN
#undef SEAM
}

extern "C" void kernel_launch(void* const* d_in, const int* in_sizes, int n_in, void* d_out, int out_size, void* d_ws, size_t ws_size, hipStream_t stream) {
    static int grid = 0;
    if (grid == 0) {
        if (n_in != 27 || in_sizes[0] != ML * D || out_size != ML * D || ws_size < WS_END) {
            fprintf(stderr, "kernel_launch: shape/workspace mismatch: n_in %d in0 %d out %d ws %zu (need %zu)\n", n_in, n_in > 0 ? in_sizes[0] : -1, out_size, ws_size, (size_t)WS_END); grid = -1; return; }
        int dev = 0, cus = 0, per_cu = 0;
        if (hipGetDevice(&dev) != hipSuccess || hipDeviceGetAttribute(&cus, hipDeviceAttributeMultiprocessorCount, dev) != hipSuccess) { grid = -1; return; }
        if (hipFuncSetAttribute((const void*)fwd_kernel, hipFuncAttributeMaxDynamicSharedMemorySize, LDS_BYTES) != hipSuccess) { fprintf(stderr, "kernel_launch: hipFuncSetAttribute failed\n"); grid = -1; return; }
        if (hipOccupancyMaxActiveBlocksPerMultiprocessor(&per_cu, (const void*)fwd_kernel, 512, LDS_BYTES) != hipSuccess || per_cu < 1) fprintf(stderr, "kernel_launch: occupancy query reports %d\n", per_cu);
        (void)hipGetLastError();
        grid = cus;
    }
    if (grid < 0) return;
    (void)hipMemsetAsync((char*)d_ws + WS_CTL, 0, CTL_BYTES, stream);
    Args a{};
    const float** ip = (const float**)&a.in;
    for (int i = 0; i < 27; ++i) ip[i] = (const float*)d_in[i];
    a.out = (float*)d_out; a.ws = (unsigned char*)d_ws;
#if MK_ONE_LAUNCH
    a.ph_lo = 0; a.ph_hi = NPHASES;
    hipLaunchKernelGGL(fwd_kernel, dim3(grid), dim3(512), LDS_BYTES, stream, a);
#else
    for (int ph = 0; ph < NPHASES; ++ph) {
#ifdef EMU
        extern int emu_stop_phase; if (emu_stop_phase >= 0 && ph >= emu_stop_phase) break; fprintf(stderr, "phase %d\n", ph);
#endif
        a.ph_lo = ph; a.ph_hi = ph + 1; hipLaunchKernelGGL(fwd_kernel, dim3(grid), dim3(512), LDS_BYTES, stream, a); }
#endif
}
```

```cpp
#ifndef EMU
#include <hip/hip_runtime.h>
#endif
#include <cstdio>
#include <cstdint>
#include <cstddef>

#ifndef CFG_SEQ
#define CFG_SEQ 16384
#endif
#ifndef CFG_CTX
#define CFG_CTX 256
#endif
#ifndef CFG_DEPTH
#define CFG_DEPTH 4
#endif
#ifndef CFG_NSEG
#define CFG_NSEG 4
#endif
#ifndef PROBE_MASK
#define PROBE_MASK 0
#endif
#ifndef PROBE_T
#define PROBE_T 0
#endif
#ifndef PROBE_TA
#define PROBE_TA 0
#endif
#ifndef PROBE_TB
#define PROBE_TB 1
#endif
#ifndef SCAN_PRIO
#define SCAN_PRIO 2
#endif
#ifndef SCAN_REP
#define SCAN_REP 0
#endif
#ifndef MK_ONE_LAUNCH
#define MK_ONE_LAUNCH 1
#endif
constexpr int D = 2048, NB = 2, SEQ = CFG_SEQ, DEPTH = CFG_DEPTH, CTX = CFG_CTX, GW = 64, HS = 64, RW = 1024, NH = 16, PWD = 1024;
constexpr int PG = 256, LORA = 96, GL = 256, DFF = 5632;
constexpr int OFF_R = 0, OFF_K = 1024, OFF_V = 2048, OFF_W = 3072, OFF_A = 3168, OFF_G = 3264, OFF_POOL = 3520, INW = 4544, INWP = 4608;
constexpr int ML = NB * SEQ, MC = NB * CTX, MR = ML + MC;
constexpr int NSEG = CFG_NSEG, TCH = (CTX + SEQ) / 64, SEG_BASE = TCH / NSEG, SEG_REM = TCH % NSEG, SEG_STEP = SEG_REM ? NSEG / SEG_REM + 1 : 1;
__host__ __device__ constexpr int seg_start(int sg) { return sg * SEG_BASE + ((sg + SEG_STEP - 1) / SEG_STEP < SEG_REM ? (sg + SEG_STEP - 1) / SEG_STEP : SEG_REM); }
static_assert(seg_start(NSEG) == TCH && seg_start(1) >= 1, "segments");
constexpr int GROWS = SEQ / GW;
constexpr float RMS_EPS = 1e-6f, GN_EPS = 64e-5f;
static_assert(ML % 256 == 0 && MR % 256 == 0 && SEQ % 256 == 0 && CTX % 64 == 0, "shape");
constexpr int NPM = MR / 256, NPM_L = ML / 256;

typedef unsigned short bf16_t;
typedef short bf16x8 __attribute__((ext_vector_type(8)));
typedef short bf16x4 __attribute__((ext_vector_type(4)));
typedef float f32x4 __attribute__((ext_vector_type(4)));
typedef float f32x2 __attribute__((ext_vector_type(2)));
typedef unsigned u32x4 __attribute__((ext_vector_type(4)));
typedef unsigned u32x2 __attribute__((ext_vector_type(2)));
#define DI __device__ __forceinline__
#ifdef EMU
#define LAS
#define GAS
#define CAS
#define MFMA16(a, b, c) emu_mfma16((a), (b), (c))
#define MFMA16K16(a, b, c) emu_mfma16k16((a), (b), (c))
#define LDS_TR16(p) emu_ds_read_tr16_b64((const void*)(p))
#define BPERM(v, src) __shfl((v), (src))
#define RFL(x) (x)
#define LDS_WAIT() emu_wave_sync()
#define VM_WAIT() do {} while (0)
#define WG_BAR() __syncthreads()
#define CFENCE() do {} while (0)
#define OPAQUE_S(x) do {} while (0)
#define OPAQUE_V(x) do {} while (0)
#define LANE_ID() ((int)(threadIdx.x & 63))
static inline float fexp(float x) { return expf(x); }
static inline float fexp2(float x) { return exp2f(x); }
static inline float frcp(float x) { return 1.0f / x; }
static inline float frsq(float x) { return 1.0f / sqrtf(x); }
#else
#define LAS __attribute__((address_space(3)))
#define GAS __attribute__((address_space(1)))
#define CAS __attribute__((address_space(4)))
#define MFMA16(a, b, c) __builtin_amdgcn_mfma_f32_16x16x32_bf16((a), (b), (c), 0, 0, 0)
#define MFMA16K16(a, b, c) __builtin_amdgcn_mfma_f32_16x16x16bf16_1k((a), (b), (c), 0, 0, 0)
#define LDS_TR16(p) __builtin_amdgcn_ds_read_tr16_b64_v4i16((LAS bf16x4*)(p))
#define BPERM(v, src) __builtin_bit_cast(float, __builtin_amdgcn_ds_bpermute(((src) & 63) << 2, __builtin_bit_cast(int, (v))))
#define RFL(x) __builtin_amdgcn_readfirstlane(x)
#define LDS_WAIT() asm volatile("s_waitcnt lgkmcnt(0)" ::: "memory")
#define VM_WAIT() asm volatile("s_waitcnt vmcnt(0)" ::: "memory")
#define WG_BAR() __syncthreads()
#define CFENCE() asm volatile("" ::: "memory")
#define OPAQUE_S(x) asm volatile("" : "+s"(x))
#define OPAQUE_V(x) asm volatile("" : "+v"(x))
DI int lane_id_volatile() { int l; asm volatile("v_mbcnt_lo_u32_b32 %0, -1, 0\n\tv_mbcnt_hi_u32_b32 %0, -1, %0" : "=v"(l)); return l; }
#define LANE_ID() lane_id_volatile()
DI float fexp(float x) { return __expf(x); }
DI float fexp2(float x) { return __builtin_amdgcn_exp2f(x); }
DI float frcp(float x) { return __builtin_amdgcn_rcpf(x); }
DI float frsq(float x) { return __builtin_amdgcn_rsqf(x); }
#endif
DI unsigned f2bf(float f) { unsigned u = __builtin_bit_cast(unsigned, f); return (u + 0x7fffu + ((u >> 16) & 1u)) >> 16; }
#ifdef EMU
DI unsigned pk2(float lo, float hi) { return f2bf(lo) | (f2bf(hi) << 16); }
#define SCHED_BAR() do {} while (0)
#else
typedef __bf16 nbf16x2 __attribute__((ext_vector_type(2)));
DI unsigned pk2(float lo, float hi) { return __builtin_bit_cast(unsigned, __builtin_convertvector((f32x2){lo, hi}, nbf16x2)); }
#define SCHED_BAR() __builtin_amdgcn_sched_barrier(0)
#endif
DI float bf2f(unsigned h) { return __builtin_bit_cast(float, h << 16); }
DI float bflo(unsigned w) { return __builtin_bit_cast(float, w << 16); }
DI float bfhi(unsigned w) { return __builtin_bit_cast(float, w & 0xffff0000u); }
DI float fsigmoid(float x) { return frcp(1.0f + fexp(-x)); }
DI float ftanh(float x) { return 1.0f - 2.0f * frcp(fexp(2.0f * x) + 1.0f); }
DI float fsilu(float x) { return x * fsigmoid(x); }
DI void unpack8(const u32x4& w, float (&f)[8]) { f[0] = bflo(w.x); f[1] = bfhi(w.x); f[2] = bflo(w.y); f[3] = bfhi(w.y); f[4] = bflo(w.z); f[5] = bfhi(w.z); f[6] = bflo(w.w); f[7] = bfhi(w.w); }
DI u32x4 pack8(const float (&f)[8]) { u32x4 w; w.x = pk2(f[0], f[1]); w.y = pk2(f[2], f[3]); w.z = pk2(f[4], f[5]); w.w = pk2(f[6], f[7]); return w; }
DI void unpack4(const u32x2& w, float (&f)[4]) { f[0] = bflo(w.x); f[1] = bfhi(w.x); f[2] = bflo(w.y); f[3] = bfhi(w.y); }
DI u32x2 pack4(const float (&f)[4]) { u32x2 w; w.x = pk2(f[0], f[1]); w.y = pk2(f[2], f[3]); return w; }
#ifdef EMU
DI float dpp_f(float x, int ctrl) { const int lane = threadIdx.x & 63; int src;
    if (ctrl == 0x141) src = (lane & ~7) | (7 - (lane & 7)); else if (ctrl == 0x140) src = (lane & ~15) | (15 - (lane & 15)); else src = (lane & ~3) | ((ctrl >> (2 * (lane & 3))) & 3);
    return __shfl(x, src); }
#else
DI float dpp_f(float x, int ctrl) { return x; }
#define dpp_f(x, ctrl) __builtin_bit_cast(float, __builtin_amdgcn_update_dpp(0, __builtin_bit_cast(int, (x)), (ctrl), 0xF, 0xF, true))
#endif
DI float row16_sum(float x) { x += dpp_f(x, 0xB1); x += dpp_f(x, 0x4E); x += dpp_f(x, 0x141); x += dpp_f(x, 0x140); return x; }
DI float wave_sum(float v) {
#pragma unroll
    for (int o = 1; o < 64; o <<= 1) v += __shfl_xor(v, o);
    return v;
}

namespace pg8 {
constexpr int BM = 256, BK = 64, HALF = 128, HTB = HALF * BK * 2, STAGE_BYTES = 8 * HTB, NXCD = 8, WGM = 4;
__host__ __device__ __forceinline__ int lds_byte(int r, int c) { const int st = (r >> 4) * 2 + (c >> 5), rr = r & 15, cc = c & 31, ob = rr * 64 + cc * 2; return st * 1024 + (ob ^ (((ob >> 9) & 1) << 5)); }
__host__ __device__ __forceinline__ void stage_rc(int b, int& R, int& C) { const int st = b / 1024, sb = b % 1024, swz = sb ^ (((sb >> 9) & 1) << 5); R = (st >> 1) * 16 + swz / 64; C = (st & 1) * 32 + (swz % 64) / 2; }
__host__ __device__ __forceinline__ int perm32(int rho) { const int n = rho >> 4, i = rho & 15; return 8 * (i >> 2) + 4 * n + (i & 3); }
struct Unit { int pm, pn, ks; };
struct Gemm { const bf16_t* A; const bf16_t* Bt; int lda, ldb, K, a_col_pn; };
struct StaticOrder {
    int nM, nN, nwg, G, c, base, limit;
    __host__ __device__ void init(int nM_, int nN_, int G_, int c_) { nM = nM_; nN = nN_; nwg = nM * nN; G = G_; c = c_; base = 0; limit = nwg; }
    __host__ __device__ void range(int base_, int limit_) { base = base_; limit = limit_; }
    __host__ __device__ bool next(int i, Unit& u) const {
        const long L = base + (long)i * G + c; if (L >= limit) return false;
        int wgid = (int)L; { const int q = nwg / NXCD, r = nwg % NXCD, xcd = wgid % NXCD, off = wgid / NXCD; wgid = (xcd < r ? xcd * (q + 1) : r * (q + 1) + (xcd - r) * q) + off; }
        const int nig = WGM * nN, gid = wgid / nig, fm = gid * WGM, gsz = (nM - fm) < WGM ? (nM - fm) : WGM;
        u.pm = fm + ((wgid % nig) % gsz); u.pn = (wgid % nig) / gsz; u.ks = 0; return true;
    }
};
struct FoldOrder {
    int nL, ksl, G, c;
    __host__ __device__ void init(int nL_, int ksl_, int G_, int c_) { nL = nL_; ksl = ksl_; G = G_; c = c_; }
    __host__ __device__ bool next(int i, Unit& u) const { const long L = (long)i * G + c; if (L >= (long)nL * 32) return false; const int r = (int)(L % 32); u.pm = r % 8; u.pn = r / 8; u.ks = (int)(L / 32) * ksl; return true; }
};
struct SplitKOrder {
    int nM, nN, nS, G, c;
    __host__ __device__ void init(int nM_, int nN_, int nS_, int G_, int c_) { nM = nM_; nN = nN_; nS = nS_; G = G_; c = c_; }
    __host__ __device__ bool next(int i, Unit& u) const { const long L = (long)i * G + c; if (L >= (long)nM * nN * nS) return false; u.ks = (int)(L % nS); u.pn = (int)((L / nS) % nN); u.pm = (int)(L / ((long)nS * nN)); return true; }
};
#ifndef EMU
#define PG8_LAS __attribute__((address_space(3)))
template <class Epi, class Sched, bool ALIGN_EPI = false, bool SP2 = false>
__device__ __forceinline__ void gemm_phase(PG8_LAS unsigned char* lds, const Gemm g, const Sched& S, const Epi& E, const int tid_) {
    const int tid = tid_, wid = __builtin_amdgcn_readfirstlane(tid >> 6), lane = tid & 63, wr = wid >> 2, wc = wid & 3, fr = lane & 15, fq = lane >> 4;
    const int K = g.K, nt = K / BK;
    unsigned voffA[2], voffB[2];
#pragma unroll
    for (int i = 0; i < 2; ++i) { int R, C; stage_rc(tid * 16 + i * 8192, R, C); const int Rb = Epi::PERM ? ((R & ~31) + perm32(R & 31)) : R;
        voffA[i] = (unsigned)(R * g.lda + C) * 2u; voffB[i] = (unsigned)(Rb * g.ldb + C) * 2u; }
    const size_t kstep = (size_t)(BK * 2);
    const size_t hstepA = (size_t)HALF * g.lda * 2, hstepB = (size_t)HALF * g.ldb * 2;
    const unsigned ldsw = (unsigned)wid * 1024u;
    const int aoff = lds_byte(wr * 64 + fr, fq * 8), boff = lds_byte(wc * 32 + fr, fq * 8);
#define PG8_SA(b, h) (((b) * 2 + (h)) * HTB)
#define PG8_SB(b, h) ((4 + (b) * 2 + (h)) * HTB)
#define PG8_STAGE(bufoff, gbase, voff) do { _Pragma("unroll") for (int _i = 0; _i < 2; ++_i) \
        __builtin_amdgcn_global_load_lds((const unsigned*)((const char*)(gbase) + (voff)[_i]), (PG8_LAS unsigned*)(lds + (bufoff) + ldsw + _i * 8192), 16, 0, 0); } while (0)
#define PG8_LDA(dst, b, h) do { _Pragma("unroll") for (int m = 0; m < 4; ++m) _Pragma("unroll") for (int k = 0; k < 2; ++k) dst[m][k] = *(const PG8_LAS bf16x8*)(lds + PG8_SA(b, h) + aoff + m * 2048 + k * 1024); } while (0)
#define PG8_LDB(dst, b, h) do { _Pragma("unroll") for (int n = 0; n < 2; ++n) _Pragma("unroll") for (int k = 0; k < 2; ++k) dst[n][k] = *(const PG8_LAS bf16x8*)(lds + PG8_SB(b, h) + boff + n * 2048 + k * 1024); } while (0)
#define PG8_MMA(ai, bj, At, Bt) do { __builtin_amdgcn_s_setprio(1); _Pragma("unroll") for (int m = 0; m < 4; ++m) _Pragma("unroll") for (int n = 0; n < 2; ++n) _Pragma("unroll") for (int k = 0; k < 2; ++k) \
        acc[ai][bj][m][n] = __builtin_amdgcn_mfma_f32_16x16x32_bf16(Bt[n][k], At[m][k], acc[ai][bj][m][n], 0, 0, 0); __builtin_amdgcn_s_setprio(0); } while (0)
#define PG8_WAIT_V(n) asm volatile("s_waitcnt vmcnt(" #n ")" ::: "memory")
#define PG8_WAIT_L(n) asm volatile("s_waitcnt lgkmcnt(" #n ")" ::: "memory")
#define PG8_BAR __builtin_amdgcn_s_barrier()
#define PG8_SCHED __builtin_amdgcn_sched_barrier(0)
#define PG8_APTR(u) ((const char*)g.A + ((size_t)(u).pm * BM * g.lda + (size_t)(u).pn * g.a_col_pn + (size_t)(u).ks * g.K) * 2)
#define PG8_BPTR(u) ((const char*)g.Bt + ((size_t)(u).pn * BM * g.ldb + (size_t)(u).ks * g.K) * 2)
    Unit cur, nxt; int ui = 0;
    if (!S.next(0, cur)) return;
    f32x4 acc[2][2][4][2];
#pragma unroll
    for (int a = 0; a < 2; ++a)
#pragma unroll
        for (int b = 0; b < 2; ++b)
#pragma unroll
            for (int m = 0; m < 4; ++m)
#pragma unroll
                for (int n = 0; n < 2; ++n) acc[a][b][m][n] = (f32x4){0.f, 0.f, 0.f, 0.f};
    bf16x8 At[4][2], B0[2][2], B1[2][2];
    const char* cA = PG8_APTR(cur); const char* cB = PG8_BPTR(cur);
    if constexpr (SP2) {
        PG8_STAGE(PG8_SB(0, 0), cB, voffB); PG8_STAGE(PG8_SB(0, 1), cB + hstepB, voffB); PG8_STAGE(PG8_SA(0, 0), cA, voffA); PG8_STAGE(PG8_SA(0, 1), cA + hstepA, voffA);
        if (wr == 1) PG8_BAR;
        PG8_WAIT_V(2); PG8_BAR;
        PG8_STAGE(PG8_SB(1, 0), cB + kstep, voffB); PG8_STAGE(PG8_SA(1, 0), cA + kstep, voffA); PG8_STAGE(PG8_SB(1, 1), cB + hstepB + kstep, voffB);
        PG8_WAIT_V(6); PG8_BAR;
    } else {
        PG8_STAGE(PG8_SB(0, 0), cB, voffB); PG8_STAGE(PG8_SA(0, 0), cA, voffA); PG8_STAGE(PG8_SB(0, 1), cB + hstepB, voffB); PG8_STAGE(PG8_SA(0, 1), cA + hstepA, voffA);
        if (wr == 1) PG8_BAR;
        PG8_WAIT_V(4); PG8_BAR;
        PG8_STAGE(PG8_SB(1, 0), cB + kstep, voffB); PG8_STAGE(PG8_SA(1, 0), cA + kstep, voffA); PG8_STAGE(PG8_SB(1, 1), cB + hstepB + kstep, voffB);
        PG8_WAIT_V(6); PG8_BAR;
    }
    for (;;) {
        const bool has_next = S.next(ui + 1, nxt);
        const char* nA = has_next ? PG8_APTR(nxt) : cA; const char* nB = has_next ? PG8_BPTR(nxt) : cB;
#pragma unroll 1
        for (int t = 0; t < nt; t += 2) {
            const bool last = (t == nt - 2);
            const char* a1 = cA + (size_t)(t + 1) * kstep;
            const char* a2 = last ? nA : cA + (size_t)(t + 2) * kstep; const char* b2 = last ? nB : cB + (size_t)(t + 2) * kstep;
            const char* a3 = a2 + kstep; const char* b3 = b2 + kstep;
            if constexpr (SP2) {
            PG8_LDB(B0, 0, 0); PG8_LDB(B1, 0, 1); PG8_SCHED; PG8_LDA(At, 0, 0); PG8_STAGE(PG8_SA(1, 1), a1 + hstepA, voffA);
            PG8_WAIT_V(8); PG8_WAIT_L(0); PG8_BAR; PG8_MMA(0, 0, At, B0); PG8_MMA(0, 1, At, B1); PG8_BAR; PG8_SCHED;
            PG8_LDA(At, 0, 1); PG8_STAGE(PG8_SB(0, 0), b2, voffB); PG8_STAGE(PG8_SB(0, 1), b2 + hstepB, voffB); PG8_STAGE(PG8_SA(0, 0), a2, voffA);
            PG8_WAIT_V(8); PG8_WAIT_L(0); PG8_BAR; PG8_MMA(1, 0, At, B0); PG8_MMA(1, 1, At, B1); PG8_BAR; PG8_SCHED;
            PG8_LDB(B0, 1, 0); PG8_LDB(B1, 1, 1); PG8_SCHED; PG8_LDA(At, 1, 0); PG8_STAGE(PG8_SA(0, 1), a2 + hstepA, voffA);
            PG8_WAIT_V(8); PG8_WAIT_L(0); PG8_BAR; PG8_MMA(0, 0, At, B0); PG8_MMA(0, 1, At, B1); PG8_BAR; PG8_SCHED;
            PG8_LDA(At, 1, 1); PG8_STAGE(PG8_SB(1, 0), b3, voffB); PG8_STAGE(PG8_SB(1, 1), b3 + hstepB, voffB); PG8_STAGE(PG8_SA(1, 0), a3, voffA);
            PG8_WAIT_V(8); PG8_WAIT_L(0); PG8_BAR; PG8_MMA(1, 0, At, B0); PG8_MMA(1, 1, At, B1); PG8_BAR; PG8_SCHED;
            } else {
            PG8_LDB(B0, 0, 0); PG8_SCHED; PG8_LDA(At, 0, 0); PG8_STAGE(PG8_SA(1, 1), a1 + hstepA, voffA);
            PG8_WAIT_L(8); PG8_BAR; PG8_WAIT_L(0); PG8_MMA(0, 0, At, B0); PG8_BAR; PG8_SCHED;
            PG8_LDB(B1, 0, 1); PG8_STAGE(PG8_SB(0, 0), b2, voffB);
            PG8_BAR; PG8_WAIT_L(0); PG8_MMA(0, 1, At, B1); PG8_BAR;
            PG8_LDA(At, 0, 1); PG8_STAGE(PG8_SA(0, 0), a2, voffA);
            PG8_BAR; PG8_WAIT_L(0); PG8_MMA(1, 0, At, B0); PG8_BAR; PG8_SCHED;
            PG8_STAGE(PG8_SB(0, 1), b2 + hstepB, voffB);
            PG8_WAIT_V(6); PG8_BAR; PG8_MMA(1, 1, At, B1); PG8_BAR;
            PG8_LDB(B0, 1, 0); PG8_SCHED; PG8_LDA(At, 1, 0); PG8_STAGE(PG8_SA(0, 1), a2 + hstepA, voffA);
            PG8_WAIT_L(8); PG8_BAR; PG8_WAIT_L(0); PG8_MMA(0, 0, At, B0); PG8_BAR; PG8_SCHED;
            PG8_LDB(B1, 1, 1); PG8_STAGE(PG8_SB(1, 0), b3, voffB);
            PG8_BAR; PG8_WAIT_L(0); PG8_MMA(0, 1, At, B1); PG8_BAR;
            PG8_LDA(At, 1, 1); PG8_STAGE(PG8_SA(1, 0), a3, voffA);
            PG8_BAR; PG8_WAIT_L(0); PG8_MMA(1, 0, At, B0); PG8_BAR; PG8_SCHED;
            PG8_STAGE(PG8_SB(1, 1), b3 + hstepB, voffB);
            PG8_WAIT_V(6); PG8_BAR; PG8_MMA(1, 1, At, B1); PG8_BAR;
            }
        }
        if constexpr (ALIGN_EPI) { if (wr == 0) PG8_BAR; }
        E(acc, cur, wr, wc, fr, fq);
        if (!has_next) break;
#pragma unroll
        for (int a = 0; a < 2; ++a)
#pragma unroll
            for (int b = 0; b < 2; ++b)
#pragma unroll
                for (int m = 0; m < 4; ++m)
#pragma unroll
                    for (int n = 0; n < 2; ++n) acc[a][b][m][n] = (f32x4){0.f, 0.f, 0.f, 0.f};
        cur = nxt; cA = nA; cB = nB; ++ui;
        if constexpr (ALIGN_EPI) { if (wr == 1) PG8_BAR; }
    }
    PG8_WAIT_V(0);
    if constexpr (!ALIGN_EPI) { if (wr == 0) PG8_BAR; }
    PG8_BAR;
#undef PG8_SA
#undef PG8_SB
#undef PG8_STAGE
#undef PG8_LDA
#undef PG8_LDB
#undef PG8_MMA
#undef PG8_WAIT_V
#undef PG8_WAIT_L
#undef PG8_BAR
#undef PG8_SCHED
#undef PG8_APTR
#undef PG8_BPTR
}
#else
static thread_local float* emu_tile = nullptr;
template <class Epi, class Sched, bool ALIGN_EPI = false, bool SP2 = false>
static void gemm_phase(unsigned char* lds, const Gemm g, const Sched& S, const Epi& E, const int tid_) {
    const int tid = tid_, wid = tid >> 6, lane = tid & 63, wr = wid >> 2, wc = wid & 3, fr = lane & 15, fq = lane >> 4;
    if (!emu_tile) emu_tile = (float*)malloc(256 * 256 * 4);
    Unit u;
    for (int i = 0; S.next(i, u); ++i) {
        const bf16_t* A = g.A + (size_t)u.pm * BM * g.lda + (size_t)u.pn * g.a_col_pn + (size_t)u.ks * g.K; const bf16_t* Bt = g.Bt + (size_t)u.pn * BM * g.ldb + (size_t)u.ks * g.K;
        { const int r = tid >> 1, c0 = (tid & 1) * 128; std::vector<float> ar(g.K); for (int k = 0; k < g.K; ++k) ar[k] = bf2f(A[(size_t)r * g.lda + k]);
          for (int c = c0; c < c0 + 128; ++c) { const bf16_t* br = Bt + (size_t)c * g.ldb; float s0 = 0, s1 = 0, s2 = 0, s3 = 0; for (int k = 0; k < g.K; k += 4) { s0 += ar[k] * bf2f(br[k]); s1 += ar[k + 1] * bf2f(br[k + 1]); s2 += ar[k + 2] * bf2f(br[k + 2]); s3 += ar[k + 3] * bf2f(br[k + 3]); } emu_tile[r * 256 + c] = (s0 + s1) + (s2 + s3); } }
        __syncthreads();
        f32x4 acc[2][2][4][2];
        for (int ai = 0; ai < 2; ++ai) for (int bj = 0; bj < 2; ++bj) for (int m = 0; m < 4; ++m) for (int n = 0; n < 2; ++n) for (int e = 0; e < 4; ++e) {
            const int r = 128 * ai + 64 * wr + 16 * m + fr; const int c = Epi::PERM ? (128 * bj + 32 * wc + 8 * fq + 4 * n + e) : (128 * bj + 32 * wc + 16 * n + 4 * fq + e);
            acc[ai][bj][m][n][e] = emu_tile[r * 256 + c]; }
        E(acc, u, wr, wc, fr, fq);
        __syncthreads();
    }
}
#endif
}

constexpr size_t al256(size_t x) { return (x + 255) & ~(size_t)255; }
constexpr size_t WS_CTL = 0, CTL_BYTES = 1u << 15;
constexpr size_t WS_MOD = WS_CTL + CTL_BYTES;
constexpr size_t SZ_MOD = al256((size_t)DEPTH * 3 * 6 * D * 4);
constexpr int ADA_KC = 16;
constexpr size_t WS_ADAP = WS_MOD + SZ_MOD;
constexpr size_t SZ_ADAP = al256((size_t)DEPTH * ADA_KC * 3 * 6 * D * 4);
constexpr size_t WL_WIN = 0, WL_WOUT = WL_WIN + (size_t)INWP * D * 2, WL_WGU = WL_WOUT + (size_t)D * D * 2, WL_WDN = WL_WGU + (size_t)2 * DFF * D * 2,
                 WL_GUP = WL_WDN + (size_t)D * DFF * 2, WL_POOL = WL_GUP + (size_t)RW * GL * 2, WL_DUP = WL_POOL + (size_t)4 * PG * PG * 2,
                 WL_IUP = WL_DUP + (size_t)2 * RW * LORA * 2, WL_SIZE = al256(WL_IUP + (size_t)2 * RW * LORA * 2);
constexpr size_t WS_W = WS_ADAP + SZ_ADAP;
constexpr size_t WS_XN = WS_W + WL_SIZE * DEPTH;
constexpr size_t WS_MIX = WS_XN + (size_t)MR * D * 2;
constexpr size_t WS_CTXH = WS_MIX + (size_t)MR * D * 2;
constexpr size_t WS_SSEG = WS_CTXH + (size_t)MC * D * 4;
constexpr size_t SZ_ST = (size_t)NB * NH * 2 * NSEG * 4096 * 4;
constexpr size_t WS_PSEG = WS_SSEG + SZ_ST, WS_HIN = WS_PSEG + SZ_ST;
constexpr size_t WS_BS = WS_HIN + SZ_ST;
constexpr size_t WS_BIG = al256(WS_BS + (size_t)2 * MR * NH * 4);
constexpr size_t WS_U = WS_BIG;
constexpr size_t WS_YF = WS_U + (size_t)MR * INWP * 2;
constexpr size_t WS_XB = WS_YF + (size_t)2 * MR * RW * 2;
static_assert((size_t)ML * D * 2 <= (size_t)2 * MR * RW * 2 && WS_XB >= WS_U + (size_t)MR * DFF * 2, "XB placement");
constexpr size_t WS_G = WS_YF + (size_t)2 * MR * RW * 4;
constexpr size_t WS_PD = WS_G + (size_t)MR * RW * 2;
constexpr size_t WS_VS = WS_PD + (size_t)MR * PWD * 2;
constexpr int KSPLIT = 512, NPART_DN = DFF / KSPLIT, NPART_WO = D / KSPLIT;
constexpr size_t WS_PART = WS_VS + (size_t)ML * PWD * 2;
constexpr size_t WS_BIG_END1 = WS_PART + (size_t)NPART_DN * MC * D * 4;
static_assert(DFF % KSPLIT == 0 && D % KSPLIT == 0, "split-K slices");
constexpr size_t WS_H = WS_BIG;
constexpr size_t WS_BIG_END2 = WS_H + (size_t)MR * DFF * 2;
constexpr size_t WS_END = WS_BIG_END1 > WS_BIG_END2 ? WS_BIG_END1 : WS_BIG_END2;
constexpr int CW_BAR = 4096;

constexpr int IMG = 8192;
constexpr int M_RT = 0, M_AT = 1, M_KB = 2, M_BB = 3, M_VT = 4, N_IMG = 5;
constexpr int SET_BYTES = N_IMG * IMG;
constexpr int SCR_G = 2 * SET_BYTES, SCR_AI = SCR_G + 64 * 64 * 4;
constexpr int SC_GC = SCR_AI + 64 * 64 * 4;
constexpr int SC_PAR = SC_GC + 512;
constexpr int SC_SH = SC_PAR + 3072;
constexpr int MISC_OFF = (SC_SH + 16384) > 131072 ? (SC_SH + 16384) : 131072;
constexpr int LDS_BYTES = MISC_OFF + 512;
static_assert(LDS_BYTES <= 160 * 1024 && pg8::STAGE_BYTES <= MISC_OFF, "LDS");

#define XB_TMO      128
#define XB_XCNT(j)  (256  + 64 * (j))
#define XB_XSUB(j)  (1280 + 64 * (j))
#define XB_XGEN(j)  (2304 + 64 * (j))
#define XB_TOP      3328
#define XB_TOPGEN   3392
#define XCD_BAR_WORDS 3456
#define XB_SPIN_CAP (1u << 18)
#ifndef EMU
__device__ __forceinline__ unsigned xb_ld(unsigned* p)              { return __hip_atomic_load(p, __ATOMIC_RELAXED, __HIP_MEMORY_SCOPE_AGENT); }
__device__ __forceinline__ unsigned xb_add(unsigned* p, unsigned v) { return __hip_atomic_fetch_add(p, v, __ATOMIC_RELAXED, __HIP_MEMORY_SCOPE_AGENT); }
__device__ __forceinline__ unsigned xb_xcc_id() { return (unsigned)__builtin_amdgcn_s_getreg((3 << 11) | 20) & 0xFu; }
#define XB_SPIN(cond, bar) do { unsigned _sp = 0; while (cond) { __builtin_amdgcn_s_sleep(1); \
    if ((++_sp & 255u) == 0u) { if (xb_ld(&(bar)[XB_TMO])) break; if (_sp > XB_SPIN_CAP) { atomicAdd(&(bar)[XB_TMO], 1u); break; } } } } while (0)
struct XcdBarrier { unsigned* bar; unsigned x; volatile LAS unsigned* st; };
__device__ __forceinline__ XcdBarrier xcd_barrier_post(unsigned* bar, volatile LAS unsigned* st) {
    XcdBarrier b; b.bar = bar; b.x = xb_xcc_id(); b.st = st;
    if (threadIdx.x == 0) (void)xb_add(&bar[XB_XCNT(b.x)], 1u);
    return b;
}
__device__ __forceinline__ void xcd_barrier_complete(unsigned* bar, unsigned x, unsigned& nloc, unsigned& nx) {
    const unsigned G = gridDim.x * gridDim.y * gridDim.z;
    unsigned sum, cnt, mine, sp = 0u;
    for (;;) {
        sum = 0u; cnt = 0u; mine = 0u;
#pragma unroll
        for (unsigned j = 0; j < 16; ++j) { const unsigned c = xb_ld(&bar[XB_XCNT(j)]); sum += c; cnt += (c > 0u) ? 1u : 0u; mine = (j == x) ? c : mine; }
        if (sum == G) break;
        __builtin_amdgcn_s_sleep(1);
        if ((++sp & 255u) == 0u) { if (xb_ld(&bar[XB_TMO])) break; if (sp > XB_SPIN_CAP) { atomicAdd(&bar[XB_TMO], 1u); break; } }
    }
    nloc = mine > 0u ? mine : 1u; nx = cnt > 0u ? cnt : 1u;
}
__device__ __forceinline__ void xcd_barrier(const XcdBarrier& b, const bool t0) {
    asm volatile("s_waitcnt vmcnt(0)" ::: "memory");
    __syncthreads();
    if (t0) {
        unsigned* bar = b.bar;
        __builtin_amdgcn_s_waitcnt(0);
        unsigned nloc = b.st[0], nx = b.st[1];
        if (nloc == 0u) { xcd_barrier_complete(bar, b.x, nloc, nx); b.st[0] = nloc; b.st[1] = nx; }
        const unsigned old = xb_add(&bar[XB_XSUB(b.x)], 1u);
        const unsigned gen = old / nloc;
        if (old + 1u == (gen + 1u) * nloc) {
            __builtin_amdgcn_fence(__ATOMIC_RELEASE, "agent");
            asm volatile("s_waitcnt vmcnt(0)" ::: "memory");
            const unsigned og = xb_add(&bar[XB_TOP], 1u);
            const unsigned tg = og / nx;
            if (og + 1u == (tg + 1u) * nx) xb_add(&bar[XB_TOPGEN], 1u);
            else XB_SPIN(xb_ld(&bar[XB_TOPGEN]) == tg, bar);
            __builtin_amdgcn_fence(__ATOMIC_ACQUIRE, "agent");
            xb_add(&bar[XB_XGEN(b.x)], 1u);
            asm volatile("s_waitcnt vmcnt(0)" ::: "memory");
        } else {
            XB_SPIN(xb_ld(&bar[XB_XGEN(b.x)]) == gen, bar);
            __builtin_amdgcn_fence(__ATOMIC_ACQUIRE, "agent");
            asm volatile("s_waitcnt vmcnt(0)" ::: "memory");
        }
    }
    __syncthreads();
}
#else
struct XcdBarrier { unsigned* bar; };
static inline void xcd_barrier(const XcdBarrier&) { fprintf(stderr, "EMU: grid barrier not supported (use per-phase launches)\n"); abort(); }
#endif

struct Inputs {
    const float *x, *c, *ctx, *c_ctx, *ada_w, *ada_b, *norm_mix, *norm_ffn, *w_in, *conv_rkv, *decay_bias, *decay_up, *iclr_bias, *iclr_up, *gate_up,
        *k_k, *k_a, *r_k, *gn_w, *gn_b, *pool_w, *pool_scale, *w_out, *ffn_gate, *ffn_up, *ffn_down, *final_norm;
};
struct Args { Inputs in; float* out; unsigned char* ws; int ph_lo, ph_hi; };
struct Frame {
    LAS unsigned char* lds;
    int tid, lane, wave, vcu, G;
    float* out; unsigned char* ws;
};
DI bf16_t* wl_ptr(const Frame& F, int l, size_t off) { return (bf16_t*)(F.ws + WS_W + (size_t)l * WL_SIZE + off); }
DI const float* mod_ptr(const Frame& F, int l, int s, int j) { return (const float*)(F.ws + WS_MOD) + ((size_t)(l * 3 + s) * 6 + j) * D; }
DI int sample_of_row(int row) { return row < ML ? row / SEQ : 2; }

struct P0Desc { const float* W; bf16_t* WT; int N, ldo, dst_row0, k0, n0; };
DI void p0_load(const P0Desc& d, const int lane, float (&v)[32]) {
#pragma unroll
    for (int i = 0; i < 32; ++i) { const int kk = 2 * i + (lane >> 5); v[i] = d.W[(size_t)(d.k0 + kk) * d.N + d.n0 + (lane & 31)]; }
}
DI void p0_store(const P0Desc& d, const int lane, const float (&v)[32], LAS float* scr) {
#pragma unroll
    for (int i = 0; i < 32; ++i) { const int kk = 2 * i + (lane >> 5); scr[kk * 33 + (lane & 31)] = v[i]; }
    LDS_WAIT();
    const int c = lane & 7;
#pragma unroll
    for (int j = 0; j < 4; ++j) { const int n = (lane >> 3) + 8 * j; const LAS float* s = scr + (8 * c) * 33 + n;
        u32x4 o; o.x = pk2(s[0 * 33], s[1 * 33]); o.y = pk2(s[2 * 33], s[3 * 33]); o.z = pk2(s[4 * 33], s[5 * 33]); o.w = pk2(s[6 * 33], s[7 * 33]);
        *(u32x4*)(d.WT + (size_t)(d.dst_row0 + n) * d.ldo + d.k0 + 8 * c) = o; }
    LDS_WAIT();
}
constexpr int P0_I_WIN = (D / 64) * (INW / 32), P0_I_WOUT = (D / 64) * (D / 32), P0_I_G = (D / 64) * (DFF / 32), P0_I_DN = (DFF / 64) * (D / 32), P0_I_GUP = (GL / 64) * (RW / 32), P0_I_POOL = 4 * (PG / 64) * (PG / 32);
constexpr int P0_I_T = P0_I_WIN + P0_I_WOUT + 2 * P0_I_G + P0_I_DN + P0_I_GUP;
DI void p0_desc(const Frame& F, const CAS Inputs& IN_, const int it, P0Desc& d) {
    const int l = it / P0_I_T; int r = it % P0_I_T;
    if (r < P0_I_WIN) { const int nb = INW / 32, kb = r / nb, n0 = 32 * (r % nb); d = P0Desc{IN_.w_in + (size_t)l * D * INW, wl_ptr(F, l, WL_WIN), INW, D, n0, 64 * kb, n0}; return; } r -= P0_I_WIN;
    if (r < P0_I_WOUT) { const int nb = D / 32, kb = r / nb, n0 = 32 * (r % nb); d = P0Desc{IN_.w_out + (size_t)l * D * D, wl_ptr(F, l, WL_WOUT), D, D, n0, 64 * kb, n0}; return; } r -= P0_I_WOUT;
    if (r < 2 * P0_I_G) { const int up = r >= P0_I_G; if (up) r -= P0_I_G; const int nb = DFF / 32, kb = r / nb, n0 = 32 * (r % nb);
        d = P0Desc{(up ? IN_.ffn_up : IN_.ffn_gate) + (size_t)l * D * DFF, wl_ptr(F, l, WL_WGU), DFF, D, (n0 / 128) * 256 + (n0 % 128) + (up ? 128 : 0), 64 * kb, n0}; return; } r -= 2 * P0_I_G;
    if (r < P0_I_DN) { const int nb = D / 32, kb = r / nb, n0 = 32 * (r % nb); d = P0Desc{IN_.ffn_down + (size_t)l * DFF * D, wl_ptr(F, l, WL_WDN), D, DFF, n0, 64 * kb, n0}; return; } r -= P0_I_DN;
    { const int nb = RW / 32, kb = r / nb, n0 = 32 * (r % nb); d = P0Desc{IN_.gate_up + (size_t)l * GL * RW, wl_ptr(F, l, WL_GUP), RW, GL, n0, 64 * kb, n0}; }
}
DI void p0_convert_span(Frame& F, const CAS Inputs& IN_, const int l, const int r_lo, const int r_hi, const int w, const int NW) {
    LAS float* scr = (LAS float*)(F.lds + F.wave * 16384);
    const int end = l * P0_I_T + r_hi; int it = l * P0_I_T + r_lo + w; P0Desc dc; float v[32];
    if (it < end) { p0_desc(F, IN_, it, dc); p0_load(dc, F.lane, v); }
    while (it < end) { const int itn = it + NW; const bool hn = itn < end; P0Desc dn = dc; float vn[32];
        if (hn) { p0_desc(F, IN_, itn, dn); p0_load(dn, F.lane, vn); }
        p0_store(dc, F.lane, v, scr);
        if (hn) { dc = dn;
#pragma unroll
            for (int i = 0; i < 32; ++i) v[i] = vn[i]; }
        it = itn; }
}
constexpr int P0_R_WOUT0 = P0_I_WIN, P0_R_WOUT1 = P0_I_WIN + P0_I_WOUT, P0_R_A1 = P0_R_WOUT1 + P0_I_G;
#ifndef P0_DEFER
#define P0_DEFER 1
#endif
DI int conv_in(int G) { return (P0_DEFER && G % 8 == 0 && G >= 32) ? G / 16 : 0; }
DI int conv_up(int G) { return (P0_DEFER && G % 8 == 0 && G >= 32) ? G / 32 : 0; }
DI void phase_p0(Frame& F, const CAS Inputs& IN_) {
    const int gw = F.vcu * 8 + F.wave, NGW = F.G * 8;
    { const bool defer = conv_in(F.G) > 0;
      p0_convert_span(F, IN_, 0, 0, P0_I_T, gw, NGW);
      for (int l = 1; l < DEPTH; ++l) { if (defer) p0_convert_span(F, IN_, l, P0_R_WOUT0, P0_R_WOUT1, gw, NGW); else p0_convert_span(F, IN_, l, 0, P0_I_T, gw, NGW); } }
    for (int it = gw; it < P0_I_POOL * DEPTH; it += NGW) { const int l = it / P0_I_POOL; int r = it % P0_I_POOL;
        const int gi = r / ((PG / 64) * (PG / 32)); r %= (PG / 64) * (PG / 32); const int nb = PG / 32, kb = r / nb, n0 = 32 * (r % nb);
        const float* src = IN_.pool_w + ((size_t)l * 4 + gi) * PG * PG; bf16_t* dst = wl_ptr(F, l, WL_POOL) + (size_t)gi * PG * PG; const int co = n0 + (F.lane & 31); const float sc = IN_.pool_scale[(size_t)l * PWD + gi * PG + co];
#pragma unroll 8
        for (int i = 0; i < 32; ++i) { const int ci = 64 * kb + 2 * i + (F.lane >> 5); dst[(size_t)ci * PG + co] = (bf16_t)f2bf(src[(size_t)ci * PG + co] * sc); } }
    const int gt = F.vcu * 512 + F.tid, NGT = F.G * 512;
    for (int i = gt; i < DEPTH * (INWP - INW) * D / 8; i += NGT) { const int l = i / ((INWP - INW) * D / 8), r = i % ((INWP - INW) * D / 8);
        *(u32x4*)(wl_ptr(F, l, WL_WIN) + (size_t)INW * D + (size_t)r * 8) = (u32x4){0u, 0u, 0u, 0u}; }
    for (int i = gt; i < DEPTH * 2 * 2 * RW * LORA; i += NGT) { int r = i; const int k = r % LORA; r /= LORA; const int n = r % RW; r /= RW; const int d = r % 2; r /= 2; const int which = r % 2; const int l = r / 2;
        const float* src = (which ? IN_.iclr_up : IN_.decay_up) + (((size_t)l * 2 + d) * LORA + k) * RW + n;
        wl_ptr(F, l, which ? WL_IUP : WL_DUP)[((size_t)d * RW + n) * LORA + k] = (bf16_t)f2bf(*src); }
    constexpr int NJB = 6 * D / 256, KCH = D / ADA_KC;
    for (int it = gw; it < DEPTH * NJB * ADA_KC; it += NGW) {
        const int kc = it % ADA_KC, jb = (it / ADA_KC) % NJB, l = it / (ADA_KC * NJB);
        const float* w = IN_.ada_w + ((size_t)l * D + (size_t)kc * KCH) * 6 * D + jb * 256 + 4 * F.lane;
        f32x4 a0 = {0.f, 0.f, 0.f, 0.f}, a1 = a0, a2 = a0;
#pragma unroll 8
        for (int k = 0; k < KCH; ++k) { const int kk = kc * KCH + k; const f32x4 wv = *(const f32x4*)(w + (size_t)k * 6 * D);
            const float c0 = fsilu(IN_.c[kk]), c1 = fsilu(IN_.c[D + kk]), c2 = fsilu(IN_.c_ctx[kk]);
            a0 += wv * c0; a1 += wv * c1; a2 += wv * c2; }
        float* p = (float*)(F.ws + WS_ADAP) + (((size_t)l * ADA_KC + kc) * 3) * 6 * D + jb * 256 + 4 * F.lane;
        *(f32x4*)(p) = a0; *(f32x4*)(p + 6 * D) = a1; *(f32x4*)(p + 12 * D) = a2;
    }
}
DI void phase_p0b(Frame& F, const CAS Inputs& IN_) {
    const int gt = F.vcu * 512 + F.tid, NGT = F.G * 512;
    for (int i = gt; i < DEPTH * 3 * 6 * D; i += NGT) { const int j = i % (6 * D), s = (i / (6 * D)) % 3, l = i / (18 * D);
        float a = IN_.ada_b[(size_t)l * 6 * D + j];
        for (int kc = 0; kc < ADA_KC; ++kc) a += ((const float*)(F.ws + WS_ADAP))[(((size_t)l * ADA_KC + kc) * 3 + s) * 6 * D + j];
        ((float*)(F.ws + WS_MOD))[i] = a; }
}

DI void phase_norm(Frame& F, const CAS Inputs& IN_, int l, bool second, int nrows, const int nparts, const float* cbase, const float* cgate) {
    const int gw = F.vcu * 8 + F.wave, NGW = F.G * 8;
    const float* gvec = (second ? IN_.norm_ffn : IN_.norm_mix) + (size_t)l * D;
    bf16_t* XN = (bf16_t*)(F.ws + WS_XN);
    int row_first = gw;
    if (!(l == 0 && !second)) {
        const bf16_t* XB = (const bf16_t*)(F.ws + WS_XB);
        for (int row = gw; row < ML; row += 2 * NGW) {
            const int row1 = row + NGW; const bool has1 = row1 < ML;
            u32x4 w0[4], w1[4];
#pragma unroll
            for (int j2 = 0; j2 < 4; ++j2) { w0[j2] = *(const u32x4*)(XB + (size_t)row * D + 8 * (F.lane + 64 * j2)); w1[j2] = has1 ? *(const u32x4*)(XB + (size_t)row1 * D + 8 * (F.lane + 64 * j2)) : (u32x4){0u, 0u, 0u, 0u}; }
            float f0[4][8], f1[4][8]; float s0 = 0.f, s1 = 0.f;
#pragma unroll
            for (int j2 = 0; j2 < 4; ++j2) { unpack8(w0[j2], f0[j2]); unpack8(w1[j2], f1[j2]);
#pragma unroll
                for (int e = 0; e < 8; ++e) { s0 += f0[j2][e] * f0[j2][e]; s1 += f1[j2][e] * f1[j2][e]; } }
#pragma unroll
            for (int o = 1; o < 64; o <<= 1) { s0 += __shfl_xor(s0, o); s1 += __shfl_xor(s1, o); }
            const float rs0 = frsq(s0 * (1.f / D) + RMS_EPS), rs1 = frsq(s1 * (1.f / D) + RMS_EPS);
            const int sa = row / SEQ, sb = has1 ? row1 / SEQ : sa;
            const float* sh0 = mod_ptr(F, l, sa, second ? 3 : 0); const float* sc0 = mod_ptr(F, l, sa, second ? 4 : 1);
            const float* sh1 = mod_ptr(F, l, sb, second ? 3 : 0); const float* sc1 = mod_ptr(F, l, sb, second ? 4 : 1);
#pragma unroll
            for (int j2 = 0; j2 < 4; ++j2) { const int c = 8 * (F.lane + 64 * j2); float g8[8], o0[8], o1[8];
                { const f32x4 ga = *(const f32x4*)(gvec + c), gb = *(const f32x4*)(gvec + c + 4); g8[0] = ga[0]; g8[1] = ga[1]; g8[2] = ga[2]; g8[3] = ga[3]; g8[4] = gb[0]; g8[5] = gb[1]; g8[6] = gb[2]; g8[7] = gb[3]; }
                { const f32x4 a0 = *(const f32x4*)(sc0 + c), a1 = *(const f32x4*)(sc0 + c + 4), b0 = *(const f32x4*)(sh0 + c), b1 = *(const f32x4*)(sh0 + c + 4);
#pragma unroll
                  for (int e = 0; e < 4; ++e) { o0[e] = f0[j2][e] * rs0 * g8[e] * (a0[e] + 1.0f) + b0[e]; o0[4 + e] = f0[j2][4 + e] * rs0 * g8[4 + e] * (a1[e] + 1.0f) + b1[e]; } }
                *(u32x4*)(XN + (size_t)row * D + c) = pack8(o0);
                if (has1) { const f32x4 a0 = *(const f32x4*)(sc1 + c), a1 = *(const f32x4*)(sc1 + c + 4), b0 = *(const f32x4*)(sh1 + c), b1 = *(const f32x4*)(sh1 + c + 4);
#pragma unroll
                  for (int e = 0; e < 4; ++e) { o1[e] = f1[j2][e] * rs1 * g8[e] * (a0[e] + 1.0f) + b0[e]; o1[4 + e] = f1[j2][4 + e] * rs1 * g8[4 + e] * (a1[e] + 1.0f) + b1[e]; }
                  *(u32x4*)(XN + (size_t)row1 * D + c) = pack8(o1); } }
        }
        row_first = ML + gw;
    }
    for (int row = row_first; row < nrows; row += NGW) {
        const float* xr;
        const bool lat_bf = row < ML && !(l == 0 && !second);
        if (row < ML) xr = IN_.x + (size_t)row * D;
        else xr = (nparts > 0 ? cbase : ((l == 0 && !second) ? IN_.ctx : (const float*)(F.ws + WS_CTXH))) + (size_t)(row - ML) * D;
        const int s = sample_of_row(row);
        const float* sh = mod_ptr(F, l, s, second ? 3 : 0); const float* sc = mod_ptr(F, l, s, second ? 4 : 1);
        f32x4 v[8]; float ss = 0.f;
        if (lat_bf) { const bf16_t* xb = (const bf16_t*)(F.ws + WS_XB) + (size_t)row * D;
#pragma unroll
            for (int j2 = 0; j2 < 4; ++j2) { float f[8]; unpack8(*(const u32x4*)(xb + 8 * (F.lane + 64 * j2)), f); v[2 * j2] = (f32x4){f[0], f[1], f[2], f[3]}; v[2 * j2 + 1] = (f32x4){f[4], f[5], f[6], f[7]}; }
        } else {
#pragma unroll
            for (int j = 0; j < 8; ++j) v[j] = *(const f32x4*)(xr + 4 * (F.lane + 64 * j)); }
        if (row >= ML && nparts > 0) {
            const float* pp = (const float*)(F.ws + WS_PART) + (size_t)(row - ML) * D; float* xo = (float*)(F.ws + WS_CTXH) + (size_t)(row - ML) * D;
#pragma unroll
            for (int j = 0; j < 8; ++j) { const int c = 4 * (F.lane + 64 * j); f32x4 a = {0.f, 0.f, 0.f, 0.f};
                for (int k = 0; k < nparts; ++k) a += *(const f32x4*)(pp + (size_t)k * MC * D + c);
                v[j] += *(const f32x4*)(cgate + c) * a; *(f32x4*)(xo + c) = v[j]; }
        }
#pragma unroll
        for (int j = 0; j < 8; ++j) ss += (v[j].x * v[j].x + v[j].y * v[j].y) + (v[j].z * v[j].z + v[j].w * v[j].w);
        const float rs = frsq(wave_sum(ss) * (1.f / D) + RMS_EPS);
#pragma unroll
        for (int j = 0; j < 8; ++j) { const int c = lat_bf ? 8 * (F.lane + 64 * (j >> 1)) + 4 * (j & 1) : 4 * (F.lane + 64 * j); const f32x4 g = *(const f32x4*)(gvec + c), a = *(const f32x4*)(sc + c), b = *(const f32x4*)(sh + c);
            const f32x4 o = v[j] * rs * g * (a + 1.0f) + b; u32x2 w; w.x = pk2(o.x, o.y); w.y = pk2(o.z, o.w); *(u32x2*)(XN + (size_t)row * D + c) = w; }
    }
}
DI void phase_final_norm(Frame& F, const CAS Inputs& IN_) {
    const int gw = F.vcu * 8 + F.wave, NGW = F.G * 8;
    const bf16_t* XB = (const bf16_t*)(F.ws + WS_XB);
    for (int row0 = gw; row0 < ML; row0 += 4 * NGW) {
        u32x4 w[4][4];
#pragma unroll
        for (int r = 0; r < 4; ++r) { const int row = row0 + r * NGW; const bool ok = row < ML;
#pragma unroll
            for (int j2 = 0; j2 < 4; ++j2) w[r][j2] = ok ? *(const u32x4*)(XB + (size_t)row * D + 8 * (F.lane + 64 * j2)) : (u32x4){0u, 0u, 0u, 0u}; }
#pragma unroll
        for (int r = 0; r < 4; ++r) { const int row = row0 + r * NGW; if (row >= ML) break;
            float* xr = F.out + (size_t)row * D; f32x4 v[8]; float ss = 0.f;
#pragma unroll
            for (int j2 = 0; j2 < 4; ++j2) { float f[8]; unpack8(w[r][j2], f); v[2 * j2] = (f32x4){f[0], f[1], f[2], f[3]}; v[2 * j2 + 1] = (f32x4){f[4], f[5], f[6], f[7]}; }
#pragma unroll
            for (int j = 0; j < 8; ++j) ss += (v[j].x * v[j].x + v[j].y * v[j].y) + (v[j].z * v[j].z + v[j].w * v[j].w);
            const float rs = frsq(wave_sum(ss) * (1.f / D) + RMS_EPS);
#pragma unroll
            for (int j = 0; j < 8; ++j) { const int c = 8 * (F.lane + 64 * (j >> 1)) + 4 * (j & 1); *(f32x4*)(xr + c) = v[j] * rs * *(const f32x4*)(IN_.final_norm + c); }
        }
    }
}

struct EpiU {
    static constexpr bool PERM = true;
    bf16_t* O; int ldc; int act;
    DI void operator()(const f32x4 (&acc)[2][2][4][2], const pg8::Unit& u, int wr, int wc, int fr, int fq) const {
        const int row0 = u.pm * 256 + wr * 64 + fr, col0 = u.pn * 256 + wc * 32 + 8 * fq;
        const bool special = act && (col0 + 128 + 8 > OFF_W) && (col0 < OFF_POOL);
#pragma unroll
        for (int ai = 0; ai < 2; ++ai)
#pragma unroll
            for (int m = 0; m < 4; ++m) { bf16_t* rowp = O + (size_t)(row0 + ai * 128 + m * 16) * ldc + col0;
#pragma unroll
                for (int bj = 0; bj < 2; ++bj) { f32x4 v0 = acc[ai][bj][m][0], v1 = acc[ai][bj][m][1];
                    if (special) { const int c = col0 + bj * 128;
                        if (c >= OFF_W && c < OFF_A) {
#pragma unroll
                            for (int e = 0; e < 4; ++e) { v0[e] = ftanh(v0[e]); v1[e] = ftanh(v1[e]); } }
                        else if (c >= OFF_G && c < OFF_POOL) {
#pragma unroll
                            for (int e = 0; e < 4; ++e) { v0[e] = fsigmoid(v0[e]); v1[e] = fsigmoid(v1[e]); } } }
                    u32x4 w; w.x = pk2(v0[0], v0[1]); w.y = pk2(v0[2], v0[3]); w.z = pk2(v1[0], v1[1]); w.w = pk2(v1[2], v1[3]);
                    *(u32x4*)(rowp + bj * 128) = w; } }
    }
};
struct EpiFold {
    static constexpr bool PERM = true;
    bf16_t* O;
    DI void operator()(const f32x4 (&acc)[2][2][4][2], const pg8::Unit& u, int wr, int wc, int fr, int fq) const {
        const int row0 = u.pm * 256 + wr * 64 + fr, col0 = u.pn * 256 + wc * 32 + 8 * fq; bf16_t* Ol = O + (size_t)u.ks * PG;
#pragma unroll
        for (int ai = 0; ai < 2; ++ai)
#pragma unroll
            for (int m = 0; m < 4; ++m)
#pragma unroll
                for (int bj = 0; bj < 2; ++bj) { const f32x4 v0 = acc[ai][bj][m][0], v1 = acc[ai][bj][m][1];
                    u32x4 w; w.x = pk2(v0[0], v0[1]); w.y = pk2(v0[2], v0[3]); w.z = pk2(v1[0], v1[1]); w.w = pk2(v1[2], v1[3]);
                    *(u32x4*)(Ol + (size_t)(row0 + ai * 128 + m * 16) * D + col0 + bj * 128) = w; }
    }
};
struct EpiPool {
    static constexpr bool PERM = true;
    bf16_t* O; const float* scale;
    DI void operator()(const f32x4 (&acc)[2][2][4][2], const pg8::Unit& u, int wr, int wc, int fr, int fq) const {
        const int row0 = u.pm * 256 + wr * 64 + fr, col0 = u.pn * 256 + wc * 32 + 8 * fq;
#pragma unroll
        for (int bj = 0; bj < 2; ++bj) { const f32x4 s0 = *(const f32x4*)(scale + col0 + bj * 128), s1 = *(const f32x4*)(scale + col0 + bj * 128 + 4);
#pragma unroll
            for (int ai = 0; ai < 2; ++ai)
#pragma unroll
                for (int m = 0; m < 4; ++m) { bf16_t* rowp = O + (size_t)(row0 + ai * 128 + m * 16) * D + RW + col0;
                    const f32x4 v0 = acc[ai][bj][m][0] * s0, v1 = acc[ai][bj][m][1] * s1;
                    u32x4 w; w.x = pk2(v0[0], v0[1]); w.y = pk2(v0[2], v0[3]); w.z = pk2(v1[0], v1[1]); w.w = pk2(v1[2], v1[3]);
                    *(u32x4*)(rowp + bj * 128) = w; }
            CFENCE(); }
    }
};
struct EpiSwiglu {
    static constexpr bool PERM = true;
    bf16_t* O;
    DI void operator()(const f32x4 (&acc)[2][2][4][2], const pg8::Unit& u, int wr, int wc, int fr, int fq) const {
        const int row0 = u.pm * 256 + wr * 64 + fr, col0 = u.pn * 128 + wc * 32 + 8 * fq;
#pragma unroll
        for (int ai = 0; ai < 2; ++ai)
#pragma unroll
            for (int m = 0; m < 4; ++m) { f32x4 v0, v1;
#pragma unroll
                for (int e = 0; e < 4; ++e) { v0[e] = fsilu(acc[ai][0][m][0][e]) * acc[ai][1][m][0][e]; v1[e] = fsilu(acc[ai][0][m][1][e]) * acc[ai][1][m][1][e]; }
                u32x4 w; w.x = pk2(v0[0], v0[1]); w.y = pk2(v0[2], v0[3]); w.z = pk2(v1[0], v1[1]); w.w = pk2(v1[2], v1[3]);
                *(u32x4*)(O + (size_t)(row0 + ai * 128 + m * 16) * DFF + col0) = w; }
    }
};
struct EpiRes {
    static constexpr bool PERM = false;
    const float* base_l; float* out_l; long long dbase_c, dout_c; const float* gate0;
    DI void operator()(const f32x4 (&acc)[2][2][4][2], const pg8::Unit& u, int wr, int wc, int fr, int fq) const {
        const bool lat = u.pm < NPM_L; const int prow = lat ? u.pm * 256 : (u.pm - NPM_L) * 256;
        const float* base = (const float*)((const char*)base_l + (lat ? 0ll : dbase_c)); float* out = (float*)((char*)out_l + (lat ? 0ll : dout_c));
        const float* gv = gate0 + (size_t)(lat ? (u.pm * 256) / SEQ : 2) * 6 * D;
        const int row0 = prow + wr * 64 + fr, col0 = u.pn * 256 + wc * 32 + 4 * fq;
        f32x4 g4[2][2];
#pragma unroll
        for (int bj = 0; bj < 2; ++bj)
#pragma unroll
            for (int n = 0; n < 2; ++n) g4[bj][n] = *(const f32x4*)(gv + col0 + bj * 128 + n * 16);
#pragma unroll
        for (int ai = 0; ai < 2; ++ai)
#pragma unroll
            for (int m = 0; m < 4; ++m) { const size_t off = (size_t)(row0 + ai * 128 + m * 16) * D + col0;
#pragma unroll
                for (int bj = 0; bj < 2; ++bj)
#pragma unroll
                    for (int n = 0; n < 2; ++n) { const f32x4 b = *(const f32x4*)(base + off + bj * 128 + n * 16); *(f32x4*)(out + off + bj * 128 + n * 16) = b + g4[bj][n] * acc[ai][bj][m][n]; }
                CFENCE(); }
    }
};

#if PROBE_T && !defined(EMU)
#define TSTAMP(k) do { if (tid == 0) { volatile LAS unsigned* M_ = (volatile LAS unsigned*)(F.lds + MISC_OFF); const unsigned long long n_ = __builtin_amdgcn_s_memtime(); \
    const unsigned long long p_ = ((unsigned long long)M_[31] << 32) | M_[30]; if ((k) >= 0) M_[32 + ((k) < 0 ? 0 : (k))] += (unsigned)((n_ - p_) >> 4); M_[30] = (unsigned)n_; M_[31] = (unsigned)(n_ >> 32); } } while (0)
#else
#define TSTAMP(k) do {} while (0)
#endif
struct EpiResB {
    static constexpr bool PERM = true;
    const void* base; int base_f32; bf16_t* out; const float* gate0;
    DI void operator()(const f32x4 (&acc)[2][2][4][2], const pg8::Unit& u, int wr, int wc, int fr, int fq) const {
        const float* gv = gate0 + (size_t)((u.pm * 256) / SEQ) * 6 * D;
        const int row0 = u.pm * 256 + wr * 64 + fr, col0 = u.pn * 256 + wc * 32 + 8 * fq;
#pragma unroll
        for (int bj = 0; bj < 2; ++bj) { const f32x4 g0 = *(const f32x4*)(gv + col0 + bj * 128), g1 = *(const f32x4*)(gv + col0 + bj * 128 + 4);
#pragma unroll
            for (int ai = 0; ai < 2; ++ai)
#pragma unroll
                for (int m = 0; m < 4; ++m) { const size_t off = (size_t)(row0 + ai * 128 + m * 16) * D + col0 + bj * 128; float b[8];
                    if (base_f32) { const f32x4 b0 = *(const f32x4*)((const float*)base + off), b1 = *(const f32x4*)((const float*)base + off + 4); b[0] = b0[0]; b[1] = b0[1]; b[2] = b0[2]; b[3] = b0[3]; b[4] = b1[0]; b[5] = b1[1]; b[6] = b1[2]; b[7] = b1[3]; }
                    else unpack8(*(const u32x4*)((const bf16_t*)base + off), b);
                    const f32x4 v0 = acc[ai][bj][m][0] * g0, v1 = acc[ai][bj][m][1] * g1;
                    float o[8] = {b[0] + v0[0], b[1] + v0[1], b[2] + v0[2], b[3] + v0[3], b[4] + v1[0], b[5] + v1[1], b[6] + v1[2], b[7] + v1[3]};
                    *(u32x4*)(out + off) = pack8(o); }
            CFENCE(); }
    }
};
struct EpiPart {
    static constexpr bool PERM = false;
    float* P;
    DI void operator()(const f32x4 (&acc)[2][2][4][2], const pg8::Unit& u, int wr, int wc, int fr, int fq) const {
        const int row0 = u.pm * 256 + wr * 64 + fr, col0 = u.pn * 256 + wc * 32 + 4 * fq; float* base = P + (size_t)u.ks * MC * D;
#pragma unroll
        for (int ai = 0; ai < 2; ++ai)
#pragma unroll
            for (int m = 0; m < 4; ++m) { float* rowp = base + (size_t)(row0 + ai * 128 + m * 16) * D + col0;
#pragma unroll
                for (int bj = 0; bj < 2; ++bj)
#pragma unroll
                    for (int n = 0; n < 2; ++n) *(f32x4*)(rowp + bj * 128 + n * 16) = acc[ai][bj][m][n]; }
    }
};
DI int img_off(int r, int c) { return r * 128 + ((((c >> 3) ^ (r & 7)) << 4) | ((c & 7) << 1)); }
DI bf16x8 ldfrag(const LAS unsigned char* img, int r0, int k0, int lane) { const int r = r0 + (lane & 15), c = k0 + 8 * (lane >> 4); return *(const LAS bf16x8*)(img + r * 128 + (((c >> 3) ^ (r & 7)) << 4)); }
template <int KK> DI f32x4 tile_mm(f32x4 acc, const LAS unsigned char* X, int x0, const LAS unsigned char* Y, int y0, int lane) {
#pragma unroll
    for (int ks = 0; ks < KK / 32; ++ks) { const bf16x8 xf = ldfrag(X, x0, 32 * ks, lane), yf = ldfrag(Y, y0, 32 * ks, lane); acc = MFMA16(xf, yf, acc); }
    return acc;
}
DI void st_tile(LAS unsigned char* img, int yrow, int xcol, const f32x4& v) { u32x2 w; w.x = pk2(v[0], v[1]); w.y = pk2(v[2], v[3]); *(LAS u32x2*)(img + img_off(yrow, xcol)) = w; }
DI bf16x4 pack4b(const f32x4& v) { u32x2 w; w.x = pk2(v[0], v[1]); w.y = pk2(v[2], v[3]); return __builtin_bit_cast(bf16x4, w); }
DI f32x4 ld_tile(const LAS unsigned char* img, int yrow, int xcol) { const u32x2 w = *(const LAS u32x2*)(img + img_off(yrow, xcol)); return (f32x4){bflo(w.x), bfhi(w.x), bflo(w.y), bfhi(w.y)}; }

struct ScanItem { int b, h, dir, seg; };
DI int item_index(const ScanItem& it) { return ((it.b * NH + it.h) * 2 + it.dir) * NSEG + it.seg; }
struct SegGeom { int seqlen, rowbase, pos0; };
DI SegGeom chunk_geom(const ScanItem& it, int gch) { SegGeom g; if (gch < CTX / 64) { g.seqlen = CTX; g.rowbase = ML + it.b * CTX; g.pos0 = 64 * gch; } else { g.seqlen = SEQ; g.rowbase = it.b * SEQ; g.pos0 = 64 * (gch - CTX / 64); } return g; }

struct ScanAF { bf16x8 af[4][3]; };
struct ScanWB { bf16x8 bfr[2][3]; float lb[2]; };
DI void scan_issue_af(const bf16_t* U, const ScanItem& it, const SegGeom& sg, const int mat, const int lane, ScanAF& A) {
    const int q = lane >> 4, l15 = lane & 15;
#pragma unroll
    for (int mt = 0; mt < 4; ++mt) { const int qq = sg.pos0 + 16 * mt + l15; const int tau = it.dir ? sg.seqlen - 1 - qq : qq;
        const bf16_t* ur = U + (size_t)(sg.rowbase + tau) * INWP + (mat ? OFF_A : OFF_W) + 8 * q;
#pragma unroll
        for (int ks = 0; ks < 3; ++ks) A.af[mt][ks] = *(const bf16x8*)(ur + 32 * ks); }
}
DI void scan_load_wb(const bf16_t* Wl, const float* bias, const ScanItem& it, const int nt0, const int lane, ScanWB& W) {
    const int q = lane >> 4, l15 = lane & 15;
#pragma unroll
    for (int n2 = 0; n2 < 2; ++n2) { const int chn = it.h * 64 + 16 * (nt0 + n2) + l15;
#pragma unroll
        for (int ks = 0; ks < 3; ++ks) W.bfr[n2][ks] = *(const bf16x8*)(Wl + (size_t)chn * LORA + 8 * q + 32 * ks);
        W.lb[n2] = bias[chn]; }
}
DI void scan_stage0(LAS unsigned char* L, LAS float* GCo, const ScanAF& A, const ScanWB& W, const int mat, const int nt0, const int lane) {
    const int q = lane >> 4, l15 = lane & 15;
#pragma unroll
    for (int n2 = 0; n2 < 2; ++n2) {
        f32x4 a4[4];
#pragma unroll
        for (int mt = 0; mt < 4; ++mt) { a4[mt] = (f32x4){0.f, 0.f, 0.f, 0.f};
#pragma unroll
            for (int ks = 0; ks < 3; ++ks) a4[mt] = MFMA16(A.af[mt][ks], W.bfr[n2][ks], a4[mt]); }
        const int cc = 16 * (nt0 + n2) + l15;
        if (mat == 0) {
            LAS float* G = (LAS float*)(L + SCR_G);
            float cs[4][4], t1[4], t2[4], t3[4];
#pragma unroll
            for (int mt = 0; mt < 4; ++mt) {
#pragma unroll
                for (int e = 0; e < 4; ++e) cs[mt][e] = -0.8750387749145276f * fsigmoid(W.lb[n2] + a4[mt][e]);
                cs[mt][1] += cs[mt][0]; cs[mt][2] += cs[mt][1]; cs[mt][3] += cs[mt][2];
                t1[mt] = BPERM(cs[mt][3], lane - 16); t2[mt] = BPERM(cs[mt][3], lane - 32); t3[mt] = BPERM(cs[mt][3], lane - 48); }
            float run = 0.f;
#pragma unroll
            for (int mt = 0; mt < 4; ++mt) { const float off = run + (q >= 1 ? t1[mt] : 0.f) + (q >= 2 ? t2[mt] : 0.f) + (q >= 3 ? t3[mt] : 0.f);
                const int p0 = 16 * mt + 4 * q;
#pragma unroll
                for (int e = 0; e < 4; ++e) G[(p0 + e) * 64 + cc] = off + cs[mt][e];
                run += (cs[mt][3] + t1[mt]) + (t2[mt] + t3[mt]); }
            if (q == 0) GCo[cc] = fexp2(run);
        } else {
            LAS float* AI = (LAS float*)(L + SCR_AI);
#pragma unroll
            for (int mt = 0; mt < 4; ++mt) { const int p0 = 16 * mt + 4 * q;
#pragma unroll
                for (int e = 0; e < 4; ++e) AI[(p0 + e) * 64 + cc] = fsigmoid(W.lb[n2] + a4[mt][e]); }
        }
    }
}
struct ScanPF { u32x2 w[3][6]; };
DI void scan_issue_uu(const bf16_t* U, const ScanItem& it, const SegGeom& sg, int tidp, ScanPF& pf) {
    const int pg = tidp >> 4, cg = tidp & 15; const int qq0 = sg.pos0 + 4 * pg - 1;
#pragma unroll
    for (int t = 0; t < 6; ++t) { const int qq = qq0 + t; const int tau = it.dir ? sg.seqlen - 1 - qq : qq;
        const bf16_t* up = U + (long long)(sg.rowbase + tau) * INWP + it.h * 64 + 4 * cg;
#pragma unroll
        for (int x = 0; x < 3; ++x) pf.w[x][t] = *(const u32x2*)(up + x * RW); }
}
#ifndef PAIR_K16
#define PAIR_K16 0
#endif
DI bf16x8 cat8(const bf16x4& a, const bf16x4& b) { return __builtin_shufflevector(a, b, 0, 1, 2, 3, 4, 5, 6, 7); }
DI f32x4 tile_xy(const bf16x8 (&xf)[2], const bf16x8 (&yf)[2]) { f32x4 a = {0.f, 0.f, 0.f, 0.f}; a = MFMA16(xf[0], yf[0], a); a = MFMA16(xf[1], yf[1], a); return a; }
DI f32x4 mm_pair(const bf16x4& a0, const bf16x4& a1, const bf16x4& b0, const bf16x4& b1, f32x4 c) {
#if PAIR_K16
    c = MFMA16K16(a0, b0, c); return MFMA16K16(a1, b1, c);
#else
    return MFMA16(cat8(a0, a1), cat8(b0, b1), c);
#endif
}
DI bf16x4 lo4(const bf16x8& v) { return __builtin_shufflevector(v, v, 0, 1, 2, 3); }
DI bf16x4 hi4(const bf16x8& v) { return __builtin_shufflevector(v, v, 4, 5, 6, 7); }
DI f32x4 mm_pair_a8(const bf16x8& a, const bf16x4& b0, const bf16x4& b1, f32x4 c) {
#if PAIR_K16
    c = MFMA16K16(lo4(a), b0, c); return MFMA16K16(hi4(a), b1, c);
#else
    return MFMA16(a, cat8(b0, b1), c);
#endif
}
DI f32x4 mm_pair_b8(const bf16x4& a0, const bf16x4& a1, const bf16x8& b, f32x4 c) {
#if PAIR_K16
    c = MFMA16K16(a0, lo4(b), c); return MFMA16K16(a1, hi4(b), c);
#else
    return MFMA16(cat8(a0, a1), b, c);
#endif
}
DI void scan_stage1(LAS unsigned char* L, LAS unsigned char* S, LAS unsigned char* SH, const ScanItem& it, const SegGeom& sg, const int tidp, const ScanPF& pf, float* BS) {
    const int pg = tidp >> 4, cg = tidp & 15, p0 = 4 * pg; const int qq0 = sg.pos0 + p0;
    const bool lo_ok = qq0 > 0, hi_ok = qq0 + 4 < sg.seqlen;
    const bool edge = (sg.pos0 == 0) || (sg.pos0 + 64 >= sg.seqlen);
    const int ccol = 4 * ((cg & 8) | ((cg & 3) << 1) | ((cg >> 2) & 1));
    const LAS float* PAR = (const LAS float*)(L + SC_PAR) + 4 * cg;
    const LAS float* G = (const LAS float*)(L + SCR_G) + 4 * cg; const LAS float* AI = (const LAS float*)(L + SCR_AI) + 4 * cg;
    f32x4 egp;
    { f32x4 gp = {0.f, 0.f, 0.f, 0.f}; if (p0 > 0) gp = *(const LAS f32x4*)(G + (p0 - 1) * 64);
#pragma unroll
      for (int e = 0; e < 4; ++e) egp[e] = fexp2(gp[e]); }
    f32x4 par[12];
#pragma unroll
    for (int i = 0; i < 12; ++i) par[i] = *(const LAS f32x4*)(PAR + i * 64);
    const f32x4 kkp = par[9], kap = par[10], rkp = par[11];
#pragma unroll
    for (int j = 0; j < 4; ++j) {
        const int p = p0 + j; const int qq = qq0 + j; const int tau = it.dir ? sg.seqlen - 1 - qq : qq; const size_t row = (size_t)(sg.rowbase + tau);
        float r4[4], k4[4], v4[4];
#pragma unroll
        for (int x = 0; x < 3; ++x) {
            float a[4], b[4], c[4];
            unpack4(pf.w[x][j], a); unpack4(pf.w[x][j + 1], b); unpack4(pf.w[x][j + 2], c);
            if (edge) {
                if (j == 0) {
#pragma unroll
                    for (int e = 0; e < 4; ++e) a[e] = lo_ok ? a[e] : 0.f; }
                if (j == 3) {
#pragma unroll
                    for (int e = 0; e < 4; ++e) c[e] = hi_ok ? c[e] : 0.f; } }
            const f32x4 w0 = par[3 * x + 0], w1 = par[3 * x + 1], w2 = par[3 * x + 2];
            float* dst = x == 0 ? r4 : (x == 1 ? k4 : v4);
#pragma unroll
            for (int e = 0; e < 4; ++e) dst[e] = a[e] * w0[e] + b[e] * w1[e] + c[e] * w2[e];
        }
        float kk4[4]; float nn = 0.f;
#pragma unroll
        for (int e = 0; e < 4; ++e) { kk4[e] = k4[e] * kkp[e]; nn += kk4[e] * kk4[e]; }
        nn = row16_sum(nn);
        const float inv = frsq(fmaxf(nn, 1e-24f));
        const f32x4 g4 = *(const LAS f32x4*)(G + p * 64), a4 = *(const LAS f32x4*)(AI + p * 64);
        float rt[4], at[4], kb[4], bb[4]; float bsum = 0.f;
#pragma unroll
        for (int e = 0; e < 4; ++e) { const float kkn = kk4[e] * inv; const float kd = k4[e] * (1.0f + (a4[e] - 1.0f) * kap[e]); const float bh = kkn * a4[e];
            const float eg = fexp2(g4[e]), eng = fexp2(-g4[e]);
            rt[e] = r4[e] * eg; at[e] = -kkn * egp[e]; kb[e] = kd * eng; bb[e] = bh * eng; bsum += r4[e] * kd * rkp[e]; egp[e] = eg; }
        *(LAS u32x2*)(S + M_RT * IMG + img_off(p, ccol)) = pack4(rt);
        *(LAS u32x2*)(S + M_AT * IMG + img_off(p, ccol)) = pack4(at);
        *(LAS u32x2*)(S + M_KB * IMG + img_off(p, ccol)) = pack4(kb);
        *(LAS u32x2*)(S + M_BB * IMG + img_off(p, ccol)) = pack4(bb);
        *(LAS u32x2*)(S + M_VT * IMG + img_off(p, 4 * cg)) = pack4(v4);
        bsum = row16_sum(bsum); if (cg == 0) BS[row * NH + it.h] = bsum;
    }
    LDS_WAIT();
    { const int w = RFL(tidp >> 6), lane = tidp & 63, q = lane >> 4, l15 = lane & 15;
      bf16x8 at8[2], rt8[2], kb8[2], bb8[2];
#pragma unroll
      for (int ks = 0; ks < 2; ++ks) { at8[ks] = ldfrag(S + M_AT * IMG, 16 * w, 32 * ks, lane); rt8[ks] = ldfrag(S + M_RT * IMG, 16 * w, 32 * ks, lane); kb8[ks] = ldfrag(S + M_KB * IMG, 16 * w, 32 * ks, lane); bb8[ks] = ldfrag(S + M_BB * IMG, 16 * w, 32 * ks, lane); }
      f32x4 s_a = tile_xy(bb8, at8), s_b = tile_xy(at8, bb8), tak = tile_xy(kb8, at8), trk = tile_xy(kb8, rt8), trb = tile_xy(bb8, rt8);
#pragma unroll
      for (int e = 0; e < 4; ++e) { const bool st = 4 * q + e < l15, in = 4 * q + e <= l15; s_a[e] = st ? s_a[e] : 0.f; s_b[e] = (l15 < 4 * q + e) ? s_b[e] : 0.f; tak[e] = st ? tak[e] : 0.f; trk[e] = in ? trk[e] : 0.f; trb[e] = in ? trb[e] : 0.f; }
      LAS unsigned char* o = SH + w * 512 + lane * 8;
      *(LAS bf16x4*)(o + 1 * 2048) = pack4b(tak); *(LAS bf16x4*)(o + 2 * 2048) = pack4b(trk); *(LAS bf16x4*)(o + 3 * 2048) = pack4b(trb);
      const bf16x4 pa = pack4b(s_a), pb = pack4b(s_b); const f32x4 z4 = {0.f, 0.f, 0.f, 0.f};
#pragma unroll
      for (int e = 0; e < 4; ++e) { const float id = (4 * q + e == l15) ? 1.f : 0.f; s_a[e] += id; s_b[e] += id; }
      const f32x4 a2b = MFMA16K16(pa, pb, z4), a2a = MFMA16K16(pb, pa, z4);
      const bf16x4 p2b = pack4b(a2b), p2a = pack4b(a2a);
      { const bf16x4 sa = pack4b(s_a); s_b = MFMA16K16(sa, p2b, s_b); s_a = MFMA16K16(p2b, sa, s_a); }
      const f32x4 a4b = MFMA16K16(p2a, p2b, z4), a4a = MFMA16K16(p2b, p2a, z4);
      const bf16x4 p4b = pack4b(a4b), p4a = pack4b(a4a);
      { const bf16x4 sa = pack4b(s_a); s_b = MFMA16K16(sa, p4b, s_b); s_a = MFMA16K16(p4b, sa, s_a); }
      const bf16x4 p8b = pack4b(MFMA16K16(p4a, p4b, z4));
      s_a = MFMA16K16(p8b, pack4b(s_a), s_a);
      *(LAS bf16x4*)o = pack4b(s_a); (void)s_b; }
}
DI int lane_of(int tid) { return tid & 63; }
DI void scan_item(Frame& F, const CAS Inputs& IN_, int l, const ScanItem it) {
    int tid_i = F.tid; OPAQUE_V(tid_i);
    const int wave_i = RFL(tid_i >> 6);
    LAS unsigned char* L = F.lds;
    const int ch0 = seg_start(it.seg), nchunks = seg_start(it.seg + 1) - ch0;
    const bf16_t* U = (const bf16_t*)(F.ws + WS_U);
    if (tid_i < 192) { const int kx = tid_i >> 4, c4 = tid_i & 15; const float* src;
        if (kx < 9) { const int tap = kx % 3; src = IN_.conv_rkv + (size_t)l * 9 * RW + (size_t)(it.dir ? 2 - tap : tap) * 3 * RW + (kx / 3) * RW + it.h * 64 + 4 * c4; }
        else src = (kx == 9 ? IN_.k_k : (kx == 10 ? IN_.k_a : IN_.r_k)) + (size_t)l * RW + it.h * 64 + 4 * c4;
        *(LAS f32x4*)(L + SC_PAR + (kx * 64 + 4 * c4) * 4) = *(const f32x4*)src; }
    if (wave_i >= 4) {
        const int mat = (wave_i >> 1) & 1, nt0 = 2 * (wave_i & 1);
        const bf16_t* Wl = wl_ptr(F, l, mat ? WL_IUP : WL_DUP) + (size_t)it.dir * RW * LORA;
        const float* lbias = (mat ? IN_.iclr_bias : IN_.decay_bias) + ((size_t)l * 2 + it.dir) * RW;
        float* BS = (float*)(F.ws + WS_BS) + (size_t)it.dir * MR * NH;
        ScanPF pf; ScanAF af; ScanWB wb;
        scan_load_wb(Wl, lbias, it, nt0, lane_of(tid_i), wb);
        { const SegGeom sg0 = chunk_geom(it, ch0); scan_issue_af(U, it, sg0, mat, lane_of(tid_i), af); }
#if SCAN_PRIO == 2 && !defined(EMU)
        __builtin_amdgcn_s_setprio(1);
#endif
        for (int k = 0; k <= nchunks; ++k) {
            int tid_o = F.tid; OPAQUE_V(tid_o);
            const int tidp = tid_o - 256, lane = tid_o & 63;
            const bool cur = k < nchunks, nxt = k + 1 < nchunks;
            const SegGeom sg = chunk_geom(it, ch0 + k);
            if (cur) { scan_issue_uu(U, it, sg, tidp, pf);
                scan_stage0(L, (LAS float*)(L + SC_GC) + 64 * (k & 1), af, wb, mat, nt0, lane); }
            LDS_WAIT(); WG_BAR();
            if (nxt) { const SegGeom sgn = chunk_geom(it, ch0 + k + 1); scan_issue_af(U, it, sgn, mat, lane, af); }
            if (cur) scan_stage1(L, L + (k & 1) * SET_BYTES, L + SC_SH + (k & 1) * 8192, it, sg, tidp, pf, BS);
            LDS_WAIT(); WG_BAR();
        }
#if SCAN_PRIO == 2 && !defined(EMU)
        __builtin_amdgcn_s_setprio(0);
#endif
        return;
    }
    const int lane_i = tid_i & 63;
    f32x4 H[2][4];
    const size_t st_off = (size_t)item_index(it) * 4096;
    { const int q = lane_i >> 4, l15 = lane_i & 15;
#pragma unroll
      for (int kt = 0; kt < 4; ++kt) { H[0][kt] = (f32x4){0.f, 0.f, 0.f, 0.f};
#pragma unroll
        for (int e = 0; e < 4; ++e) H[1][kt][e] = (16 * wave_i + l15 == 16 * kt + 4 * q + e) ? 1.f : 0.f; } }
    bf16_t* YO = (bf16_t*)(F.ws + WS_YF) + (size_t)it.dir * MR * RW;
    bf16_t* MCo = (bf16_t*)(F.ws + WS_XN) + (size_t)it.dir * MR * RW;
    LDS_WAIT(); WG_BAR();
    LDS_WAIT(); WG_BAR();
#if SCAN_PRIO == 1 && !defined(EMU)
    __builtin_amdgcn_s_setprio(1);
#endif
    for (int c = 0; c < nchunks; ++c) {
        const SegGeom sg = chunk_geom(it, ch0 + c);
        int tid_o = F.tid; OPAQUE_V(tid_o);
        const int lane = tid_o & 63, cb = RFL(tid_o >> 6), q = lane >> 4, l15 = lane & 15;
        const int qpos0 = sg.pos0;
        const LAS unsigned char* S = L + (c & 1) * SET_BYTES;
        const LAS unsigned char* SH = L + SC_SH + (c & 1) * 8192;
        bf16x4 vb[4], hb[2][4], ub[2][4];
        {
            bf16x8 at8[4][2], kb8[4][2], bb8[4][2]; bf16x4 aakf[10], aabf[6], df[4];
#pragma unroll
            for (int pt = 0; pt < 4; ++pt) vb[pt] = LDS_TR16(S + M_VT * IMG + img_off(16 * pt + 4 * q + (l15 >> 2), 16 * cb + 4 * (l15 & 3)));
#pragma unroll
            for (int i = 0; i < 4; ++i)
#pragma unroll
                for (int ks = 0; ks < 2; ++ks) { at8[i][ks] = ldfrag(S + M_AT * IMG, 16 * i, 32 * ks, lane); kb8[i][ks] = ldfrag(S + M_KB * IMG, 16 * i, 32 * ks, lane); bb8[i][ks] = ldfrag(S + M_BB * IMG, 16 * i, 32 * ks, lane); }
#pragma unroll
            for (int i = 0; i < 4; ++i) { aakf[(i * (i + 1)) / 2 + i] = *(const LAS bf16x4*)(SH + 1 * 2048 + i * 512 + lane * 8); df[i] = *(const LAS bf16x4*)(SH + i * 512 + lane * 8); }
#pragma unroll
            for (int b2 = 0; b2 < 2; ++b2)
#pragma unroll
                for (int kt = 0; kt < 4; ++kt) hb[b2][kt] = pack4b(H[b2][kt]);
            LDS_WAIT(); SCHED_BAR();
#pragma unroll
            for (int i = 1; i < 4; ++i)
#pragma unroll
                for (int jt = 0; jt < i; ++jt) { aakf[(i * (i + 1)) / 2 + jt] = pack4b(tile_xy(kb8[jt], at8[i])); aabf[(i * (i - 1)) / 2 + jt] = pack4b(tile_xy(bb8[jt], at8[i])); }
            SCHED_BAR();
#pragma unroll
            for (int i = 0; i < 4; ++i) {
#pragma unroll
                for (int b2 = 0; b2 < 2; ++b2) { f32x4 a = {0.f, 0.f, 0.f, 0.f}, t = {0.f, 0.f, 0.f, 0.f};
                    if (b2 == 0) {
#pragma unroll
                        for (int pt = 0; pt + 1 <= i; pt += 2) a = mm_pair(aakf[(i * (i + 1)) / 2 + pt], aakf[(i * (i + 1)) / 2 + pt + 1], vb[pt], vb[pt + 1], a);
                        if (!(i & 1)) t = MFMA16K16(aakf[(i * (i + 1)) / 2 + i], vb[i], t); }
#pragma unroll
                    for (int ks = 0; ks < 2; ++ks) a = mm_pair_a8(at8[i][ks], hb[b2][2 * ks], hb[b2][2 * ks + 1], a);
#pragma unroll
                    for (int j = 0; j + 1 < i; j += 2) a = mm_pair(aabf[(i * (i - 1)) / 2 + j], aabf[(i * (i - 1)) / 2 + j + 1], ub[b2][j], ub[b2][j + 1], a);
                    if (i & 1) t = MFMA16K16(aabf[(i * (i - 1)) / 2 + i - 1], ub[b2][i - 1], t);
                    if (b2 == 0 || (i & 1)) a = a + t;
                    const bf16x4 ab = pack4b(a);
                    const f32x4 u = MFMA16K16(df[i], ab, ((f32x4){0.f, 0.f, 0.f, 0.f}));
                    ub[b2][i] = pack4b(u); } }
        }
        LDS_WAIT(); WG_BAR();
        {
            bf16x8 rt8[4][2]; bf16x4 arkf[10], arbf[10];
            {
                bf16x8 kb8[4][2], bb8[4][2];
#pragma unroll
                for (int i = 0; i < 4; ++i)
#pragma unroll
                    for (int ks = 0; ks < 2; ++ks) { rt8[i][ks] = ldfrag(S + M_RT * IMG, 16 * i, 32 * ks, lane); kb8[i][ks] = ldfrag(S + M_KB * IMG, 16 * i, 32 * ks, lane); bb8[i][ks] = ldfrag(S + M_BB * IMG, 16 * i, 32 * ks, lane); }
#pragma unroll
                for (int i = 0; i < 4; ++i) { arkf[(i * (i + 1)) / 2 + i] = *(const LAS bf16x4*)(SH + 2 * 2048 + i * 512 + lane * 8); arbf[(i * (i + 1)) / 2 + i] = *(const LAS bf16x4*)(SH + 3 * 2048 + i * 512 + lane * 8); }
                LDS_WAIT(); SCHED_BAR();
#pragma unroll
                for (int i = 1; i < 4; ++i)
#pragma unroll
                    for (int jt = 0; jt < i; ++jt) { arkf[(i * (i + 1)) / 2 + jt] = pack4b(tile_xy(kb8[jt], rt8[i])); arbf[(i * (i + 1)) / 2 + jt] = pack4b(tile_xy(bb8[jt], rt8[i])); }
            }
            SCHED_BAR();
#pragma unroll
            for (int i = 0; i < 4; ++i) { const int qq = qpos0 + 16 * i + l15; const int tau = it.dir ? sg.seqlen - 1 - qq : qq; const size_t o = (size_t)(sg.rowbase + tau) * RW + it.h * 64 + 16 * cb + 4 * q;
#pragma unroll
                for (int b2 = 0; b2 < 2; ++b2) { f32x4 y = {0.f, 0.f, 0.f, 0.f}, t = {0.f, 0.f, 0.f, 0.f};
#pragma unroll
                    for (int ks = 0; ks < 2; ++ks) y = mm_pair_b8(hb[b2][2 * ks], hb[b2][2 * ks + 1], rt8[i][ks], y);
                    if (b2 == 0) {
#pragma unroll
                        for (int pt = 0; pt + 1 <= i; pt += 2) y = mm_pair(vb[pt], vb[pt + 1], arkf[(i * (i + 1)) / 2 + pt], arkf[(i * (i + 1)) / 2 + pt + 1], y);
                        if (!(i & 1)) t = MFMA16K16(vb[i], arkf[(i * (i + 1)) / 2 + i], t); }
#pragma unroll
                    for (int j = 0; j + 1 <= i; j += 2) y = mm_pair(ub[b2][j], ub[b2][j + 1], arbf[(i * (i + 1)) / 2 + j], arbf[(i * (i + 1)) / 2 + j + 1], y);
                    if (!(i & 1)) { t = MFMA16K16(ub[b2][i], arbf[(i * (i + 1)) / 2 + i], t); y = y + t; }
                    u32x2 w; w.x = pk2(y[0], y[1]); w.y = pk2(y[2], y[3]);
                    *(u32x2*)((b2 == 0 ? YO : MCo) + o) = w; } }
            SCHED_BAR();
        }
        {
            bf16x4 ktf[4][4], btf[4][4];
#pragma unroll
            for (int kt = 0; kt < 4; ++kt)
#pragma unroll
                for (int pt = 0; pt < 4; ++pt) { const int col = 32 * (kt >> 1) + 8 * (l15 & 3) + 4 * (kt & 1);
                    ktf[kt][pt] = LDS_TR16(S + M_KB * IMG + img_off(16 * pt + 4 * q + (l15 >> 2), col));
                    btf[kt][pt] = LDS_TR16(S + M_BB * IMG + img_off(16 * pt + 4 * q + (l15 >> 2), col)); }
            LDS_WAIT(); SCHED_BAR();
#pragma unroll
            for (int kt = 0; kt < 4; ++kt) { const f32x4 gc = *(const LAS f32x4*)(L + SC_GC + (64 * (c & 1) + 16 * kt + 4 * q) * 4);
#pragma unroll
                for (int b2 = 0; b2 < 2; ++b2) { f32x4 a = H[b2][kt];
                    if (b2 == 0) {
#pragma unroll
                        for (int pp = 0; pp < 2; ++pp) a = mm_pair(ktf[kt][2 * pp], ktf[kt][2 * pp + 1], vb[2 * pp], vb[2 * pp + 1], a); }
#pragma unroll
                    for (int pp = 0; pp < 2; ++pp) a = mm_pair(btf[kt][2 * pp], btf[kt][2 * pp + 1], ub[b2][2 * pp], ub[b2][2 * pp + 1], a);
                    H[b2][kt] = a * gc; } }
        }
        LDS_WAIT(); WG_BAR();
    }
#if SCAN_PRIO == 1 && !defined(EMU)
    __builtin_amdgcn_s_setprio(0);
#endif
    { const int q = lane_i >> 4, l15 = lane_i & 15; const int v = 16 * wave_i + l15;
#pragma unroll
      for (int kt = 0; kt < 4; ++kt) { const int k = 16 * kt + 4 * q;
          *(f32x4*)((float*)(F.ws + WS_SSEG) + st_off + (size_t)v * 64 + k) = H[0][kt]; *(f32x4*)((float*)(F.ws + WS_PSEG) + st_off + (size_t)v * 64 + k) = H[1][kt]; }
    }
}
DI bool scan_item_of(int idx, ScanItem& it) {
    constexpr int NCHN = NB * NH * 2; if (idx >= NCHN * NSEG) return false;
    const int chain = idx % NCHN; it.seg = idx / NCHN; it.dir = chain & 1; it.h = (chain >> 1) % NH; it.b = (chain >> 1) / NH; return true;
}
DI void phase_chain(Frame& F) {
    LAS float* Sm = (LAS float*)F.lds; LAS float* Pm = Sm + 64 * 65;
    const int v = F.tid >> 3, kg = F.tid & 7;
    for (int ci = F.vcu; ci < NB * NH * 2; ci += F.G) {
        const size_t base = (size_t)ci * NSEG * 4096;
        float s8[8];
#pragma unroll
        for (int j = 0; j < 8; ++j) s8[j] = 0.f;
        for (int seg = 0; seg < NSEG; ++seg) {
            float* hin = (float*)(F.ws + WS_HIN) + base + (size_t)seg * 4096 + v * 64 + 8 * kg;
            *(f32x4*)hin = (f32x4){s8[0], s8[1], s8[2], s8[3]}; *(f32x4*)(hin + 4) = (f32x4){s8[4], s8[5], s8[6], s8[7]};
            if (seg == NSEG - 1) break;
            const float* pp = (const float*)(F.ws + WS_PSEG) + base + (size_t)seg * 4096 + v * 64 + 8 * kg;
            const float* sp = (const float*)(F.ws + WS_SSEG) + base + (size_t)seg * 4096 + v * 64 + 8 * kg;
            WG_BAR();
#pragma unroll
            for (int j = 0; j < 8; ++j) { Sm[v * 65 + 8 * kg + j] = s8[j]; Pm[v * 64 + 8 * kg + j] = pp[j]; }
            float o8[8];
#pragma unroll
            for (int j = 0; j < 8; ++j) o8[j] = sp[j];
            LDS_WAIT(); WG_BAR();
            for (int j = 0; j < 64; ++j) { const float sv = Sm[v * 65 + j]; const f32x4 p0 = *(const LAS f32x4*)(Pm + j * 64 + 8 * kg), p1 = *(const LAS f32x4*)(Pm + j * 64 + 8 * kg + 4);
                o8[0] += sv * p0[0]; o8[1] += sv * p0[1]; o8[2] += sv * p0[2]; o8[3] += sv * p0[3]; o8[4] += sv * p1[0]; o8[5] += sv * p1[1]; o8[6] += sv * p1[2]; o8[7] += sv * p1[3]; }
#pragma unroll
            for (int j = 0; j < 8; ++j) s8[j] = o8[j];
        }
        WG_BAR();
    }
}

DI void ld8(const bf16_t* p, float (&f)[8]) { unpack8(*(const u32x4*)p, f); }
constexpr int PBAND = GROWS < 32 ? GROWS : 32;
DI void phase_poolv(Frame& F, int start, int stride) {
    const bf16_t* U = (const bf16_t*)(F.ws + WS_U); bf16_t* VS = (bf16_t*)(F.ws + WS_VS);
    constexpr int NBAND = GROWS / PBAND;
    for (int i = start; i < NB * NBAND * GW * 128; i += stride) { const int ck = i & 127, x = (i >> 7) % GW, band = ((i >> 7) / GW) % NBAND, b = (i >> 7) / (GW * NBAND); const int half = 1 << (ck >> 5);
        const bf16_t* ub = U + ((size_t)b * SEQ + x) * INWP + OFF_POOL + 8 * ck; bf16_t* vb = VS + ((size_t)b * SEQ + x) * PWD + 8 * ck;
        const int y0 = band * PBAND; float s[8], f[8];
#pragma unroll
        for (int j = 0; j < 8; ++j) s[j] = 0.f;
        for (int yy = (y0 - half < 0 ? 0 : y0 - half); yy < (y0 + half > GROWS ? GROWS : y0 + half); ++yy) { ld8(ub + (size_t)yy * GW * INWP, f);
#pragma unroll
            for (int j = 0; j < 8; ++j) s[j] += f[j]; }
#pragma unroll 4
        for (int y = y0; y < y0 + PBAND; ++y) { *(u32x4*)(vb + (size_t)y * GW * PWD) = pack8(s);
            if (y + half < GROWS) { ld8(ub + (size_t)(y + half) * GW * INWP, f);
#pragma unroll
                for (int j = 0; j < 8; ++j) s[j] += f[j]; }
            if (y - half >= 0) { ld8(ub + (size_t)(y - half) * GW * INWP, f);
#pragma unroll
                for (int j = 0; j < 8; ++j) s[j] -= f[j]; } }
    }
}
constexpr int PCB = 4;
DI void phase_poolh(Frame& F, int start, int stride, const bool with_ctx) {
    const bf16_t* U = (const bf16_t*)(F.ws + WS_U); const bf16_t* VS = (const bf16_t*)(F.ws + WS_VS); bf16_t* PD = (bf16_t*)(F.ws + WS_MIX) + RW;
    constexpr int NLAT = NB * GROWS * 2 * 128, NCTXI = NB * (CTX / PCB) * 128;
    for (int i = start; i < NLAT + (with_ctx ? NCTXI : 0); i += stride) {
        float s[8], f[8], c8[8];
#pragma unroll
        for (int j = 0; j < 8; ++j) s[j] = 0.f;
        if (i < NLAT) { const int ck = i & 127, xh = (i >> 7) & 1, gy = (i >> 8) % GROWS, b = (i >> 8) / GROWS; const int half = 1 << (ck >> 5);
            const size_t rowb = (size_t)b * SEQ + (size_t)gy * GW; const bf16_t* vs = VS + rowb * PWD + 8 * ck; const bf16_t* uc = U + rowb * INWP + OFF_POOL + 8 * ck; bf16_t* pd = PD + rowb * D + 8 * ck;
            const int ylo = gy - half < 0 ? 0 : gy - half, yhi = gy + half > GROWS ? GROWS : gy + half; const float ny = (float)(yhi - ylo);
            const int x0 = xh * 32;
            for (int xx = (x0 - half < 0 ? 0 : x0 - half); xx < (x0 + half > GW ? GW : x0 + half); ++xx) { ld8(vs + (size_t)xx * PWD, f);
#pragma unroll
                for (int j = 0; j < 8; ++j) s[j] += f[j]; }
#pragma unroll 4
            for (int x = x0; x < x0 + 32; ++x) { const int xlo = x - half < 0 ? 0 : x - half, xhi = x + half > GW ? GW : x + half; const float ic = 1.0f / (ny * (float)(xhi - xlo));
                ld8(uc + (size_t)x * INWP, c8); float o[8];
#pragma unroll
                for (int j = 0; j < 8; ++j) o[j] = s[j] * ic - c8[j];
                *(u32x4*)(pd + (size_t)x * D) = pack8(o);
                if (x + half < GW) { ld8(vs + (size_t)(x + half) * PWD, f);
#pragma unroll
                    for (int j = 0; j < 8; ++j) s[j] += f[j]; }
                if (x - half >= 0) { ld8(vs + (size_t)(x - half) * PWD, f);
#pragma unroll
                    for (int j = 0; j < 8; ++j) s[j] -= f[j]; } }
        } else { const int i2 = i - NLAT; const int ck = i2 & 127, band = (i2 >> 7) % (CTX / PCB), b = (i2 >> 7) / (CTX / PCB); const int half = 1 << (ck >> 5);
            const size_t rowb = (size_t)ML + (size_t)b * CTX; const bf16_t* uc = U + rowb * INWP + OFF_POOL + 8 * ck; bf16_t* pd = PD + rowb * D + 8 * ck;
            const int t0 = band * PCB;
            for (int tt = (t0 - half < 0 ? 0 : t0 - half); tt < (t0 + half > CTX ? CTX : t0 + half); ++tt) { ld8(uc + (size_t)tt * INWP, f);
#pragma unroll
                for (int j = 0; j < 8; ++j) s[j] += f[j]; }
#pragma unroll 4
            for (int t = t0; t < t0 + PCB; ++t) { const int lo = t - half < 0 ? 0 : t - half, hi = t + half > CTX ? CTX : t + half; const float ic = 1.0f / (float)(hi - lo);
                ld8(uc + (size_t)t * INWP, c8); float o[8];
#pragma unroll
                for (int j = 0; j < 8; ++j) o[j] = s[j] * ic - c8[j];
                *(u32x4*)(pd + (size_t)t * D) = pack8(o);
                if (t + half < CTX) { ld8(uc + (size_t)(t + half) * INWP, f);
#pragma unroll
                    for (int j = 0; j < 8; ++j) s[j] += f[j]; }
                if (t - half >= 0) { ld8(uc + (size_t)(t - half) * INWP, f);
#pragma unroll
                    for (int j = 0; j < 8; ++j) s[j] -= f[j]; } }
        }
    }
}

template <int MT> DI void finish_item(Frame& F, const CAS Inputs& IN_, const int l, const int row0, const int h) {
    const bf16_t* U = (const bf16_t*)(F.ws + WS_U); const bf16_t* Gt = (const bf16_t*)(F.ws + WS_G); bf16_t* MIX = (bf16_t*)(F.ws + WS_MIX);
    const bf16_t* YL = (const bf16_t*)(F.ws + WS_YF); const bf16_t* MCb = (const bf16_t*)(F.ws + WS_XN);
    const float* BS0 = (const float*)(F.ws + WS_BS); const float* BS1 = BS0 + (size_t)MR * NH;
    const float* cw = IN_.conv_rkv + (size_t)l * 9 * RW + 2 * RW;
    const int lane = F.lane, q = lane >> 4, l15 = lane & 15;
    const bool lat = row0 < ML;
    f32x4 acc[MT][4];
#pragma unroll
    for (int mt = 0; mt < MT; ++mt)
#pragma unroll
        for (int j = 0; j < 2; ++j) { const size_t o = (size_t)(row0 + 16 * mt + l15) * RW + h * 64 + 32 * j + 8 * q; float a[8], b[8];
            unpack8(*(const u32x4*)(YL + o), a); unpack8(*(const u32x4*)(YL + (size_t)MR * RW + o), b);
            acc[mt][2 * j] = (f32x4){a[0] + b[0], a[1] + b[1], a[2] + b[2], a[3] + b[3]}; acc[mt][2 * j + 1] = (f32x4){a[4] + b[4], a[5] + b[5], a[6] + b[6], a[7] + b[7]}; }
    {
        const int r64 = row0 & ~63; const int bb = lat ? r64 / SEQ : (r64 - ML) / CTX, t0 = lat ? r64 % SEQ : (r64 - ML) % CTX;
#pragma unroll
        for (int dir = 0; dir < 2; ++dir) {
            const int gch = lat ? CTX / 64 + (dir ? (SEQ - 64 - t0) / 64 : t0 / 64) : (dir ? (CTX - 64 - t0) / 64 : t0 / 64);
            int seg = 0; for (int sx = 1; sx < NSEG; ++sx) seg = (seg_start(sx) <= gch) ? sx : seg;
            if (seg == 0) continue;
            const float* Hin = (const float*)(F.ws + WS_HIN) + (size_t)((((bb * NH + h) * 2 + dir) * NSEG) + seg) * 4096;
            const bf16_t* Mc = MCb + (size_t)dir * MR * RW + (size_t)row0 * RW + h * 64;
            bf16x8 hf[4][2];
#pragma unroll
            for (int vt = 0; vt < 4; ++vt)
#pragma unroll
                for (int ks = 0; ks < 2; ++ks) { const int v = 32 * (vt >> 1) + 8 * (l15 >> 2) + 4 * (vt & 1) + (l15 & 3);
                    const float* hp = Hin + (size_t)v * 64 + 32 * ks + 8 * q; const f32x4 x0 = *(const f32x4*)hp, x1 = *(const f32x4*)(hp + 4);
                    u32x4 w; w.x = pk2(x0[0], x0[1]); w.y = pk2(x0[2], x0[3]); w.z = pk2(x1[0], x1[1]); w.w = pk2(x1[2], x1[3]); hf[vt][ks] = __builtin_bit_cast(bf16x8, w); }
#pragma unroll
            for (int mt = 0; mt < MT; ++mt) { bf16x8 mf[2];
#pragma unroll
                for (int ks = 0; ks < 2; ++ks) mf[ks] = *(const bf16x8*)(Mc + (size_t)(16 * mt + l15) * RW + 32 * ks + 8 * q);
#pragma unroll
                for (int vt = 0; vt < 4; ++vt) { acc[mt][vt] = MFMA16(hf[vt][0], mf[0], acc[mt][vt]); acc[mt][vt] = MFMA16(hf[vt][1], mf[1], acc[mt][vt]); } }
        }
    }
#pragma unroll
    for (int mt = 0; mt < MT; ++mt) { const int row = row0 + 16 * mt + l15;
        int tau, len; if (row < ML) { tau = row % SEQ; len = SEQ; } else { tau = (row - ML) % CTX; len = CTX; }
        float sm = 0.f;
#pragma unroll
        for (int vt = 0; vt < 4; ++vt) sm += (acc[mt][vt][0] + acc[mt][vt][1]) + (acc[mt][vt][2] + acc[mt][vt][3]);
        sm += __shfl_xor(sm, 16); sm += __shfl_xor(sm, 32);
        const float mu = sm * (1.f / 64.f); float vq = 0.f;
#pragma unroll
        for (int vt = 0; vt < 4; ++vt)
#pragma unroll
            for (int e = 0; e < 4; ++e) { const float d = acc[mt][vt][e] - mu; acc[mt][vt][e] = d; vq += d * d; }
        vq += __shfl_xor(vq, 16); vq += __shfl_xor(vq, 32);
        const float rstd = frsq(vq * (1.f / 64.f) + GN_EPS);
        const float bsum = BS0[(size_t)row * NH + h] + BS1[(size_t)row * NH + h];
        const bool hasm = tau > 0, hasp = tau < len - 1;
#pragma unroll
        for (int j = 0; j < 2; ++j) { const int ch = h * 64 + 32 * j + 8 * q;
            const bf16_t* up = U + (size_t)row * INWP + OFF_V + ch; float cen[8], lo[8], hi[8], g8[8];
            unpack8(*(const u32x4*)up, cen); unpack8(*(const u32x4*)(up - INWP), lo); unpack8(*(const u32x4*)(up + INWP), hi);
            unpack8(*(const u32x4*)(Gt + (size_t)row * RW + ch), g8);
            float o[8];
#pragma unroll
            for (int hh = 0; hh < 2; ++hh) { const int c4 = ch + 4 * hh;
                const f32x4 w0 = *(const f32x4*)(cw + c4), w1 = *(const f32x4*)(cw + 3 * RW + c4), w2 = *(const f32x4*)(cw + 6 * RW + c4);
                const f32x4 gw4 = *(const f32x4*)(IN_.gn_w + (size_t)l * RW + c4), gb4 = *(const f32x4*)(IN_.gn_b + (size_t)l * RW + c4);
#pragma unroll
                for (int e = 0; e < 4; ++e) { const float v = (hasm ? lo[4 * hh + e] : 0.f) * w0[e] + cen[4 * hh + e] * w1[e] + (hasp ? hi[4 * hh + e] : 0.f) * w2[e];
                    o[4 * hh + e] = (acc[mt][2 * j + hh][e] * rstd * gw4[e] + gb4[e] + bsum * v) * g8[4 * hh + e]; } }
            *(u32x4*)(MIX + (size_t)row * D + ch) = pack8(o); }
    }
}
DI void phase_finish(Frame& F, const CAS Inputs& IN_, int l, int nrows) {
    const int gw = F.vcu * 8 + F.wave, NGW = F.G * 8;
    for (int itx = gw; itx < (ML / 64) * NH; itx += NGW) finish_item<4>(F, IN_, l, (itx / NH) * 64, itx % NH);
    for (int itx = gw; itx < ((nrows - ML) / 16) * NH; itx += NGW) finish_item<1>(F, IN_, l, ML + (itx / NH) * 16, itx % NH);
}

constexpr int PH_P0 = 0, PH_P0B = 1, PH_L0 = 2, PH_PER_LAYER = 11, PH_FINAL = PH_L0 + PH_PER_LAYER * DEPTH, NPHASES = PH_FINAL + 1;
#define IN(k) (lo <= (k) && (k) < hi)
#define REP(k) for (int rep_ = 0; rep_ < (((PROBE_MASK) >> (k)) & 1) + 1; ++rep_)
#define PHASE_BEGIN() const CAS Args* AP = kargs; OPAQUE_S(AP); do { F.ws = AP->ws; F.out = AP->out; F.wave = wave_id; OPAQUE_S(F.wave); F.lane = LANE_ID(); OPAQUE_V(F.lane); F.tid = F.wave * 64 + F.lane; } while (0)
#ifdef EMU
#define SEAM(k) do { if (IN(k) && IN((k) + 1)) xcd_barrier(bar); } while (0)
#else
#define SEAM(k) do { if (IN(k) && IN((k) + 1)) { XcdBarrier bb_ = bar; { const CAS Args* ap_ = kargs; OPAQUE_S(ap_); bb_.bar = (unsigned*)(ap_->ws + WS_CTL) + CW_BAR; } OPAQUE_S(bb_.bar); xcd_barrier(bb_, (lane_id_volatile() == 0) && (wave_id == 0)); } } while (0)
#endif
template <int l> DI void run_layer(Frame F, const CAS Args* const kargs, const int lo, const int hi, const XcdBarrier bar, const int wave_id) {

        const int pb = PH_L0 + PH_PER_LAYER * l; const bool last = (l == DEPTH - 1);
        const int npm = last ? NPM_L : NPM;
        if (IN(pb + 0)) REP(0) { PHASE_BEGIN(); phase_norm(F, AP->in, l, false, MR, l > 0 ? NPART_DN : 0, (const float*)(F.ws + WS_CTXH), mod_ptr(F, l > 0 ? l - 1 : 0, 2, 5)); }
        SEAM(pb + 0);
        if (IN(pb + 1)) REP(1) { PHASE_BEGIN(); const int nc = (l + 1 < DEPTH) ? conv_in(F.G) : 0; const int c = (int)blockIdx.x;
            if (c >= F.G - nc) { const int w = (c - (F.G - nc)) * 8 + F.wave, NW = nc * 8;
                p0_convert_span(F, AP->in, l + 1, 0, P0_I_WIN, w, NW); p0_convert_span(F, AP->in, l + 1, P0_R_WOUT1, P0_R_A1, w, NW); }
            else { pg8::Gemm g{(const bf16_t*)(F.ws + WS_XN), wl_ptr(F, l, WL_WIN), D, D, D, 0}; pg8::StaticOrder S; S.init(NPM, INWP / 256, F.G - nc, c);
                EpiU E{(bf16_t*)(F.ws + WS_U), INWP, 1}; pg8::gemm_phase<EpiU, pg8::StaticOrder, true, true>(F.lds, g, S, E, F.tid); } }
        SEAM(pb + 1);
        if (IN(pb + 2)) REP(2) { PHASE_BEGIN(); ScanItem it; for (int i = F.vcu; scan_item_of(i, it); i += F.G) scan_item(F, AP->in, l, it); }
        SEAM(pb + 2);
        if (IN(pb + 3)) REP(3) { PHASE_BEGIN(); constexpr int NCH = NB * NH * 2;
            if (F.G <= NCH) phase_chain(F);
            phase_poolv(F, F.vcu * 512 + F.tid, F.G * 512); }
        SEAM(pb + 3);
        if (IN(pb + 4)) REP(4) { PHASE_BEGIN(); phase_poolh(F, F.vcu * 512 + F.tid, F.G * 512, !last); }
        if (IN(pb + 5)) REP(5) { PHASE_BEGIN();
            { constexpr int NCH = NB * NH * 2; const bool split = F.G > NCH;
              if (split && F.vcu < NCH) { phase_chain(F); WG_BAR(); }
              else { pg8::Gemm g{(const bf16_t*)(F.ws + WS_U) + OFF_G, wl_ptr(F, l, WL_GUP), INWP, GL, GL, 0}; pg8::StaticOrder S; S.init(npm, RW / 256, split ? F.G - NCH : F.G, split ? F.vcu - NCH : (int)blockIdx.x);
                EpiU E{(bf16_t*)(F.ws + WS_G), RW, 0}; pg8::gemm_phase<EpiU, pg8::StaticOrder, false, false>(F.lds, g, S, E, F.tid); } }
        }
        SEAM(pb + 5);
        if (IN(pb + 6)) REP(6) { PHASE_BEGIN(); phase_finish(F, AP->in, l, npm * 256); }
        SEAM(pb + 6);
        if (IN(pb + 7)) { PHASE_BEGIN();
            if (!last) {
                pg8::Gemm g{(const bf16_t*)(F.ws + WS_MIX) + (size_t)ML * D, wl_ptr(F, l, WL_WOUT), D, D, KSPLIT, 0}; pg8::SplitKOrder S; S.init(MC / 256, D / 256, NPART_WO, F.G, (int)blockIdx.x);
                EpiPart E{(float*)(F.ws + WS_PART)};
                pg8::gemm_phase<EpiPart, pg8::SplitKOrder, true, true>(F.lds, g, S, E, F.tid); }
            { pg8::Gemm g{(const bf16_t*)(F.ws + WS_MIX), wl_ptr(F, l, WL_WOUT), D, D, D, 0}; pg8::StaticOrder S; S.init(NPM_L, D / 256, F.G, (int)blockIdx.x);
              EpiResB E{l == 0 ? (const void*)AP->in.x : (const void*)(F.ws + WS_XB), l == 0 ? 1 : 0, (bf16_t*)(F.ws + WS_XB), mod_ptr(F, l, 0, 2)};
              pg8::gemm_phase<EpiResB, pg8::StaticOrder, true, true>(F.lds, g, S, E, F.tid); }
        }
        SEAM(pb + 7);
        if (IN(pb + 8)) REP(8) { PHASE_BEGIN(); phase_norm(F, AP->in, l, true, npm * 256, last ? 0 : NPART_WO, l == 0 ? AP->in.ctx : (const float*)(F.ws + WS_CTXH), mod_ptr(F, l, 2, 2)); }
        SEAM(pb + 8);
        if (IN(pb + 9)) REP(9) { PHASE_BEGIN(); const int nc = (l + 1 < DEPTH) ? conv_up(F.G) : 0; const int c = (int)blockIdx.x; const int Gp = F.G - nc;
            const int nunits = npm * (2 * DFF / 256), nfull = (nunits / Gp) * Gp; const int lim = (nc > 0 && nunits - nfull <= 4 * nc) ? nfull : nunits;
            pg8::Gemm g{(const bf16_t*)(F.ws + WS_XN), wl_ptr(F, l, WL_WGU), D, D, D, 0}; EpiSwiglu E{(bf16_t*)(F.ws + WS_H)}; pg8::StaticOrder S;
            if (c >= Gp) { const int ci = c - Gp; const int w = ci * 8 + F.wave, NW = nc * 8;
                p0_convert_span(F, AP->in, l + 1, P0_R_A1, P0_I_T, w, NW); WG_BAR();
                S.init(npm, 2 * DFF / 256, nc, ci); S.range(lim, nunits); }
            else { S.init(npm, 2 * DFF / 256, Gp, c); S.range(0, lim); }
            pg8::gemm_phase<EpiSwiglu, pg8::StaticOrder, true, true>(F.lds, g, S, E, F.tid); }
        SEAM(pb + 9);
        if (IN(pb + 10)) { PHASE_BEGIN();
            if (!last) {
                pg8::Gemm g{(const bf16_t*)(F.ws + WS_H) + (size_t)ML * DFF, wl_ptr(F, l, WL_WDN), DFF, DFF, KSPLIT, 0}; pg8::SplitKOrder S; S.init(MC / 256, D / 256, NPART_DN, F.G, (int)blockIdx.x);
                EpiPart E{(float*)(F.ws + WS_PART)};
                pg8::gemm_phase<EpiPart, pg8::SplitKOrder, true, true>(F.lds, g, S, E, F.tid); }
            { pg8::Gemm g{(const bf16_t*)(F.ws + WS_H), wl_ptr(F, l, WL_WDN), DFF, DFF, DFF, 0}; pg8::StaticOrder S; S.init(NPM_L, D / 256, F.G, (int)blockIdx.x);
              EpiResB E{(const void*)(F.ws + WS_XB), 0, (bf16_t*)(F.ws + WS_XB), mod_ptr(F, l, 0, 5)};
              pg8::gemm_phase<EpiResB, pg8::StaticOrder, true, true>(F.lds, g, S, E, F.tid); }
        }
        SEAM(pb + 10);
    }
__global__ void __launch_bounds__(512, 2) fwd_kernel(Args args) {
#ifdef EMU
    unsigned char* lds = emu_blk->lds;
#else
    extern __shared__ __attribute__((aligned(16))) unsigned char lds[];
#endif
    Frame F;
    F.lds = (LAS unsigned char*)lds;
    F.tid = threadIdx.x; F.lane = F.tid & 63; F.wave = RFL(F.tid >> 6);
    const int wave_id = F.wave;
    F.G = gridDim.x; { const int bx = blockIdx.x; F.vcu = (F.G % 8 == 0) ? (bx % 8) * (F.G / 8) + bx / 8 : bx; }
#ifdef EMU
    const Args* const kargs = &args;
#else
    const CAS Args* const kargs = (const CAS Args*)__builtin_amdgcn_kernarg_segment_ptr();
#endif
    F.out = kargs->out; F.ws = kargs->ws;
    const int lo = args.ph_lo, hi = args.ph_hi;
#ifndef EMU
    volatile LAS unsigned* MISC = (volatile LAS unsigned*)(F.lds + MISC_OFF);
    if (F.tid < 128) MISC[F.tid] = 0u;
    __syncthreads();
    XcdBarrier bar; bar.bar = (unsigned*)(F.ws + WS_CTL) + CW_BAR; bar.x = 0; bar.st = nullptr;
    if (hi - lo > 1) bar = xcd_barrier_post((unsigned*)(F.ws + WS_CTL) + CW_BAR, MISC + 8);
#else
    XcdBarrier bar; bar.bar = nullptr;
#endif
    if (IN(PH_P0)) REP(11) { PHASE_BEGIN(); phase_p0(F, AP->in); }
    SEAM(PH_P0);
    if (IN(PH_P0B)) { PHASE_BEGIN(); phase_p0b(F, AP->in);
        { static_assert(WL_SIZE % (2 * PG) == 0, "layer stride"); WG_BAR();
          pg8::Gemm g{wl_ptr(F, 0, WL_WOUT) + RW, wl_ptr(F, 0, WL_POOL), D, PG, PG, 256}; pg8::FoldOrder S; S.init(DEPTH, (int)(WL_SIZE / (2 * PG)), F.G, (int)blockIdx.x);
          EpiFold E{wl_ptr(F, 0, WL_WOUT) + RW}; pg8::gemm_phase<EpiFold, pg8::FoldOrder, true, true>(F.lds, g, S, E, F.tid); } }
    SEAM(PH_P0B);
    run_layer<0>(F, kargs, lo, hi, bar, wave_id);
    if constexpr (DEPTH > 1) run_layer<1>(F, kargs, lo, hi, bar, wave_id);
    if constexpr (DEPTH > 2) run_layer<2>(F, kargs, lo, hi, bar, wave_id);
    if constexpr (DEPTH > 3) run_layer<3>(F, kargs, lo, hi, bar, wave_id);
    static_assert(DEPTH <= 4, "layers");
    if (IN(PH_FINAL)) { PHASE_BEGIN(); phase_final_norm(F, AP->in);
#if PROBE_T && !defined(EMU)
        __syncthreads(); if (blockIdx.x == 0 && F.tid == 0) { volatile LAS unsigned* M_ = (volatile LAS unsigned*)(F.lds + MISC_OFF); F.out[0] = (float)M_[32 + PROBE_TA] * (16.0f / 1000.0f); F.out[1] = (float)M_[32 + PROBE_TB] * (16.0f / 1000.0f); }
#endif
    }
#undef IN
#undef SEAM
}

extern "C" void kernel_launch(void* const* d_in, const int* in_sizes, int n_in, void* d_out, int out_size, void* d_ws, size_t ws_size, hipStream_t stream) {
    static int grid = 0;
    if (grid == 0) {
        if (n_in != 27 || in_sizes[0] != ML * D || out_size != ML * D || ws_size < WS_END) {
            fprintf(stderr, "kernel_launch: shape/workspace mismatch: n_in %d in0 %d out %d ws %zu (need %zu)\n", n_in, n_in > 0 ? in_sizes[0] : -1, out_size, ws_size, (size_t)WS_END); grid = -1; return; }
        int dev = 0, cus = 0, per_cu = 0;
        if (hipGetDevice(&dev) != hipSuccess || hipDeviceGetAttribute(&cus, hipDeviceAttributeMultiprocessorCount, dev) != hipSuccess) { grid = -1; return; }
        if (hipFuncSetAttribute((const void*)fwd_kernel, hipFuncAttributeMaxDynamicSharedMemorySize, LDS_BYTES) != hipSuccess) { fprintf(stderr, "kernel_launch: hipFuncSetAttribute failed\n"); grid = -1; return; }
        if (hipOccupancyMaxActiveBlocksPerMultiprocessor(&per_cu, (const void*)fwd_kernel, 512, LDS_BYTES) != hipSuccess || per_cu < 1) fprintf(stderr, "kernel_launch: occupancy query reports %d\n", per_cu);
        (void)hipGetLastError();
        grid = cus;
    }
    if (grid < 0) return;
    (void)hipMemsetAsync((char*)d_ws + WS_CTL, 0, CTL_BYTES, stream);
    Args a{};
    const float** ip = (const float**)&a.in;
    for (int i = 0; i < 27; ++i) ip[i] = (const float*)d_in[i];
    a.out = (float*)d_out; a.ws = (unsigned char*)d_ws;
#if MK_ONE_LAUNCH
    a.ph_lo = 0; a.ph_hi = NPHASES;
    hipLaunchKernelGGL(fwd_kernel, dim3(grid), dim3(512), LDS_BYTES, stream, a);
#else
    for (int ph = 0; ph < NPHASES; ++ph) {
#ifdef EMU
        extern int emu_stop_phase; if (emu_stop_phase >= 0 && ph >= emu_stop_phase) break; fprintf(stderr, "phase %d\n", ph);
#endif
        a.ph_lo = ph; a.ph_hi = ph + 1; hipLaunchKernelGGL(fwd_kernel, dim3(grid), dim3(512), LDS_BYTES, stream, a); }
#endif
}
```

```cpp
#ifndef EMU
#include <hip/hip_runtime.h>
#endif
#include <cstdio>
#include <cstdint>
#include <cstddef>

#ifndef CFG_SEQ
#define CFG_SEQ 16384
#endif
#ifndef CFG_CTX
#define CFG_CTX 256
#endif
#ifndef CFG_DEPTH
#define CFG_DEPTH 4
#endif
#ifndef CFG_NSEG
#define CFG_NSEG 4
#endif
#ifndef PROBE_MASK
#define PROBE_MASK 0
#endif
#ifndef PROBE_T
#define PROBE_T 0
#endif
#ifndef PROBE_TA
#define PROBE_TA 0
#endif
#ifndef PROBE_TB
#define PROBE_TB 1
#endif
#ifndef SCAN_PRIO
#define SCAN_PRIO 2
#endif
#ifndef SCAN_REP
#define SCAN_REP 0
#endif
#ifndef MK_ONE_LAUNCH
#define MK_ONE_LAUNCH 1
#endif
constexpr int D = 2048, NB = 2, SEQ = CFG_SEQ, DEPTH = CFG_DEPTH, CTX = CFG_CTX, GW = 64, HS = 64, RW = 1024, NH = 16, PWD = 1024;
constexpr int PG = 256, LORA = 96, GL = 256, DFF = 5632;
constexpr int OFF_R = 0, OFF_K = 1024, OFF_V = 2048, OFF_W = 3072, OFF_A = 3168, OFF_G = 3264, OFF_POOL = 3520, INW = 4544, INWP = 4608;
constexpr int ML = NB * SEQ, MC = NB * CTX, MR = ML + MC;
constexpr int NSEG = CFG_NSEG, TCH = (CTX + SEQ) / 64, SEG_BASE = TCH / NSEG, SEG_REM = TCH % NSEG, SEG_STEP = SEG_REM ? NSEG / SEG_REM + 1 : 1;
__host__ __device__ constexpr int seg_start(int sg) { return sg * SEG_BASE + ((sg + SEG_STEP - 1) / SEG_STEP < SEG_REM ? (sg + SEG_STEP - 1) / SEG_STEP : SEG_REM); }
static_assert(seg_start(NSEG) == TCH && seg_start(1) >= 1, "segments");
constexpr int GROWS = SEQ / GW;
constexpr float RMS_EPS = 1e-6f, GN_EPS = 64e-5f;
static_assert(ML % 256 == 0 && MR % 256 == 0 && SEQ % 256 == 0 && CTX % 64 == 0, "shape");
constexpr int NPM = MR / 256, NPM_L = ML / 256;

typedef unsigned short bf16_t;
typedef short bf16x8 __attribute__((ext_vector_type(8)));
typedef short bf16x4 __attribute__((ext_vector_type(4)));
typedef float f32x4 __attribute__((ext_vector_type(4)));
typedef float f32x2 __attribute__((ext_vector_type(2)));
typedef unsigned u32x4 __attribute__((ext_vector_type(4)));
typedef unsigned u32x2 __attribute__((ext_vector_type(2)));
#define DI __device__ __forceinline__
#ifdef EMU
#define LAS
#define GAS
#define CAS
#define MFMA16(a, b, c) emu_mfma16((a), (b), (c))
#define MFMA16K16(a, b, c) emu_mfma16k16((a), (b), (c))
#define LDS_TR16(p) emu_ds_read_tr16_b64((const void*)(p))
#define BPERM(v, src) __shfl((v), (src))
#define RFL(x) (x)
#define LDS_WAIT() emu_wave_sync()
#define VM_WAIT() do {} while (0)
#define WG_BAR() __syncthreads()
#define CFENCE() do {} while (0)
#define OPAQUE_S(x) do {} while (0)
#define OPAQUE_V(x) do {} while (0)
#define LANE_ID() ((int)(threadIdx.x & 63))
static inline float fexp(float x) { return expf(x); }
static inline float fexp2(float x) { return exp2f(x); }
static inline float frcp(float x) { return 1.0f / x; }
static inline float frsq(float x) { return 1.0f / sqrtf(x); }
#else
#define LAS __attribute__((address_space(3)))
#define GAS __attribute__((address_space(1)))
#define CAS __attribute__((address_space(4)))
#define MFMA16(a, b, c) __builtin_amdgcn_mfma_f32_16x16x32_bf16((a), (b), (c), 0, 0, 0)
#define MFMA16K16(a, b, c) __builtin_amdgcn_mfma_f32_16x16x16bf16_1k((a), (b), (c), 0, 0, 0)
#define LDS_TR16(p) __builtin_amdgcn_ds_read_tr16_b64_v4i16((LAS bf16x4*)(p))
#define BPERM(v, src) __builtin_bit_cast(float, __builtin_amdgcn_ds_bpermute(((src) & 63) << 2, __builtin_bit_cast(int, (v))))
#define RFL(x) __builtin_amdgcn_readfirstlane(x)
#define LDS_WAIT() asm volatile("s_waitcnt lgkmcnt(0)" ::: "memory")
#define VM_WAIT() asm volatile("s_waitcnt vmcnt(0)" ::: "memory")
#define WG_BAR() __syncthreads()
#define CFENCE() asm volatile("" ::: "memory")
#define OPAQUE_S(x) asm volatile("" : "+s"(x))
#define OPAQUE_V(x) asm volatile("" : "+v"(x))
DI int lane_id_volatile() { int l; asm volatile("v_mbcnt_lo_u32_b32 %0, -1, 0\n\tv_mbcnt_hi_u32_b32 %0, -1, %0" : "=v"(l)); return l; }
#define LANE_ID() lane_id_volatile()
DI float fexp(float x) { return __expf(x); }
DI float fexp2(float x) { return __builtin_amdgcn_exp2f(x); }
DI float frcp(float x) { return __builtin_amdgcn_rcpf(x); }
DI float frsq(float x) { return __builtin_amdgcn_rsqf(x); }
#endif
DI unsigned f2bf(float f) { unsigned u = __builtin_bit_cast(unsigned, f); return (u + 0x7fffu + ((u >> 16) & 1u)) >> 16; }
#ifdef EMU
DI unsigned pk2(float lo, float hi) { return f2bf(lo) | (f2bf(hi) << 16); }
#define SCHED_BAR() do {} while (0)
#else
typedef __bf16 nbf16x2 __attribute__((ext_vector_type(2)));
DI unsigned pk2(float lo, float hi) { return __builtin_bit_cast(unsigned, __builtin_convertvector((f32x2){lo, hi}, nbf16x2)); }
#define SCHED_BAR() __builtin_amdgcn_sched_barrier(0)
#endif
DI float bf2f(unsigned h) { return __builtin_bit_cast(float, h << 16); }
DI float bflo(unsigned w) { return __builtin_bit_cast(float, w << 16); }
DI float bfhi(unsigned w) { return __builtin_bit_cast(float, w & 0xffff0000u); }
DI float fsigmoid(float x) { return frcp(1.0f + fexp(-x)); }
DI float ftanh(float x) { return 1.0f - 2.0f * frcp(fexp(2.0f * x) + 1.0f); }
DI float fsilu(float x) { return x * fsigmoid(x); }
DI void unpack8(const u32x4& w, float (&f)[8]) { f[0] = bflo(w.x); f[1] = bfhi(w.x); f[2] = bflo(w.y); f[3] = bfhi(w.y); f[4] = bflo(w.z); f[5] = bfhi(w.z); f[6] = bflo(w.w); f[7] = bfhi(w.w); }
DI u32x4 pack8(const float (&f)[8]) { u32x4 w; w.x = pk2(f[0], f[1]); w.y = pk2(f[2], f[3]); w.z = pk2(f[4], f[5]); w.w = pk2(f[6], f[7]); return w; }
DI void unpack4(const u32x2& w, float (&f)[4]) { f[0] = bflo(w.x); f[1] = bfhi(w.x); f[2] = bflo(w.y); f[3] = bfhi(w.y); }
DI u32x2 pack4(const float (&f)[4]) { u32x2 w; w.x = pk2(f[0], f[1]); w.y = pk2(f[2], f[3]); return w; }
#ifdef EMU
DI float dpp_f(float x, int ctrl) { const int lane = threadIdx.x & 63; int src;
    if (ctrl == 0x141) src = (lane & ~7) | (7 - (lane & 7)); else if (ctrl == 0x140) src = (lane & ~15) | (15 - (lane & 15)); else src = (lane & ~3) | ((ctrl >> (2 * (lane & 3))) & 3);
    return __shfl(x, src); }
#else
DI float dpp_f(float x, int ctrl) { return x; }
#define dpp_f(x, ctrl) __builtin_bit_cast(float, __builtin_amdgcn_update_dpp(0, __builtin_bit_cast(int, (x)), (ctrl), 0xF, 0xF, true))
#endif
DI float row16_sum(float x) { x += dpp_f(x, 0xB1); x += dpp_f(x, 0x4E); x += dpp_f(x, 0x141); x += dpp_f(x, 0x140); return x; }
DI float wave_sum(float v) {
#pragma unroll
    for (int o = 1; o < 64; o <<= 1) v += __shfl_xor(v, o);
    return v;
}

namespace pg8 {
constexpr int BM = 256, BK = 64, HALF = 128, HTB = HALF * BK * 2, STAGE_BYTES = 8 * HTB, NXCD = 8, WGM = 4;
__host__ __device__ __forceinline__ int lds_byte(int r, int c) { const int st = (r >> 4) * 2 + (c >> 5), rr = r & 15, cc = c & 31, ob = rr * 64 + cc * 2; return st * 1024 + (ob ^ (((ob >> 9) & 1) << 5)); }
__host__ __device__ __forceinline__ void stage_rc(int b, int& R, int& C) { const int st = b / 1024, sb = b % 1024, swz = sb ^ (((sb >> 9) & 1) << 5); R = (st >> 1) * 16 + swz / 64; C = (st & 1) * 32 + (swz % 64) / 2; }
__host__ __device__ __forceinline__ int perm32(int rho) { const int n = rho >> 4, i = rho & 15; return 8 * (i >> 2) + 4 * n + (i & 3); }
struct Unit { int pm, pn, ks; };
struct Gemm { const bf16_t* A; const bf16_t* Bt; int lda, ldb, K, a_col_pn; };
struct StaticOrder {
    int nM, nN, nwg, G, c, base, limit;
    __host__ __device__ void init(int nM_, int nN_, int G_, int c_) { nM = nM_; nN = nN_; nwg = nM * nN; G = G_; c = c_; base = 0; limit = nwg; }
    __host__ __device__ void range(int base_, int limit_) { base = base_; limit = limit_; }
    __host__ __device__ bool next(int i, Unit& u) const {
        const long L = base + (long)i * G + c; if (L >= limit) return false;
        int wgid = (int)L; { const int q = nwg / NXCD, r = nwg % NXCD, xcd = wgid % NXCD, off = wgid / NXCD; wgid = (xcd < r ? xcd * (q + 1) : r * (q + 1) + (xcd - r) * q) + off; }
        const int nig = WGM * nN, gid = wgid / nig, fm = gid * WGM, gsz = (nM - fm) < WGM ? (nM - fm) : WGM;
        u.pm = fm + ((wgid % nig) % gsz); u.pn = (wgid % nig) / gsz; u.ks = 0; return true;
    }
};
struct FoldOrder {
    int nL, ksl, G, c;
    __host__ __device__ void init(int nL_, int ksl_, int G_, int c_) { nL = nL_; ksl = ksl_; G = G_; c = c_; }
    __host__ __device__ bool next(int i, Unit& u) const { const long L = (long)i * G + c; if (L >= (long)nL * 32) return false; const int r = (int)(L % 32); u.pm = r % 8; u.pn = r / 8; u.ks = (int)(L / 32) * ksl; return true; }
};
struct SplitKOrder {
    int nM, nN, nS, G, c;
    __host__ __device__ void init(int nM_, int nN_, int nS_, int G_, int c_) { nM = nM_; nN = nN_; nS = nS_; G = G_; c = c_; }
    __host__ __device__ bool next(int i, Unit& u) const { const long L = (long)i * G + c; if (L >= (long)nM * nN * nS) return false; u.ks = (int)(L % nS); u.pn = (int)((L / nS) % nN); u.pm = (int)(L / ((long)nS * nN)); return true; }
};
#ifndef EMU
#define PG8_LAS __attribute__((address_space(3)))
template <class Epi, class Sched, bool ALIGN_EPI = false, bool SP2 = false>
__device__ __forceinline__ void gemm_phase(PG8_LAS unsigned char* lds, const Gemm g, const Sched& S, const Epi& E, const int tid_) {
    const int tid = tid_, wid = __builtin_amdgcn_readfirstlane(tid >> 6), lane = tid & 63, wr = wid >> 2, wc = wid & 3, fr = lane & 15, fq = lane >> 4;
    const int K = g.K, nt = K / BK;
    unsigned voffA[2], voffB[2];
#pragma unroll
    for (int i = 0; i < 2; ++i) { int R, C; stage_rc(tid * 16 + i * 8192, R, C); const int Rb = Epi::PERM ? ((R & ~31) + perm32(R & 31)) : R;
        voffA[i] = (unsigned)(R * g.lda + C) * 2u; voffB[i] = (unsigned)(Rb * g.ldb + C) * 2u; }
    const size_t kstep = (size_t)(BK * 2);
    const size_t hstepA = (size_t)HALF * g.lda * 2, hstepB = (size_t)HALF * g.ldb * 2;
    const unsigned ldsw = (unsigned)wid * 1024u;
    const int aoff = lds_byte(wr * 64 + fr, fq * 8), boff = lds_byte(wc * 32 + fr, fq * 8);
#define PG8_SA(b, h) (((b) * 2 + (h)) * HTB)
#define PG8_SB(b, h) ((4 + (b) * 2 + (h)) * HTB)
#define PG8_STAGE(bufoff, gbase, voff) do { _Pragma("unroll") for (int _i = 0; _i < 2; ++_i) \
        __builtin_amdgcn_global_load_lds((const unsigned*)((const char*)(gbase) + (voff)[_i]), (PG8_LAS unsigned*)(lds + (bufoff) + ldsw + _i * 8192), 16, 0, 0); } while (0)
#define PG8_LDA(dst, b, h) do { _Pragma("unroll") for (int m = 0; m < 4; ++m) _Pragma("unroll") for (int k = 0; k < 2; ++k) dst[m][k] = *(const PG8_LAS bf16x8*)(lds + PG8_SA(b, h) + aoff + m * 2048 + k * 1024); } while (0)
#define PG8_LDB(dst, b, h) do { _Pragma("unroll") for (int n = 0; n < 2; ++n) _Pragma("unroll") for (int k = 0; k < 2; ++k) dst[n][k] = *(const PG8_LAS bf16x8*)(lds + PG8_SB(b, h) + boff + n * 2048 + k * 1024); } while (0)
#define PG8_MMA(ai, bj, At, Bt) do { __builtin_amdgcn_s_setprio(1); _Pragma("unroll") for (int m = 0; m < 4; ++m) _Pragma("unroll") for (int n = 0; n < 2; ++n) _Pragma("unroll") for (int k = 0; k < 2; ++k) \
        acc[ai][bj][m][n] = __builtin_amdgcn_mfma_f32_16x16x32_bf16(Bt[n][k], At[m][k], acc[ai][bj][m][n], 0, 0, 0); __builtin_amdgcn_s_setprio(0); } while (0)
#define PG8_WAIT_V(n) asm volatile("s_waitcnt vmcnt(" #n ")" ::: "memory")
#define PG8_WAIT_L(n) asm volatile("s_waitcnt lgkmcnt(" #n ")" ::: "memory")
#define PG8_BAR __builtin_amdgcn_s_barrier()
#define PG8_SCHED __builtin_amdgcn_sched_barrier(0)
#define PG8_APTR(u) ((const char*)g.A + ((size_t)(u).pm * BM * g.lda + (size_t)(u).pn * g.a_col_pn + (size_t)(u).ks * g.K) * 2)
#define PG8_BPTR(u) ((const char*)g.Bt + ((size_t)(u).pn * BM * g.ldb + (size_t)(u).ks * g.K) * 2)
    Unit cur, nxt; int ui = 0;
    if (!S.next(0, cur)) return;
    f32x4 acc[2][2][4][2];
#pragma unroll
    for (int a = 0; a < 2; ++a)
#pragma unroll
        for (int b = 0; b < 2; ++b)
#pragma unroll
            for (int m = 0; m < 4; ++m)
#pragma unroll
                for (int n = 0; n < 2; ++n) acc[a][b][m][n] = (f32x4){0.f, 0.f, 0.f, 0.f};
    bf16x8 At[4][2], B0[2][2], B1[2][2];
    const char* cA = PG8_APTR(cur); const char* cB = PG8_BPTR(cur);
    if constexpr (SP2) {
        PG8_STAGE(PG8_SB(0, 0), cB, voffB); PG8_STAGE(PG8_SB(0, 1), cB + hstepB, voffB); PG8_STAGE(PG8_SA(0, 0), cA, voffA); PG8_STAGE(PG8_SA(0, 1), cA + hstepA, voffA);
        if (wr == 1) PG8_BAR;
        PG8_WAIT_V(2); PG8_BAR;
        PG8_STAGE(PG8_SB(1, 0), cB + kstep, voffB); PG8_STAGE(PG8_SA(1, 0), cA + kstep, voffA); PG8_STAGE(PG8_SB(1, 1), cB + hstepB + kstep, voffB);
        PG8_WAIT_V(6); PG8_BAR;
    } else {
        PG8_STAGE(PG8_SB(0, 0), cB, voffB); PG8_STAGE(PG8_SA(0, 0), cA, voffA); PG8_STAGE(PG8_SB(0, 1), cB + hstepB, voffB); PG8_STAGE(PG8_SA(0, 1), cA + hstepA, voffA);
        if (wr == 1) PG8_BAR;
        PG8_WAIT_V(4); PG8_BAR;
        PG8_STAGE(PG8_SB(1, 0), cB + kstep, voffB); PG8_STAGE(PG8_SA(1, 0), cA + kstep, voffA); PG8_STAGE(PG8_SB(1, 1), cB + hstepB + kstep, voffB);
        PG8_WAIT_V(6); PG8_BAR;
    }
    for (;;) {
        const bool has_next = S.next(ui + 1, nxt);
        const char* nA = has_next ? PG8_APTR(nxt) : cA; const char* nB = has_next ? PG8_BPTR(nxt) : cB;
#pragma unroll 1
        for (int t = 0; t < nt; t += 2) {
            const bool last = (t == nt - 2);
            const char* a1 = cA + (size_t)(t + 1) * kstep;
            const char* a2 = last ? nA : cA + (size_t)(t + 2) * kstep; const char* b2 = last ? nB : cB + (size_t)(t + 2) * kstep;
            const char* a3 = a2 + kstep; const char* b3 = b2 + kstep;
            if constexpr (SP2) {
            PG8_LDB(B0, 0, 0); PG8_LDB(B1, 0, 1); PG8_SCHED; PG8_LDA(At, 0, 0); PG8_STAGE(PG8_SA(1, 1), a1 + hstepA, voffA);
            PG8_WAIT_V(8); PG8_WAIT_L(0); PG8_BAR; PG8_MMA(0, 0, At, B0); PG8_MMA(0, 1, At, B1); PG8_BAR; PG8_SCHED;
            PG8_LDA(At, 0, 1); PG8_STAGE(PG8_SB(0, 0), b2, voffB); PG8_STAGE(PG8_SB(0, 1), b2 + hstepB, voffB); PG8_STAGE(PG8_SA(0, 0), a2, voffA);
            PG8_WAIT_V(8); PG8_WAIT_L(0); PG8_BAR; PG8_MMA(1, 0, At, B0); PG8_MMA(1, 1, At, B1); PG8_BAR; PG8_SCHED;
            PG8_LDB(B0, 1, 0); PG8_LDB(B1, 1, 1); PG8_SCHED; PG8_LDA(At, 1, 0); PG8_STAGE(PG8_SA(0, 1), a2 + hstepA, voffA);
            PG8_WAIT_V(8); PG8_WAIT_L(0); PG8_BAR; PG8_MMA(0, 0, At, B0); PG8_MMA(0, 1, At, B1); PG8_BAR; PG8_SCHED;
            PG8_LDA(At, 1, 1); PG8_STAGE(PG8_SB(1, 0), b3, voffB); PG8_STAGE(PG8_SB(1, 1), b3 + hstepB, voffB); PG8_STAGE(PG8_SA(1, 0), a3, voffA);
            PG8_WAIT_V(8); PG8_WAIT_L(0); PG8_BAR; PG8_MMA(1, 0, At, B0); PG8_MMA(1, 1, At, B1); PG8_BAR; PG8_SCHED;
            } else {
            PG8_LDB(B0, 0, 0); PG8_SCHED; PG8_LDA(At, 0, 0); PG8_STAGE(PG8_SA(1, 1), a1 + hstepA, voffA);
            PG8_WAIT_L(8); PG8_BAR; PG8_WAIT_L(0); PG8_MMA(0, 0, At, B0); PG8_BAR; PG8_SCHED;
            PG8_LDB(B1, 0, 1); PG8_STAGE(PG8_SB(0, 0), b2, voffB);
            PG8_BAR; PG8_WAIT_L(0); PG8_MMA(0, 1, At, B1); PG8_BAR;
            PG8_LDA(At, 0, 1); PG8_STAGE(PG8_SA(0, 0), a2, voffA);
            PG8_BAR; PG8_WAIT_L(0); PG8_MMA(1, 0, At, B0); PG8_BAR; PG8_SCHED;
            PG8_STAGE(PG8_SB(0, 1), b2 + hstepB, voffB);
            PG8_WAIT_V(6); PG8_BAR; PG8_MMA(1, 1, At, B1); PG8_BAR;
            PG8_LDB(B0, 1, 0); PG8_SCHED; PG8_LDA(At, 1, 0); PG8_STAGE(PG8_SA(0, 1), a2 + hstepA, voffA);
            PG8_WAIT_L(8); PG8_BAR; PG8_WAIT_L(0); PG8_MMA(0, 0, At, B0); PG8_BAR; PG8_SCHED;
            PG8_LDB(B1, 1, 1); PG8_STAGE(PG8_SB(1, 0), b3, voffB);
            PG8_BAR; PG8_WAIT_L(0); PG8_MMA(0, 1, At, B1); PG8_BAR;
            PG8_LDA(At, 1, 1); PG8_STAGE(PG8_SA(1, 0), a3, voffA);
            PG8_BAR; PG8_WAIT_L(0); PG8_MMA(1, 0, At, B0); PG8_BAR; PG8_SCHED;
            PG8_STAGE(PG8_SB(1, 1), b3 + hstepB, voffB);
            PG8_WAIT_V(6); PG8_BAR; PG8_MMA(1, 1, At, B1); PG8_BAR;
            }
        }
        if constexpr (ALIGN_EPI) { if (wr == 0) PG8_BAR; }
        E(acc, cur, wr, wc, fr, fq);
        if (!has_next) break;
#pragma unroll
        for (int a = 0; a < 2; ++a)
#pragma unroll
            for (int b = 0; b < 2; ++b)
#pragma unroll
                for (int m = 0; m < 4; ++m)
#pragma unroll
                    for (int n = 0; n < 2; ++n) acc[a][b][m][n] = (f32x4){0.f, 0.f, 0.f, 0.f};
        cur = nxt; cA = nA; cB = nB; ++ui;
        if constexpr (ALIGN_EPI) { if (wr == 1) PG8_BAR; }
    }
    PG8_WAIT_V(0);
    if constexpr (!ALIGN_EPI) { if (wr == 0) PG8_BAR; }
    PG8_BAR;
#undef PG8_SA
#undef PG8_SB
#undef PG8_STAGE
#undef PG8_LDA
#undef PG8_LDB
#undef PG8_MMA
#undef PG8_WAIT_V
#undef PG8_WAIT_L
#undef PG8_BAR
#undef PG8_SCHED
#undef PG8_APTR
#undef PG8_BPTR
}
#else
static thread_local float* emu_tile = nullptr;
template <class Epi, class Sched, bool ALIGN_EPI = false, bool SP2 = false>
static void gemm_phase(unsigned char* lds, const Gemm g, const Sched& S, const Epi& E, const int tid_) {
    const int tid = tid_, wid = tid >> 6, lane = tid & 63, wr = wid >> 2, wc = wid & 3, fr = lane & 15, fq = lane >> 4;
    if (!emu_tile) emu_tile = (float*)malloc(256 * 256 * 4);
    Unit u;
    for (int i = 0; S.next(i, u); ++i) {
        const bf16_t* A = g.A + (size_t)u.pm * BM * g.lda + (size_t)u.pn * g.a_col_pn + (size_t)u.ks * g.K; const bf16_t* Bt = g.Bt + (size_t)u.pn * BM * g.ldb + (size_t)u.ks * g.K;
        { const int r = tid >> 1, c0 = (tid & 1) * 128; std::vector<float> ar(g.K); for (int k = 0; k < g.K; ++k) ar[k] = bf2f(A[(size_t)r * g.lda + k]);
          for (int c = c0; c < c0 + 128; ++c) { const bf16_t* br = Bt + (size_t)c * g.ldb; float s0 = 0, s1 = 0, s2 = 0, s3 = 0; for (int k = 0; k < g.K; k += 4) { s0 += ar[k] * bf2f(br[k]); s1 += ar[k + 1] * bf2f(br[k + 1]); s2 += ar[k + 2] * bf2f(br[k + 2]); s3 += ar[k + 3] * bf2f(br[k + 3]); } emu_tile[r * 256 + c] = (s0 + s1) + (s2 + s3); } }
        __syncthreads();
        f32x4 acc[2][2][4][2];
        for (int ai = 0; ai < 2; ++ai) for (int bj = 0; bj < 2; ++bj) for (int m = 0; m < 4; ++m) for (int n = 0; n < 2; ++n) for (int e = 0; e < 4; ++e) {
            const int r = 128 * ai + 64 * wr + 16 * m + fr; const int c = Epi::PERM ? (128 * bj + 32 * wc + 8 * fq + 4 * n + e) : (128 * bj + 32 * wc + 16 * n + 4 * fq + e);
            acc[ai][bj][m][n][e] = emu_tile[r * 256 + c]; }
        E(acc, u, wr, wc, fr, fq);
        __syncthreads();
    }
}
#endif
}

constexpr size_t al256(size_t x) { return (x + 255) & ~(size_t)255; }
constexpr size_t WS_CTL = 0, CTL_BYTES = 1u << 15;
constexpr size_t WS_MOD = WS_CTL + CTL_BYTES;
constexpr size_t SZ_MOD = al256((size_t)DEPTH * 3 * 6 * D * 4);
constexpr int ADA_KC = 16;
constexpr size_t WS_ADAP = WS_MOD + SZ_MOD;
constexpr size_t SZ_ADAP = al256((size_t)DEPTH * ADA_KC * 3 * 6 * D * 4);
constexpr size_t WL_WIN = 0, WL_WOUT = WL_WIN + (size_t)INWP * D * 2, WL_WGU = WL_WOUT + (size_t)D * D * 2, WL_WDN = WL_WGU + (size_t)2 * DFF * D * 2,
                 WL_GUP = WL_WDN + (size_t)D * DFF * 2, WL_POOL = WL_GUP + (size_t)RW * GL * 2, WL_DUP = WL_POOL + (size_t)4 * PG * PG * 2,
                 WL_IUP = WL_DUP + (size_t)2 * RW * LORA * 2, WL_SIZE = al256(WL_IUP + (size_t)2 * RW * LORA * 2);
constexpr size_t WS_W = WS_ADAP + SZ_ADAP;
constexpr size_t WS_XN = WS_W + WL_SIZE * DEPTH;
constexpr size_t WS_MIX = WS_XN + (size_t)MR * D * 2;
constexpr size_t WS_CTXH = WS_MIX + (size_t)MR * D * 2;
constexpr size_t WS_SSEG = WS_CTXH + (size_t)MC * D * 4;
constexpr size_t SZ_ST = (size_t)NB * NH * 2 * NSEG * 4096 * 4;
constexpr size_t WS_PSEG = WS_SSEG + SZ_ST, WS_HIN = WS_PSEG + SZ_ST;
constexpr size_t WS_BS = WS_HIN + SZ_ST;
constexpr size_t WS_BIG = al256(WS_BS + (size_t)2 * MR * NH * 4);
constexpr size_t WS_U = WS_BIG;
constexpr size_t WS_YF = WS_U + (size_t)MR * INWP * 2;
constexpr size_t WS_XB = WS_YF + (size_t)2 * MR * RW * 2;
static_assert((size_t)ML * D * 2 <= (size_t)2 * MR * RW * 2 && WS_XB >= WS_U + (size_t)MR * DFF * 2, "XB placement");
constexpr size_t WS_G = WS_YF + (size_t)2 * MR * RW * 4;
constexpr size_t WS_PD = WS_G + (size_t)MR * RW * 2;
constexpr size_t WS_VS = WS_PD + (size_t)MR * PWD * 2;
constexpr int KSPLIT = 512, NPART_DN = DFF / KSPLIT, NPART_WO = D / KSPLIT;
constexpr size_t WS_PART = WS_VS + (size_t)ML * PWD * 2;
constexpr size_t WS_BIG_END1 = WS_PART + (size_t)NPART_DN * MC * D * 4;
static_assert(DFF % KSPLIT == 0 && D % KSPLIT == 0, "split-K slices");
constexpr size_t WS_H = WS_BIG;
constexpr size_t WS_BIG_END2 = WS_H + (size_t)MR * DFF * 2;
constexpr size_t WS_END = WS_BIG_END1 > WS_BIG_END2 ? WS_BIG_END1 : WS_BIG_END2;
constexpr int CW_BAR = 4096;

constexpr int IMG = 8192;
constexpr int M_RT = 0, M_AT = 1, M_KB = 2, M_BB = 3, M_VT = 4, N_IMG = 5;
constexpr int SET_BYTES = N_IMG * IMG;
constexpr int SCR_G = 2 * SET_BYTES, SCR_AI = SCR_G + 64 * 64 * 4;
constexpr int SC_GC = SCR_AI + 64 * 64 * 4;
constexpr int SC_PAR = SC_GC + 512;
constexpr int SC_SH = SC_PAR + 3072;
constexpr int MISC_OFF = (SC_SH + 16384) > 131072 ? (SC_SH + 16384) : 131072;
constexpr int LDS_BYTES = MISC_OFF + 512;
static_assert(LDS_BYTES <= 160 * 1024 && pg8::STAGE_BYTES <= MISC_OFF, "LDS");

#define XB_TMO      128
#define XB_XCNT(j)  (256  + 64 * (j))
#define XB_XSUB(j)  (1280 + 64 * (j))
#define XB_XGEN(j)  (2304 + 64 * (j))
#define XB_TOP      3328
#define XB_TOPGEN   3392
#define XCD_BAR_WORDS 3456
#define XB_SPIN_CAP (1u << 18)
#ifndef EMU
__device__ __forceinline__ unsigned xb_ld(unsigned* p)              { return __hip_atomic_load(p, __ATOMIC_RELAXED, __HIP_MEMORY_SCOPE_AGENT); }
__device__ __forceinline__ unsigned xb_add(unsigned* p, unsigned v) { return __hip_atomic_fetch_add(p, v, __ATOMIC_RELAXED, __HIP_MEMORY_SCOPE_AGENT); }
__device__ __forceinline__ unsigned xb_xcc_id() { return (unsigned)__builtin_amdgcn_s_getreg((3 << 11) | 20) & 0xFu; }
#define XB_SPIN(cond, bar) do { unsigned _sp = 0; while (cond) { __builtin_amdgcn_s_sleep(1); \
    if ((++_sp & 255u) == 0u) { if (xb_ld(&(bar)[XB_TMO])) break; if (_sp > XB_SPIN_CAP) { atomicAdd(&(bar)[XB_TMO], 1u); break; } } } } while (0)
struct XcdBarrier { unsigned* bar; unsigned x; volatile LAS unsigned* st; };
__device__ __forceinline__ XcdBarrier xcd_barrier_post(unsigned* bar, volatile LAS unsigned* st) {
    XcdBarrier b; b.bar = bar; b.x = xb_xcc_id(); b.st = st;
    if (threadIdx.x == 0) (void)xb_add(&bar[XB_XCNT(b.x)], 1u);
    return b;
}
__device__ __forceinline__ void xcd_barrier_complete(unsigned* bar, unsigned x, unsigned& nloc, unsigned& nx) {
    const unsigned G = gridDim.x * gridDim.y * gridDim.z;
    unsigned sum, cnt, mine, sp = 0u;
    for (;;) {
        sum = 0u; cnt = 0u; mine = 0u;
#pragma unroll
        for (unsigned j = 0; j < 16; ++j) { const unsigned c = xb_ld(&bar[XB_XCNT(j)]); sum += c; cnt += (c > 0u) ? 1u : 0u; mine = (j == x) ? c : mine; }
        if (sum == G) break;
        __builtin_amdgcn_s_sleep(1);
        if ((++sp & 255u) == 0u) { if (xb_ld(&bar[XB_TMO])) break; if (sp > XB_SPIN_CAP) { atomicAdd(&bar[XB_TMO], 1u); break; } }
    }
    nloc = mine > 0u ? mine : 1u; nx = cnt > 0u ? cnt : 1u;
}
__device__ __forceinline__ void xcd_barrier(const XcdBarrier& b, const bool t0) {
    asm volatile("s_waitcnt vmcnt(0)" ::: "memory");
    __syncthreads();
    if (t0) {
        unsigned* bar = b.bar;
        __builtin_amdgcn_s_waitcnt(0);
        unsigned nloc = b.st[0], nx = b.st[1];
        if (nloc == 0u) { xcd_barrier_complete(bar, b.x, nloc, nx); b.st[0] = nloc; b.st[1] = nx; }
        const unsigned old = xb_add(&bar[XB_XSUB(b.x)], 1u);
        const unsigned gen = old / nloc;
        if (old + 1u == (gen + 1u) * nloc) {
            __builtin_amdgcn_fence(__ATOMIC_RELEASE, "agent");
            asm volatile("s_waitcnt vmcnt(0)" ::: "memory");
            const unsigned og = xb_add(&bar[XB_TOP], 1u);
            const unsigned tg = og / nx;
            if (og + 1u == (tg + 1u) * nx) xb_add(&bar[XB_TOPGEN], 1u);
            else XB_SPIN(xb_ld(&bar[XB_TOPGEN]) == tg, bar);
            __builtin_amdgcn_fence(__ATOMIC_ACQUIRE, "agent");
            xb_add(&bar[XB_XGEN(b.x)], 1u);
            asm volatile("s_waitcnt vmcnt(0)" ::: "memory");
        } else {
            XB_SPIN(xb_ld(&bar[XB_XGEN(b.x)]) == gen, bar);
            __builtin_amdgcn_fence(__ATOMIC_ACQUIRE, "agent");
            asm volatile("s_waitcnt vmcnt(0)" ::: "memory");
        }
    }
    __syncthreads();
}
#else
struct XcdBarrier { unsigned* bar; };
static inline void xcd_barrier(const XcdBarrier&) { fprintf(stderr, "EMU: grid barrier not supported (use per-phase launches)\n"); abort(); }
#endif

struct Inputs {
    const float *x, *c, *ctx, *c_ctx, *ada_w, *ada_b, *norm_mix, *norm_ffn, *w_in, *conv_rkv, *decay_bias, *decay_up, *iclr_bias, *iclr_up, *gate_up,
        *k_k, *k_a, *r_k, *gn_w, *gn_b, *pool_w, *pool_scale, *w_out, *ffn_gate, *ffn_up, *ffn_down, *final_norm;
};
struct Args { Inputs in; float* out; unsigned char* ws; int ph_lo, ph_hi; };
struct Frame {
    LAS unsigned char* lds;
    int tid, lane, wave, vcu, G;
    float* out; unsigned char* ws;
};
DI bf16_t* wl_ptr(const Frame& F, int l, size_t off) { return (bf16_t*)(F.ws + WS_W + (size_t)l * WL_SIZE + off); }
DI const float* mod_ptr(const Frame& F, int l, int s, int j) { return (const float*)(F.ws + WS_MOD) + ((size_t)(l * 3 + s) * 6 + j) * D; }
DI int sample_of_row(int row) { return row < ML ? row / SEQ : 2; }

struct P0Desc { const float* W; bf16_t* WT; int N, ldo, dst_row0, k0, n0; };
DI void p0_load(const P0Desc& d, const int lane, float (&v)[32]) {
#pragma unroll
    for (int i = 0; i < 32; ++i) { const int kk = 2 * i + (lane >> 5); v[i] = d.W[(size_t)(d.k0 + kk) * d.N + d.n0 + (lane & 31)]; }
}
DI void p0_store(const P0Desc& d, const int lane, const float (&v)[32], LAS float* scr) {
#pragma unroll
    for (int i = 0; i < 32; ++i) { const int kk = 2 * i + (lane >> 5); scr[kk * 33 + (lane & 31)] = v[i]; }
    LDS_WAIT();
    const int c = lane & 7;
#pragma unroll
    for (int j = 0; j < 4; ++j) { const int n = (lane >> 3) + 8 * j; const LAS float* s = scr + (8 * c) * 33 + n;
        u32x4 o; o.x = pk2(s[0 * 33], s[1 * 33]); o.y = pk2(s[2 * 33], s[3 * 33]); o.z = pk2(s[4 * 33], s[5 * 33]); o.w = pk2(s[6 * 33], s[7 * 33]);
        *(u32x4*)(d.WT + (size_t)(d.dst_row0 + n) * d.ldo + d.k0 + 8 * c) = o; }
    LDS_WAIT();
}
constexpr int P0_I_WIN = (D / 64) * (INW / 32), P0_I_WOUT = (D / 64) * (D / 32), P0_I_G = (D / 64) * (DFF / 32), P0_I_DN = (DFF / 64) * (D / 32), P0_I_GUP = (GL / 64) * (RW / 32), P0_I_POOL = 4 * (PG / 64) * (PG / 32);
constexpr int P0_I_T = P0_I_WIN + P0_I_WOUT + 2 * P0_I_G + P0_I_DN + P0_I_GUP;
DI void p0_desc(const Frame& F, const CAS Inputs& IN_, const int it, P0Desc& d) {
    const int l = it / P0_I_T; int r = it % P0_I_T;
    if (r < P0_I_WIN) { const int nb = INW / 32, kb = r / nb, n0 = 32 * (r % nb); d = P0Desc{IN_.w_in + (size_t)l * D * INW, wl_ptr(F, l, WL_WIN), INW, D, n0, 64 * kb, n0}; return; } r -= P0_I_WIN;
    if (r < P0_I_WOUT) { const int nb = D / 32, kb = r / nb, n0 = 32 * (r % nb); d = P0Desc{IN_.w_out + (size_t)l * D * D, wl_ptr(F, l, WL_WOUT), D, D, n0, 64 * kb, n0}; return; } r -= P0_I_WOUT;
    if (r < 2 * P0_I_G) { const int up = r >= P0_I_G; if (up) r -= P0_I_G; const int nb = DFF / 32, kb = r / nb, n0 = 32 * (r % nb);
        d = P0Desc{(up ? IN_.ffn_up : IN_.ffn_gate) + (size_t)l * D * DFF, wl_ptr(F, l, WL_WGU), DFF, D, (n0 / 128) * 256 + (n0 % 128) + (up ? 128 : 0), 64 * kb, n0}; return; } r -= 2 * P0_I_G;
    if (r < P0_I_DN) { const int nb = D / 32, kb = r / nb, n0 = 32 * (r % nb); d = P0Desc{IN_.ffn_down + (size_t)l * DFF * D, wl_ptr(F, l, WL_WDN), D, DFF, n0, 64 * kb, n0}; return; } r -= P0_I_DN;
    { const int nb = RW / 32, kb = r / nb, n0 = 32 * (r % nb); d = P0Desc{IN_.gate_up + (size_t)l * GL * RW, wl_ptr(F, l, WL_GUP), RW, GL, n0, 64 * kb, n0}; }
}
DI void p0_convert_span(Frame& F, const CAS Inputs& IN_, const int l, const int r_lo, const int r_hi, const int w, const int NW) {
    LAS float* scr = (LAS float*)(F.lds + F.wave * 16384);
    const int end = l * P0_I_T + r_hi; int it = l * P0_I_T + r_lo + w; P0Desc dc; float v[32];
    if (it < end) { p0_desc(F, IN_, it, dc); p0_load(dc, F.lane, v); }
    while (it < end) { const int itn = it + NW; const bool hn = itn < end; P0Desc dn = dc; float vn[32];
        if (hn) { p0_desc(F, IN_, itn, dn); p0_load(dn, F.lane, vn); }
        p0_store(dc, F.lane, v, scr);
        if (hn) { dc = dn;
#pragma unroll
            for (int i = 0; i < 32; ++i) v[i] = vn[i]; }
        it = itn; }
}
constexpr int P0_R_WOUT0 = P0_I_WIN, P0_R_WOUT1 = P0_I_WIN + P0_I_WOUT, P0_R_A1 = P0_R_WOUT1 + P0_I_G;
#ifndef P0_DEFER
#define P0_DEFER 1
#endif
DI int conv_in(int G) { return (P0_DEFER && G % 8 == 0 && G >= 32) ? G / 16 : 0; }
DI int conv_up(int G) { return (P0_DEFER && G % 8 == 0 && G >= 32) ? G / 32 : 0; }
DI void phase_p0(Frame& F, const CAS Inputs& IN_) {
    const int gw = F.vcu * 8 + F.wave, NGW = F.G * 8;
    { const bool defer = conv_in(F.G) > 0;
      p0_convert_span(F, IN_, 0, 0, P0_I_T, gw, NGW);
      for (int l = 1; l < DEPTH; ++l) { if (defer) p0_convert_span(F, IN_, l, P0_R_WOUT0, P0_R_WOUT1, gw, NGW); else p0_convert_span(F, IN_, l, 0, P0_I_T, gw, NGW); } }
    for (int it = gw; it < P0_I_POOL * DEPTH; it += NGW) { const int l = it / P0_I_POOL; int r = it % P0_I_POOL;
        const int gi = r / ((PG / 64) * (PG / 32)); r %= (PG / 64) * (PG / 32); const int nb = PG / 32, kb = r / nb, n0 = 32 * (r % nb);
        const float* src = IN_.pool_w + ((size_t)l * 4 + gi) * PG * PG; bf16_t* dst = wl_ptr(F, l, WL_POOL) + (size_t)gi * PG * PG; const int co = n0 + (F.lane & 31); const float sc = IN_.pool_scale[(size_t)l * PWD + gi * PG + co];
#pragma unroll 8
        for (int i = 0; i < 32; ++i) { const int ci = 64 * kb + 2 * i + (F.lane >> 5); dst[(size_t)ci * PG + co] = (bf16_t)f2bf(src[(size_t)ci * PG + co] * sc); } }
    const int gt = F.vcu * 512 + F.tid, NGT = F.G * 512;
    for (int i = gt; i < DEPTH * (INWP - INW) * D / 8; i += NGT) { const int l = i / ((INWP - INW) * D / 8), r = i % ((INWP - INW) * D / 8);
        *(u32x4*)(wl_ptr(F, l, WL_WIN) + (size_t)INW * D + (size_t)r * 8) = (u32x4){0u, 0u, 0u, 0u}; }
    for (int i = gt; i < DEPTH * 2 * 2 * RW * LORA; i += NGT) { int r = i; const int k = r % LORA; r /= LORA; const int n = r % RW; r /= RW; const int d = r % 2; r /= 2; const int which = r % 2; const int l = r / 2;
        const float* src = (which ? IN_.iclr_up : IN_.decay_up) + (((size_t)l * 2 + d) * LORA + k) * RW + n;
        wl_ptr(F, l, which ? WL_IUP : WL_DUP)[((size_t)d * RW + n) * LORA + k] = (bf16_t)f2bf(*src); }
    constexpr int NJB = 6 * D / 256, KCH = D / ADA_KC;
    for (int it = gw; it < DEPTH * NJB * ADA_KC; it += NGW) {
        const int kc = it % ADA_KC, jb = (it / ADA_KC) % NJB, l = it / (ADA_KC * NJB);
        const float* w = IN_.ada_w + ((size_t)l * D + (size_t)kc * KCH) * 6 * D + jb * 256 + 4 * F.lane;
        f32x4 a0 = {0.f, 0.f, 0.f, 0.f}, a1 = a0, a2 = a0;
#pragma unroll 8
        for (int k = 0; k < KCH; ++k) { const int kk = kc * KCH + k; const f32x4 wv = *(const f32x4*)(w + (size_t)k * 6 * D);
            const float c0 = fsilu(IN_.c[kk]), c1 = fsilu(IN_.c[D + kk]), c2 = fsilu(IN_.c_ctx[kk]);
            a0 += wv * c0; a1 += wv * c1; a2 += wv * c2; }
        float* p = (float*)(F.ws + WS_ADAP) + (((size_t)l * ADA_KC + kc) * 3) * 6 * D + jb * 256 + 4 * F.lane;
        *(f32x4*)(p) = a0; *(f32x4*)(p + 6 * D) = a1; *(f32x4*)(p + 12 * D) = a2;
    }
}
DI void phase_p0b(Frame& F, const CAS Inputs& IN_) {
    const int gt = F.vcu * 512 + F.tid, NGT = F.G * 512;
    for (int i = gt; i < DEPTH * 3 * 6 * D; i += NGT) { const int j = i % (6 * D), s = (i / (6 * D)) % 3, l = i / (18 * D);
        float a = IN_.ada_b[(size_t)l * 6 * D + j];
        for (int kc = 0; kc < ADA_KC; ++kc) a += ((const float*)(F.ws + WS_ADAP))[(((size_t)l * ADA_KC + kc) * 3 + s) * 6 * D + j];
        ((float*)(F.ws + WS_MOD))[i] = a; }
}

DI void phase_norm(Frame& F, const CAS Inputs& IN_, int l, bool second, int nrows, const int nparts, const float* cbase, const float* cgate) {
    const int gw = F.vcu * 8 + F.wave, NGW = F.G * 8;
    const float* gvec = (second ? IN_.norm_ffn : IN_.norm_mix) + (size_t)l * D;
    bf16_t* XN = (bf16_t*)(F.ws + WS_XN);
    int row_first = gw;
    if (!(l == 0 && !second)) {
        const bf16_t* XB = (const bf16_t*)(F.ws + WS_XB);
        u32x4 w0[4], w1[4];
        if (gw < ML) {
#pragma unroll
            for (int j2 = 0; j2 < 4; ++j2) { w0[j2] = *(const u32x4*)(XB + (size_t)gw * D + 8 * (F.lane + 64 * j2)); w1[j2] = (gw + NGW < ML) ? *(const u32x4*)(XB + (size_t)(gw + NGW) * D + 8 * (F.lane + 64 * j2)) : (u32x4){0u, 0u, 0u, 0u}; } }
        for (int row = gw; row < ML; row += 2 * NGW) {
            const int row1 = row + NGW; const bool has1 = row1 < ML;
            u32x4 n0[4], n1[4]; const int rown = row + 2 * NGW;
#pragma unroll
            for (int j2 = 0; j2 < 4; ++j2) { n0[j2] = (rown < ML) ? *(const u32x4*)(XB + (size_t)rown * D + 8 * (F.lane + 64 * j2)) : (u32x4){0u, 0u, 0u, 0u}; n1[j2] = (rown + NGW < ML) ? *(const u32x4*)(XB + (size_t)(rown + NGW) * D + 8 * (F.lane + 64 * j2)) : (u32x4){0u, 0u, 0u, 0u}; }
            float f0[4][8], f1[4][8]; float s0 = 0.f, s1 = 0.f;
#pragma unroll
            for (int j2 = 0; j2 < 4; ++j2) { unpack8(w0[j2], f0[j2]); unpack8(w1[j2], f1[j2]);
#pragma unroll
                for (int e = 0; e < 8; ++e) { s0 += f0[j2][e] * f0[j2][e]; s1 += f1[j2][e] * f1[j2][e]; } }
#pragma unroll
            for (int o = 1; o < 64; o <<= 1) { s0 += __shfl_xor(s0, o); s1 += __shfl_xor(s1, o); }
            const float rs0 = frsq(s0 * (1.f / D) + RMS_EPS), rs1 = frsq(s1 * (1.f / D) + RMS_EPS);
            const int sa = row / SEQ, sb = has1 ? row1 / SEQ : sa;
            const float* sh0 = mod_ptr(F, l, sa, second ? 3 : 0); const float* sc0 = mod_ptr(F, l, sa, second ? 4 : 1);
            const float* sh1 = mod_ptr(F, l, sb, second ? 3 : 0); const float* sc1 = mod_ptr(F, l, sb, second ? 4 : 1);
#pragma unroll
            for (int j2 = 0; j2 < 4; ++j2) { const int c = 8 * (F.lane + 64 * j2); float g8[8], o0[8], o1[8];
                { const f32x4 ga = *(const f32x4*)(gvec + c), gb = *(const f32x4*)(gvec + c + 4); g8[0] = ga[0]; g8[1] = ga[1]; g8[2] = ga[2]; g8[3] = ga[3]; g8[4] = gb[0]; g8[5] = gb[1]; g8[6] = gb[2]; g8[7] = gb[3]; }
                { const f32x4 a0 = *(const f32x4*)(sc0 + c), a1 = *(const f32x4*)(sc0 + c + 4), b0 = *(const f32x4*)(sh0 + c), b1 = *(const f32x4*)(sh0 + c + 4);
#pragma unroll
                  for (int e = 0; e < 4; ++e) { o0[e] = f0[j2][e] * rs0 * g8[e] * (a0[e] + 1.0f) + b0[e]; o0[4 + e] = f0[j2][4 + e] * rs0 * g8[4 + e] * (a1[e] + 1.0f) + b1[e]; } }
                *(u32x4*)(XN + (size_t)row * D + c) = pack8(o0);
                if (has1) { const f32x4 a0 = *(const f32x4*)(sc1 + c), a1 = *(const f32x4*)(sc1 + c + 4), b0 = *(const f32x4*)(sh1 + c), b1 = *(const f32x4*)(sh1 + c + 4);
#pragma unroll
                  for (int e = 0; e < 4; ++e) { o1[e] = f1[j2][e] * rs1 * g8[e] * (a0[e] + 1.0f) + b0[e]; o1[4 + e] = f1[j2][4 + e] * rs1 * g8[4 + e] * (a1[e] + 1.0f) + b1[e]; }
                  *(u32x4*)(XN + (size_t)row1 * D + c) = pack8(o1); } }
#pragma unroll
            for (int j2 = 0; j2 < 4; ++j2) { w0[j2] = n0[j2]; w1[j2] = n1[j2]; }
        }
        row_first = ML + gw;
    }
    for (int row = row_first; row < nrows; row += NGW) {
        const float* xr;
        const bool lat_bf = row < ML && !(l == 0 && !second);
        if (row < ML) xr = IN_.x + (size_t)row * D;
        else xr = (nparts > 0 ? cbase : ((l == 0 && !second) ? IN_.ctx : (const float*)(F.ws + WS_CTXH))) + (size_t)(row - ML) * D;
        const int s = sample_of_row(row);
        const float* sh = mod_ptr(F, l, s, second ? 3 : 0); const float* sc = mod_ptr(F, l, s, second ? 4 : 1);
        f32x4 v[8]; float ss = 0.f;
        if (lat_bf) { const bf16_t* xb = (const bf16_t*)(F.ws + WS_XB) + (size_t)row * D;
#pragma unroll
            for (int j2 = 0; j2 < 4; ++j2) { float f[8]; unpack8(*(const u32x4*)(xb + 8 * (F.lane + 64 * j2)), f); v[2 * j2] = (f32x4){f[0], f[1], f[2], f[3]}; v[2 * j2 + 1] = (f32x4){f[4], f[5], f[6], f[7]}; }
        } else {
#pragma unroll
            for (int j = 0; j < 8; ++j) v[j] = *(const f32x4*)(xr + 4 * (F.lane + 64 * j)); }
        if (row >= ML && nparts > 0) {
            const float* pp = (const float*)(F.ws + WS_PART) + (size_t)(row - ML) * D; float* xo = (float*)(F.ws + WS_CTXH) + (size_t)(row - ML) * D;
#pragma unroll
            for (int j = 0; j < 8; ++j) { const int c = 4 * (F.lane + 64 * j); f32x4 a = {0.f, 0.f, 0.f, 0.f};
                for (int k = 0; k < nparts; ++k) a += *(const f32x4*)(pp + (size_t)k * MC * D + c);
                v[j] += *(const f32x4*)(cgate + c) * a; *(f32x4*)(xo + c) = v[j]; }
        }
#pragma unroll
        for (int j = 0; j < 8; ++j) ss += (v[j].x * v[j].x + v[j].y * v[j].y) + (v[j].z * v[j].z + v[j].w * v[j].w);
        const float rs = frsq(wave_sum(ss) * (1.f / D) + RMS_EPS);
#pragma unroll
        for (int j = 0; j < 8; ++j) { const int c = lat_bf ? 8 * (F.lane + 64 * (j >> 1)) + 4 * (j & 1) : 4 * (F.lane + 64 * j); const f32x4 g = *(const f32x4*)(gvec + c), a = *(const f32x4*)(sc + c), b = *(const f32x4*)(sh + c);
            const f32x4 o = v[j] * rs * g * (a + 1.0f) + b; u32x2 w; w.x = pk2(o.x, o.y); w.y = pk2(o.z, o.w); *(u32x2*)(XN + (size_t)row * D + c) = w; }
    }
}
DI void phase_final_norm(Frame& F, const CAS Inputs& IN_) {
    const int gw = F.vcu * 8 + F.wave, NGW = F.G * 8;
    const bf16_t* XB = (const bf16_t*)(F.ws + WS_XB);
    for (int row0 = gw; row0 < ML; row0 += 4 * NGW) {
        u32x4 w[4][4];
#pragma unroll
        for (int r = 0; r < 4; ++r) { const int row = row0 + r * NGW; const bool ok = row < ML;
#pragma unroll
            for (int j2 = 0; j2 < 4; ++j2) w[r][j2] = ok ? *(const u32x4*)(XB + (size_t)row * D + 8 * (F.lane + 64 * j2)) : (u32x4){0u, 0u, 0u, 0u}; }
#pragma unroll
        for (int r = 0; r < 4; ++r) { const int row = row0 + r * NGW; if (row >= ML) break;
            float* xr = F.out + (size_t)row * D; f32x4 v[8]; float ss = 0.f;
#pragma unroll
            for (int j2 = 0; j2 < 4; ++j2) { float f[8]; unpack8(w[r][j2], f); v[2 * j2] = (f32x4){f[0], f[1], f[2], f[3]}; v[2 * j2 + 1] = (f32x4){f[4], f[5], f[6], f[7]}; }
#pragma unroll
            for (int j = 0; j < 8; ++j) ss += (v[j].x * v[j].x + v[j].y * v[j].y) + (v[j].z * v[j].z + v[j].w * v[j].w);
            const float rs = frsq(wave_sum(ss) * (1.f / D) + RMS_EPS);
#pragma unroll
            for (int j = 0; j < 8; ++j) { const int c = 8 * (F.lane + 64 * (j >> 1)) + 4 * (j & 1); *(f32x4*)(xr + c) = v[j] * rs * *(const f32x4*)(IN_.final_norm + c); }
        }
    }
}

struct EpiU {
    static constexpr bool PERM = true;
    bf16_t* O; int ldc; int act;
    DI void operator()(const f32x4 (&acc)[2][2][4][2], const pg8::Unit& u, int wr, int wc, int fr, int fq) const {
        const int row0 = u.pm * 256 + wr * 64 + fr, col0 = u.pn * 256 + wc * 32 + 8 * fq;
        const bool special = act && (col0 + 128 + 8 > OFF_W) && (col0 < OFF_POOL);
#pragma unroll
        for (int ai = 0; ai < 2; ++ai)
#pragma unroll
            for (int m = 0; m < 4; ++m) { bf16_t* rowp = O + (size_t)(row0 + ai * 128 + m * 16) * ldc + col0;
#pragma unroll
                for (int bj = 0; bj < 2; ++bj) { f32x4 v0 = acc[ai][bj][m][0], v1 = acc[ai][bj][m][1];
                    if (special) { const int c = col0 + bj * 128;
                        if (c >= OFF_W && c < OFF_A) {
#pragma unroll
                            for (int e = 0; e < 4; ++e) { v0[e] = ftanh(v0[e]); v1[e] = ftanh(v1[e]); } }
                        else if (c >= OFF_G && c < OFF_POOL) {
#pragma unroll
                            for (int e = 0; e < 4; ++e) { v0[e] = fsigmoid(v0[e]); v1[e] = fsigmoid(v1[e]); } } }
                    u32x4 w; w.x = pk2(v0[0], v0[1]); w.y = pk2(v0[2], v0[3]); w.z = pk2(v1[0], v1[1]); w.w = pk2(v1[2], v1[3]);
                    *(u32x4*)(rowp + bj * 128) = w; } }
    }
};
struct EpiFold {
    static constexpr bool PERM = true;
    bf16_t* O;
    DI void operator()(const f32x4 (&acc)[2][2][4][2], const pg8::Unit& u, int wr, int wc, int fr, int fq) const {
        const int row0 = u.pm * 256 + wr * 64 + fr, col0 = u.pn * 256 + wc * 32 + 8 * fq; bf16_t* Ol = O + (size_t)u.ks * PG;
#pragma unroll
        for (int ai = 0; ai < 2; ++ai)
#pragma unroll
            for (int m = 0; m < 4; ++m)
#pragma unroll
                for (int bj = 0; bj < 2; ++bj) { const f32x4 v0 = acc[ai][bj][m][0], v1 = acc[ai][bj][m][1];
                    u32x4 w; w.x = pk2(v0[0], v0[1]); w.y = pk2(v0[2], v0[3]); w.z = pk2(v1[0], v1[1]); w.w = pk2(v1[2], v1[3]);
                    *(u32x4*)(Ol + (size_t)(row0 + ai * 128 + m * 16) * D + col0 + bj * 128) = w; }
    }
};
struct EpiPool {
    static constexpr bool PERM = true;
    bf16_t* O; const float* scale;
    DI void operator()(const f32x4 (&acc)[2][2][4][2], const pg8::Unit& u, int wr, int wc, int fr, int fq) const {
        const int row0 = u.pm * 256 + wr * 64 + fr, col0 = u.pn * 256 + wc * 32 + 8 * fq;
#pragma unroll
        for (int bj = 0; bj < 2; ++bj) { const f32x4 s0 = *(const f32x4*)(scale + col0 + bj * 128), s1 = *(const f32x4*)(scale + col0 + bj * 128 + 4);
#pragma unroll
            for (int ai = 0; ai < 2; ++ai)
#pragma unroll
                for (int m = 0; m < 4; ++m) { bf16_t* rowp = O + (size_t)(row0 + ai * 128 + m * 16) * D + RW + col0;
                    const f32x4 v0 = acc[ai][bj][m][0] * s0, v1 = acc[ai][bj][m][1] * s1;
                    u32x4 w; w.x = pk2(v0[0], v0[1]); w.y = pk2(v0[2], v0[3]); w.z = pk2(v1[0], v1[1]); w.w = pk2(v1[2], v1[3]);
                    *(u32x4*)(rowp + bj * 128) = w; }
            CFENCE(); }
    }
};
struct EpiSwiglu {
    static constexpr bool PERM = true;
    bf16_t* O;
    DI void operator()(const f32x4 (&acc)[2][2][4][2], const pg8::Unit& u, int wr, int wc, int fr, int fq) const {
        const int row0 = u.pm * 256 + wr * 64 + fr, col0 = u.pn * 128 + wc * 32 + 8 * fq;
#pragma unroll
        for (int ai = 0; ai < 2; ++ai)
#pragma unroll
            for (int m = 0; m < 4; ++m) { f32x4 v0, v1;
#pragma unroll
                for (int e = 0; e < 4; ++e) { v0[e] = fsilu(acc[ai][0][m][0][e]) * acc[ai][1][m][0][e]; v1[e] = fsilu(acc[ai][0][m][1][e]) * acc[ai][1][m][1][e]; }
                u32x4 w; w.x = pk2(v0[0], v0[1]); w.y = pk2(v0[2], v0[3]); w.z = pk2(v1[0], v1[1]); w.w = pk2(v1[2], v1[3]);
                *(u32x4*)(O + (size_t)(row0 + ai * 128 + m * 16) * DFF + col0) = w; }
    }
};
struct EpiRes {
    static constexpr bool PERM = false;
    const float* base_l; float* out_l; long long dbase_c, dout_c; const float* gate0;
    DI void operator()(const f32x4 (&acc)[2][2][4][2], const pg8::Unit& u, int wr, int wc, int fr, int fq) const {
        const bool lat = u.pm < NPM_L; const int prow = lat ? u.pm * 256 : (u.pm - NPM_L) * 256;
        const float* base = (const float*)((const char*)base_l + (lat ? 0ll : dbase_c)); float* out = (float*)((char*)out_l + (lat ? 0ll : dout_c));
        const float* gv = gate0 + (size_t)(lat ? (u.pm * 256) / SEQ : 2) * 6 * D;
        const int row0 = prow + wr * 64 + fr, col0 = u.pn * 256 + wc * 32 + 4 * fq;
        f32x4 g4[2][2];
#pragma unroll
        for (int bj = 0; bj < 2; ++bj)
#pragma unroll
            for (int n = 0; n < 2; ++n) g4[bj][n] = *(const f32x4*)(gv + col0 + bj * 128 + n * 16);
#pragma unroll
        for (int ai = 0; ai < 2; ++ai)
#pragma unroll
            for (int m = 0; m < 4; ++m) { const size_t off = (size_t)(row0 + ai * 128 + m * 16) * D + col0;
#pragma unroll
                for (int bj = 0; bj < 2; ++bj)
#pragma unroll
                    for (int n = 0; n < 2; ++n) { const f32x4 b = *(const f32x4*)(base + off + bj * 128 + n * 16); *(f32x4*)(out + off + bj * 128 + n * 16) = b + g4[bj][n] * acc[ai][bj][m][n]; }
                CFENCE(); }
    }
};

#if PROBE_T && !defined(EMU)
#define TSTAMP(k) do { if (tid == 0) { volatile LAS unsigned* M_ = (volatile LAS unsigned*)(F.lds + MISC_OFF); const unsigned long long n_ = __builtin_amdgcn_s_memtime(); \
    const unsigned long long p_ = ((unsigned long long)M_[31] << 32) | M_[30]; if ((k) >= 0) M_[32 + ((k) < 0 ? 0 : (k))] += (unsigned)((n_ - p_) >> 4); M_[30] = (unsigned)n_; M_[31] = (unsigned)(n_ >> 32); } } while (0)
#else
#define TSTAMP(k) do {} while (0)
#endif
struct EpiResB {
    static constexpr bool PERM = true;
    const void* base; int base_f32; bf16_t* out; const float* gate0;
    DI void operator()(const f32x4 (&acc)[2][2][4][2], const pg8::Unit& u, int wr, int wc, int fr, int fq) const {
        const float* gv = gate0 + (size_t)((u.pm * 256) / SEQ) * 6 * D;
        const int row0 = u.pm * 256 + wr * 64 + fr, col0 = u.pn * 256 + wc * 32 + 8 * fq;
#pragma unroll
        for (int bj = 0; bj < 2; ++bj) { const f32x4 g0 = *(const f32x4*)(gv + col0 + bj * 128), g1 = *(const f32x4*)(gv + col0 + bj * 128 + 4);
#pragma unroll
            for (int ai = 0; ai < 2; ++ai)
#pragma unroll
                for (int m = 0; m < 4; ++m) { const size_t off = (size_t)(row0 + ai * 128 + m * 16) * D + col0 + bj * 128; float b[8];
                    if (base_f32) { const f32x4 b0 = *(const f32x4*)((const float*)base + off), b1 = *(const f32x4*)((const float*)base + off + 4); b[0] = b0[0]; b[1] = b0[1]; b[2] = b0[2]; b[3] = b0[3]; b[4] = b1[0]; b[5] = b1[1]; b[6] = b1[2]; b[7] = b1[3]; }
                    else unpack8(*(const u32x4*)((const bf16_t*)base + off), b);
                    const f32x4 v0 = acc[ai][bj][m][0] * g0, v1 = acc[ai][bj][m][1] * g1;
                    float o[8] = {b[0] + v0[0], b[1] + v0[1], b[2] + v0[2], b[3] + v0[3], b[4] + v1[0], b[5] + v1[1], b[6] + v1[2], b[7] + v1[3]};
                    *(u32x4*)(out + off) = pack8(o); }
            CFENCE(); }
    }
};
struct EpiPart {
    static constexpr bool PERM = false;
    float* P;
    DI void operator()(const f32x4 (&acc)[2][2][4][2], const pg8::Unit& u, int wr, int wc, int fr, int fq) const {
        const int row0 = u.pm * 256 + wr * 64 + fr, col0 = u.pn * 256 + wc * 32 + 4 * fq; float* base = P + (size_t)u.ks * MC * D;
#pragma unroll
        for (int ai = 0; ai < 2; ++ai)
#pragma unroll
            for (int m = 0; m < 4; ++m) { float* rowp = base + (size_t)(row0 + ai * 128 + m * 16) * D + col0;
#pragma unroll
                for (int bj = 0; bj < 2; ++bj)
#pragma unroll
                    for (int n = 0; n < 2; ++n) *(f32x4*)(rowp + bj * 128 + n * 16) = acc[ai][bj][m][n]; }
    }
};
DI int img_off(int r, int c) { return r * 128 + ((((c >> 3) ^ (r & 7)) << 4) | ((c & 7) << 1)); }
DI bf16x8 ldfrag(const LAS unsigned char* img, int r0, int k0, int lane) { const int r = r0 + (lane & 15), c = k0 + 8 * (lane >> 4); return *(const LAS bf16x8*)(img + r * 128 + (((c >> 3) ^ (r & 7)) << 4)); }
template <int KK> DI f32x4 tile_mm(f32x4 acc, const LAS unsigned char* X, int x0, const LAS unsigned char* Y, int y0, int lane) {
#pragma unroll
    for (int ks = 0; ks < KK / 32; ++ks) { const bf16x8 xf = ldfrag(X, x0, 32 * ks, lane), yf = ldfrag(Y, y0, 32 * ks, lane); acc = MFMA16(xf, yf, acc); }
    return acc;
}
DI void st_tile(LAS unsigned char* img, int yrow, int xcol, const f32x4& v) { u32x2 w; w.x = pk2(v[0], v[1]); w.y = pk2(v[2], v[3]); *(LAS u32x2*)(img + img_off(yrow, xcol)) = w; }
DI bf16x4 pack4b(const f32x4& v) { u32x2 w; w.x = pk2(v[0], v[1]); w.y = pk2(v[2], v[3]); return __builtin_bit_cast(bf16x4, w); }
DI f32x4 ld_tile(const LAS unsigned char* img, int yrow, int xcol) { const u32x2 w = *(const LAS u32x2*)(img + img_off(yrow, xcol)); return (f32x4){bflo(w.x), bfhi(w.x), bflo(w.y), bfhi(w.y)}; }

struct ScanItem { int b, h, dir, seg; };
DI int item_index(const ScanItem& it) { return ((it.b * NH + it.h) * 2 + it.dir) * NSEG + it.seg; }
struct SegGeom { int seqlen, rowbase, pos0; };
DI SegGeom chunk_geom(const ScanItem& it, int gch) { SegGeom g; if (gch < CTX / 64) { g.seqlen = CTX; g.rowbase = ML + it.b * CTX; g.pos0 = 64 * gch; } else { g.seqlen = SEQ; g.rowbase = it.b * SEQ; g.pos0 = 64 * (gch - CTX / 64); } return g; }

struct ScanAF { bf16x8 af[4][3]; };
struct ScanWB { bf16x8 bfr[2][3]; float lb[2]; };
DI void scan_issue_af(const bf16_t* U, const ScanItem& it, const SegGeom& sg, const int mat, const int lane, ScanAF& A) {
    const int q = lane >> 4, l15 = lane & 15;
#pragma unroll
    for (int mt = 0; mt < 4; ++mt) { const int qq = sg.pos0 + 16 * mt + l15; const int tau = it.dir ? sg.seqlen - 1 - qq : qq;
        const bf16_t* ur = U + (size_t)(sg.rowbase + tau) * INWP + (mat ? OFF_A : OFF_W) + 8 * q;
#pragma unroll
        for (int ks = 0; ks < 3; ++ks) A.af[mt][ks] = *(const bf16x8*)(ur + 32 * ks); }
}
DI void scan_load_wb(const bf16_t* Wl, const float* bias, const ScanItem& it, const int nt0, const int lane, ScanWB& W) {
    const int q = lane >> 4, l15 = lane & 15;
#pragma unroll
    for (int n2 = 0; n2 < 2; ++n2) { const int chn = it.h * 64 + 16 * (nt0 + n2) + l15;
#pragma unroll
        for (int ks = 0; ks < 3; ++ks) W.bfr[n2][ks] = *(const bf16x8*)(Wl + (size_t)chn * LORA + 8 * q + 32 * ks);
        W.lb[n2] = bias[chn]; }
}
DI void scan_stage0(LAS unsigned char* L, LAS float* GCo, const ScanAF& A, const ScanWB& W, const int mat, const int nt0, const int lane) {
    const int q = lane >> 4, l15 = lane & 15;
#pragma unroll
    for (int n2 = 0; n2 < 2; ++n2) {
        f32x4 a4[4];
#pragma unroll
        for (int mt = 0; mt < 4; ++mt) { a4[mt] = (f32x4){0.f, 0.f, 0.f, 0.f};
#pragma unroll
            for (int ks = 0; ks < 3; ++ks) a4[mt] = MFMA16(A.af[mt][ks], W.bfr[n2][ks], a4[mt]); }
        const int cc = 16 * (nt0 + n2) + l15;
        if (mat == 0) {
            LAS float* G = (LAS float*)(L + SCR_G);
            float cs[4][4], t1[4], t2[4], t3[4];
#pragma unroll
            for (int mt = 0; mt < 4; ++mt) {
#pragma unroll
                for (int e = 0; e < 4; ++e) cs[mt][e] = -0.8750387749145276f * fsigmoid(W.lb[n2] + a4[mt][e]);
                cs[mt][1] += cs[mt][0]; cs[mt][2] += cs[mt][1]; cs[mt][3] += cs[mt][2];
                t1[mt] = BPERM(cs[mt][3], lane - 16); t2[mt] = BPERM(cs[mt][3], lane - 32); t3[mt] = BPERM(cs[mt][3], lane - 48); }
            float run = 0.f;
#pragma unroll
            for (int mt = 0; mt < 4; ++mt) { const float off = run + (q >= 1 ? t1[mt] : 0.f) + (q >= 2 ? t2[mt] : 0.f) + (q >= 3 ? t3[mt] : 0.f);
                const int p0 = 16 * mt + 4 * q;
#pragma unroll
                for (int e = 0; e < 4; ++e) G[(p0 + e) * 64 + cc] = off + cs[mt][e];
                run += (cs[mt][3] + t1[mt]) + (t2[mt] + t3[mt]); }
            if (q == 0) GCo[cc] = fexp2(run);
        } else {
            LAS float* AI = (LAS float*)(L + SCR_AI);
#pragma unroll
            for (int mt = 0; mt < 4; ++mt) { const int p0 = 16 * mt + 4 * q;
#pragma unroll
                for (int e = 0; e < 4; ++e) AI[(p0 + e) * 64 + cc] = fsigmoid(W.lb[n2] + a4[mt][e]); }
        }
    }
}
struct ScanPF { u32x2 w[3][6]; };
DI void scan_issue_uu(const bf16_t* U, const ScanItem& it, const SegGeom& sg, int tidp, ScanPF& pf) {
    const int pg = tidp >> 4, cg = tidp & 15; const int qq0 = sg.pos0 + 4 * pg - 1;
#pragma unroll
    for (int t = 0; t < 6; ++t) { const int qq = qq0 + t; const int tau = it.dir ? sg.seqlen - 1 - qq : qq;
        const bf16_t* up = U + (long long)(sg.rowbase + tau) * INWP + it.h * 64 + 4 * cg;
#pragma unroll
        for (int x = 0; x < 3; ++x) pf.w[x][t] = *(const u32x2*)(up + x * RW); }
}
#ifndef PAIR_K16
#define PAIR_K16 0
#endif
DI bf16x8 cat8(const bf16x4& a, const bf16x4& b) { return __builtin_shufflevector(a, b, 0, 1, 2, 3, 4, 5, 6, 7); }
DI f32x4 tile_xy(const bf16x8 (&xf)[2], const bf16x8 (&yf)[2]) { f32x4 a = {0.f, 0.f, 0.f, 0.f}; a = MFMA16(xf[0], yf[0], a); a = MFMA16(xf[1], yf[1], a); return a; }
DI f32x4 mm_pair(const bf16x4& a0, const bf16x4& a1, const bf16x4& b0, const bf16x4& b1, f32x4 c) {
#if PAIR_K16
    c = MFMA16K16(a0, b0, c); return MFMA16K16(a1, b1, c);
#else
    return MFMA16(cat8(a0, a1), cat8(b0, b1), c);
#endif
}
DI bf16x4 lo4(const bf16x8& v) { return __builtin_shufflevector(v, v, 0, 1, 2, 3); }
DI bf16x4 hi4(const bf16x8& v) { return __builtin_shufflevector(v, v, 4, 5, 6, 7); }
DI f32x4 mm_pair_a8(const bf16x8& a, const bf16x4& b0, const bf16x4& b1, f32x4 c) {
#if PAIR_K16
    c = MFMA16K16(lo4(a), b0, c); return MFMA16K16(hi4(a), b1, c);
#else
    return MFMA16(a, cat8(b0, b1), c);
#endif
}
DI f32x4 mm_pair_b8(const bf16x4& a0, const bf16x4& a1, const bf16x8& b, f32x4 c) {
#if PAIR_K16
    c = MFMA16K16(a0, lo4(b), c); return MFMA16K16(a1, hi4(b), c);
#else
    return MFMA16(cat8(a0, a1), b, c);
#endif
}
DI void scan_stage1(LAS unsigned char* L, LAS unsigned char* S, LAS unsigned char* SH, const ScanItem& it, const SegGeom& sg, const int tidp, const ScanPF& pf, float* BS) {
    const int pg = tidp >> 4, cg = tidp & 15, p0 = 4 * pg; const int qq0 = sg.pos0 + p0;
    const bool lo_ok = qq0 > 0, hi_ok = qq0 + 4 < sg.seqlen;
    const bool edge = (sg.pos0 == 0) || (sg.pos0 + 64 >= sg.seqlen);
    const int ccol = 4 * ((cg & 8) | ((cg & 3) << 1) | ((cg >> 2) & 1));
    const LAS float* PAR = (const LAS float*)(L + SC_PAR) + 4 * cg;
    const LAS float* G = (const LAS float*)(L + SCR_G) + 4 * cg; const LAS float* AI = (const LAS float*)(L + SCR_AI) + 4 * cg;
    f32x4 egp;
    { f32x4 gp = {0.f, 0.f, 0.f, 0.f}; if (p0 > 0) gp = *(const LAS f32x4*)(G + (p0 - 1) * 64);
#pragma unroll
      for (int e = 0; e < 4; ++e) egp[e] = fexp2(gp[e]); }
    f32x4 par[12];
#pragma unroll
    for (int i = 0; i < 12; ++i) par[i] = *(const LAS f32x4*)(PAR + i * 64);
    const f32x4 kkp = par[9], kap = par[10], rkp = par[11];
#pragma unroll
    for (int j = 0; j < 4; ++j) {
        const int p = p0 + j; const int qq = qq0 + j; const int tau = it.dir ? sg.seqlen - 1 - qq : qq; const size_t row = (size_t)(sg.rowbase + tau);
        float r4[4], k4[4], v4[4];
#pragma unroll
        for (int x = 0; x < 3; ++x) {
            float a[4], b[4], c[4];
            unpack4(pf.w[x][j], a); unpack4(pf.w[x][j + 1], b); unpack4(pf.w[x][j + 2], c);
            if (edge) {
                if (j == 0) {
#pragma unroll
                    for (int e = 0; e < 4; ++e) a[e] = lo_ok ? a[e] : 0.f; }
                if (j == 3) {
#pragma unroll
                    for (int e = 0; e < 4; ++e) c[e] = hi_ok ? c[e] : 0.f; } }
            const f32x4 w0 = par[3 * x + 0], w1 = par[3 * x + 1], w2 = par[3 * x + 2];
            float* dst = x == 0 ? r4 : (x == 1 ? k4 : v4);
#pragma unroll
            for (int e = 0; e < 4; ++e) dst[e] = a[e] * w0[e] + b[e] * w1[e] + c[e] * w2[e];
        }
        float kk4[4]; float nn = 0.f;
#pragma unroll
        for (int e = 0; e < 4; ++e) { kk4[e] = k4[e] * kkp[e]; nn += kk4[e] * kk4[e]; }
        nn = row16_sum(nn);
        const float inv = frsq(fmaxf(nn, 1e-24f));
        const f32x4 g4 = *(const LAS f32x4*)(G + p * 64), a4 = *(const LAS f32x4*)(AI + p * 64);
        float rt[4], at[4], kb[4], bb[4]; float bsum = 0.f;
#pragma unroll
        for (int e = 0; e < 4; ++e) { const float kkn = kk4[e] * inv; const float kd = k4[e] * (1.0f + (a4[e] - 1.0f) * kap[e]); const float bh = kkn * a4[e];
            const float eg = fexp2(g4[e]), eng = fexp2(-g4[e]);
            rt[e] = r4[e] * eg; at[e] = -kkn * egp[e]; kb[e] = kd * eng; bb[e] = bh * eng; bsum += r4[e] * kd * rkp[e]; egp[e] = eg; }
        *(LAS u32x2*)(S + M_RT * IMG + img_off(p, ccol)) = pack4(rt);
        *(LAS u32x2*)(S + M_AT * IMG + img_off(p, ccol)) = pack4(at);
        *(LAS u32x2*)(S + M_KB * IMG + img_off(p, ccol)) = pack4(kb);
        *(LAS u32x2*)(S + M_BB * IMG + img_off(p, ccol)) = pack4(bb);
        *(LAS u32x2*)(S + M_VT * IMG + img_off(p, 4 * cg)) = pack4(v4);
        bsum = row16_sum(bsum); if (cg == 0) BS[row * NH + it.h] = bsum;
    }
    LDS_WAIT();
    { const int w = RFL(tidp >> 6), lane = tidp & 63, q = lane >> 4, l15 = lane & 15;
      bf16x8 at8[2], rt8[2], kb8[2], bb8[2];
#pragma unroll
      for (int ks = 0; ks < 2; ++ks) { at8[ks] = ldfrag(S + M_AT * IMG, 16 * w, 32 * ks, lane); rt8[ks] = ldfrag(S + M_RT * IMG, 16 * w, 32 * ks, lane); kb8[ks] = ldfrag(S + M_KB * IMG, 16 * w, 32 * ks, lane); bb8[ks] = ldfrag(S + M_BB * IMG, 16 * w, 32 * ks, lane); }
      f32x4 s_a = tile_xy(bb8, at8), s_b = tile_xy(at8, bb8), tak = tile_xy(kb8, at8), trk = tile_xy(kb8, rt8), trb = tile_xy(bb8, rt8);
#pragma unroll
      for (int e = 0; e < 4; ++e) { const bool st = 4 * q + e < l15, in = 4 * q + e <= l15; s_a[e] = st ? s_a[e] : 0.f; s_b[e] = (l15 < 4 * q + e) ? s_b[e] : 0.f; tak[e] = st ? tak[e] : 0.f; trk[e] = in ? trk[e] : 0.f; trb[e] = in ? trb[e] : 0.f; }
      LAS unsigned char* o = SH + w * 512 + lane * 8;
      *(LAS bf16x4*)(o + 1 * 2048) = pack4b(tak); *(LAS bf16x4*)(o + 2 * 2048) = pack4b(trk); *(LAS bf16x4*)(o + 3 * 2048) = pack4b(trb);
      const bf16x4 pa = pack4b(s_a), pb = pack4b(s_b); const f32x4 z4 = {0.f, 0.f, 0.f, 0.f};
#pragma unroll
      for (int e = 0; e < 4; ++e) { const float id = (4 * q + e == l15) ? 1.f : 0.f; s_a[e] += id; s_b[e] += id; }
      const f32x4 a2b = MFMA16K16(pa, pb, z4), a2a = MFMA16K16(pb, pa, z4);
      const bf16x4 p2b = pack4b(a2b), p2a = pack4b(a2a);
      { const bf16x4 sa = pack4b(s_a); s_b = MFMA16K16(sa, p2b, s_b); s_a = MFMA16K16(p2b, sa, s_a); }
      const f32x4 a4b = MFMA16K16(p2a, p2b, z4), a4a = MFMA16K16(p2b, p2a, z4);
      const bf16x4 p4b = pack4b(a4b), p4a = pack4b(a4a);
      { const bf16x4 sa = pack4b(s_a); s_b = MFMA16K16(sa, p4b, s_b); s_a = MFMA16K16(p4b, sa, s_a); }
      const bf16x4 p8b = pack4b(MFMA16K16(p4a, p4b, z4));
      s_a = MFMA16K16(p8b, pack4b(s_a), s_a);
      *(LAS bf16x4*)o = pack4b(s_a); (void)s_b; }
}
DI int lane_of(int tid) { return tid & 63; }
DI void scan_item(Frame& F, const CAS Inputs& IN_, int l, const ScanItem it) {
    int tid_i = F.tid; OPAQUE_V(tid_i);
    const int wave_i = RFL(tid_i >> 6);
    LAS unsigned char* L = F.lds;
    const int ch0 = seg_start(it.seg), nchunks = seg_start(it.seg + 1) - ch0;
    const bf16_t* U = (const bf16_t*)(F.ws + WS_U);
    if (tid_i < 192) { const int kx = tid_i >> 4, c4 = tid_i & 15; const float* src;
        if (kx < 9) { const int tap = kx % 3; src = IN_.conv_rkv + (size_t)l * 9 * RW + (size_t)(it.dir ? 2 - tap : tap) * 3 * RW + (kx / 3) * RW + it.h * 64 + 4 * c4; }
        else src = (kx == 9 ? IN_.k_k : (kx == 10 ? IN_.k_a : IN_.r_k)) + (size_t)l * RW + it.h * 64 + 4 * c4;
        *(LAS f32x4*)(L + SC_PAR + (kx * 64 + 4 * c4) * 4) = *(const f32x4*)src; }
    if (wave_i >= 4) {
        const int mat = (wave_i >> 1) & 1, nt0 = 2 * (wave_i & 1);
        const bf16_t* Wl = wl_ptr(F, l, mat ? WL_IUP : WL_DUP) + (size_t)it.dir * RW * LORA;
        const float* lbias = (mat ? IN_.iclr_bias : IN_.decay_bias) + ((size_t)l * 2 + it.dir) * RW;
        float* BS = (float*)(F.ws + WS_BS) + (size_t)it.dir * MR * NH;
        ScanPF pf; ScanAF af; ScanWB wb;
        scan_load_wb(Wl, lbias, it, nt0, lane_of(tid_i), wb);
        { const SegGeom sg0 = chunk_geom(it, ch0); scan_issue_af(U, it, sg0, mat, lane_of(tid_i), af); }
#if SCAN_PRIO == 2 && !defined(EMU)
        __builtin_amdgcn_s_setprio(1);
#endif
        for (int k = 0; k <= nchunks; ++k) {
            int tid_o = F.tid; OPAQUE_V(tid_o);
            const int tidp = tid_o - 256, lane = tid_o & 63;
            const bool cur = k < nchunks, nxt = k + 1 < nchunks;
            const SegGeom sg = chunk_geom(it, ch0 + k);
            if (cur) { scan_issue_uu(U, it, sg, tidp, pf);
                scan_stage0(L, (LAS float*)(L + SC_GC) + 64 * (k & 1), af, wb, mat, nt0, lane); }
            LDS_WAIT(); WG_BAR();
            if (nxt) { const SegGeom sgn = chunk_geom(it, ch0 + k + 1); scan_issue_af(U, it, sgn, mat, lane, af); }
            if (cur) scan_stage1(L, L + (k & 1) * SET_BYTES, L + SC_SH + (k & 1) * 8192, it, sg, tidp, pf, BS);
            LDS_WAIT(); WG_BAR();
        }
#if SCAN_PRIO == 2 && !defined(EMU)
        __builtin_amdgcn_s_setprio(0);
#endif
        return;
    }
    const int lane_i = tid_i & 63;
    f32x4 H[2][4];
    const size_t st_off = (size_t)item_index(it) * 4096;
    { const int q = lane_i >> 4, l15 = lane_i & 15;
#pragma unroll
      for (int kt = 0; kt < 4; ++kt) { H[0][kt] = (f32x4){0.f, 0.f, 0.f, 0.f};
#pragma unroll
        for (int e = 0; e < 4; ++e) H[1][kt][e] = (16 * wave_i + l15 == 16 * kt + 4 * q + e) ? 1.f : 0.f; } }
    bf16_t* YO = (bf16_t*)(F.ws + WS_YF) + (size_t)it.dir * MR * RW;
    bf16_t* MCo = (bf16_t*)(F.ws + WS_XN) + (size_t)it.dir * MR * RW;
    LDS_WAIT(); WG_BAR();
    LDS_WAIT(); WG_BAR();
#if SCAN_PRIO == 1 && !defined(EMU)
    __builtin_amdgcn_s_setprio(1);
#endif
    for (int c = 0; c < nchunks; ++c) {
        const SegGeom sg = chunk_geom(it, ch0 + c);
        int tid_o = F.tid; OPAQUE_V(tid_o);
        const int lane = tid_o & 63, cb = RFL(tid_o >> 6), q = lane >> 4, l15 = lane & 15;
        const int qpos0 = sg.pos0;
        const LAS unsigned char* S = L + (c & 1) * SET_BYTES;
        const LAS unsigned char* SH = L + SC_SH + (c & 1) * 8192;
        bf16x4 vb[4], hb[2][4], ub[2][4];
        {
            bf16x8 at8[4][2], kb8[4][2], bb8[4][2]; bf16x4 aakf[10], aabf[6], df[4];
#pragma unroll
            for (int pt = 0; pt < 4; ++pt) vb[pt] = LDS_TR16(S + M_VT * IMG + img_off(16 * pt + 4 * q + (l15 >> 2), 16 * cb + 4 * (l15 & 3)));
#pragma unroll
            for (int i = 0; i < 4; ++i)
#pragma unroll
                for (int ks = 0; ks < 2; ++ks) { at8[i][ks] = ldfrag(S + M_AT * IMG, 16 * i, 32 * ks, lane); kb8[i][ks] = ldfrag(S + M_KB * IMG, 16 * i, 32 * ks, lane); bb8[i][ks] = ldfrag(S + M_BB * IMG, 16 * i, 32 * ks, lane); }
#pragma unroll
            for (int i = 0; i < 4; ++i) { aakf[(i * (i + 1)) / 2 + i] = *(const LAS bf16x4*)(SH + 1 * 2048 + i * 512 + lane * 8); df[i] = *(const LAS bf16x4*)(SH + i * 512 + lane * 8); }
#pragma unroll
            for (int b2 = 0; b2 < 2; ++b2)
#pragma unroll
                for (int kt = 0; kt < 4; ++kt) hb[b2][kt] = pack4b(H[b2][kt]);
            LDS_WAIT(); SCHED_BAR();
#pragma unroll
            for (int i = 1; i < 4; ++i)
#pragma unroll
                for (int jt = 0; jt < i; ++jt) { aakf[(i * (i + 1)) / 2 + jt] = pack4b(tile_xy(kb8[jt], at8[i])); aabf[(i * (i - 1)) / 2 + jt] = pack4b(tile_xy(bb8[jt], at8[i])); }
            SCHED_BAR();
#pragma unroll
            for (int i = 0; i < 4; ++i) {
#pragma unroll
                for (int b2 = 0; b2 < 2; ++b2) { f32x4 a = {0.f, 0.f, 0.f, 0.f}, t = {0.f, 0.f, 0.f, 0.f};
                    if (b2 == 0) {
#pragma unroll
                        for (int pt = 0; pt + 1 <= i; pt += 2) a = mm_pair(aakf[(i * (i + 1)) / 2 + pt], aakf[(i * (i + 1)) / 2 + pt + 1], vb[pt], vb[pt + 1], a);
                        if (!(i & 1)) t = MFMA16K16(aakf[(i * (i + 1)) / 2 + i], vb[i], t); }
#pragma unroll
                    for (int ks = 0; ks < 2; ++ks) a = mm_pair_a8(at8[i][ks], hb[b2][2 * ks], hb[b2][2 * ks + 1], a);
#pragma unroll
                    for (int j = 0; j + 1 < i; j += 2) a = mm_pair(aabf[(i * (i - 1)) / 2 + j], aabf[(i * (i - 1)) / 2 + j + 1], ub[b2][j], ub[b2][j + 1], a);
                    if (i & 1) t = MFMA16K16(aabf[(i * (i - 1)) / 2 + i - 1], ub[b2][i - 1], t);
                    if (b2 == 0 || (i & 1)) a = a + t;
                    const bf16x4 ab = pack4b(a);
                    const f32x4 u = MFMA16K16(df[i], ab, ((f32x4){0.f, 0.f, 0.f, 0.f}));
                    ub[b2][i] = pack4b(u); } }
        }
        LDS_WAIT(); WG_BAR();
        {
            bf16x8 rt8[4][2]; bf16x4 arkf[10], arbf[10];
            {
                bf16x8 kb8[4][2], bb8[4][2];
#pragma unroll
                for (int i = 0; i < 4; ++i)
#pragma unroll
                    for (int ks = 0; ks < 2; ++ks) { rt8[i][ks] = ldfrag(S + M_RT * IMG, 16 * i, 32 * ks, lane); kb8[i][ks] = ldfrag(S + M_KB * IMG, 16 * i, 32 * ks, lane); bb8[i][ks] = ldfrag(S + M_BB * IMG, 16 * i, 32 * ks, lane); }
#pragma unroll
                for (int i = 0; i < 4; ++i) { arkf[(i * (i + 1)) / 2 + i] = *(const LAS bf16x4*)(SH + 2 * 2048 + i * 512 + lane * 8); arbf[(i * (i + 1)) / 2 + i] = *(const LAS bf16x4*)(SH + 3 * 2048 + i * 512 + lane * 8); }
                LDS_WAIT(); SCHED_BAR();
#pragma unroll
                for (int i = 1; i < 4; ++i)
#pragma unroll
                    for (int jt = 0; jt < i; ++jt) { arkf[(i * (i + 1)) / 2 + jt] = pack4b(tile_xy(kb8[jt], rt8[i])); arbf[(i * (i + 1)) / 2 + jt] = pack4b(tile_xy(bb8[jt], rt8[i])); }
            }
            SCHED_BAR();
#pragma unroll
            for (int i = 0; i < 4; ++i) { const int qq = qpos0 + 16 * i + l15; const int tau = it.dir ? sg.seqlen - 1 - qq : qq; const size_t o = (size_t)(sg.rowbase + tau) * RW + it.h * 64 + 16 * cb + 4 * q;
#pragma unroll
                for (int b2 = 0; b2 < 2; ++b2) { f32x4 y = {0.f, 0.f, 0.f, 0.f}, t = {0.f, 0.f, 0.f, 0.f};
#pragma unroll
                    for (int ks = 0; ks < 2; ++ks) y = mm_pair_b8(hb[b2][2 * ks], hb[b2][2 * ks + 1], rt8[i][ks], y);
                    if (b2 == 0) {
#pragma unroll
                        for (int pt = 0; pt + 1 <= i; pt += 2) y = mm_pair(vb[pt], vb[pt + 1], arkf[(i * (i + 1)) / 2 + pt], arkf[(i * (i + 1)) / 2 + pt + 1], y);
                        if (!(i & 1)) t = MFMA16K16(vb[i], arkf[(i * (i + 1)) / 2 + i], t); }
#pragma unroll
                    for (int j = 0; j + 1 <= i; j += 2) y = mm_pair(ub[b2][j], ub[b2][j + 1], arbf[(i * (i + 1)) / 2 + j], arbf[(i * (i + 1)) / 2 + j + 1], y);
                    if (!(i & 1)) { t = MFMA16K16(ub[b2][i], arbf[(i * (i + 1)) / 2 + i], t); y = y + t; }
                    u32x2 w; w.x = pk2(y[0], y[1]); w.y = pk2(y[2], y[3]);
                    *(u32x2*)((b2 == 0 ? YO : MCo) + o) = w; } }
            SCHED_BAR();
        }
        {
            bf16x4 ktf[4][4], btf[4][4];
#pragma unroll
            for (int kt = 0; kt < 4; ++kt)
#pragma unroll
                for (int pt = 0; pt < 4; ++pt) { const int col = 32 * (kt >> 1) + 8 * (l15 & 3) + 4 * (kt & 1);
                    ktf[kt][pt] = LDS_TR16(S + M_KB * IMG + img_off(16 * pt + 4 * q + (l15 >> 2), col));
                    btf[kt][pt] = LDS_TR16(S + M_BB * IMG + img_off(16 * pt + 4 * q + (l15 >> 2), col)); }
            LDS_WAIT(); SCHED_BAR();
#pragma unroll
            for (int kt = 0; kt < 4; ++kt) { const f32x4 gc = *(const LAS f32x4*)(L + SC_GC + (64 * (c & 1) + 16 * kt + 4 * q) * 4);
#pragma unroll
                for (int b2 = 0; b2 < 2; ++b2) { f32x4 a = H[b2][kt];
                    if (b2 == 0) {
#pragma unroll
                        for (int pp = 0; pp < 2; ++pp) a = mm_pair(ktf[kt][2 * pp], ktf[kt][2 * pp + 1], vb[2 * pp], vb[2 * pp + 1], a); }
#pragma unroll
                    for (int pp = 0; pp < 2; ++pp) a = mm_pair(btf[kt][2 * pp], btf[kt][2 * pp + 1], ub[b2][2 * pp], ub[b2][2 * pp + 1], a);
                    H[b2][kt] = a * gc; } }
        }
        LDS_WAIT(); WG_BAR();
    }
#if SCAN_PRIO == 1 && !defined(EMU)
    __builtin_amdgcn_s_setprio(0);
#endif
    { const int q = lane_i >> 4, l15 = lane_i & 15; const int v = 16 * wave_i + l15;
#pragma unroll
      for (int kt = 0; kt < 4; ++kt) { const int k = 16 * kt + 4 * q;
          *(f32x4*)((float*)(F.ws + WS_SSEG) + st_off + (size_t)v * 64 + k) = H[0][kt]; *(f32x4*)((float*)(F.ws + WS_PSEG) + st_off + (size_t)v * 64 + k) = H[1][kt]; }
    }
}
DI bool scan_item_of(int idx, ScanItem& it) {
    constexpr int NCHN = NB * NH * 2; if (idx >= NCHN * NSEG) return false;
    const int chain = idx % NCHN; it.seg = idx / NCHN; it.dir = chain & 1; it.h = (chain >> 1) % NH; it.b = (chain >> 1) / NH; return true;
}
DI void phase_chain(Frame& F) {
    LAS float* Sm = (LAS float*)F.lds; LAS float* Pm = Sm + 64 * 65;
    const int v = F.tid >> 3, kg = F.tid & 7;
    for (int ci = F.vcu; ci < NB * NH * 2; ci += F.G) {
        const size_t base = (size_t)ci * NSEG * 4096;
        float s8[8];
#pragma unroll
        for (int j = 0; j < 8; ++j) s8[j] = 0.f;
        for (int seg = 0; seg < NSEG; ++seg) {
            float* hin = (float*)(F.ws + WS_HIN) + base + (size_t)seg * 4096 + v * 64 + 8 * kg;
            *(f32x4*)hin = (f32x4){s8[0], s8[1], s8[2], s8[3]}; *(f32x4*)(hin + 4) = (f32x4){s8[4], s8[5], s8[6], s8[7]};
            if (seg == NSEG - 1) break;
            const float* pp = (const float*)(F.ws + WS_PSEG) + base + (size_t)seg * 4096 + v * 64 + 8 * kg;
            const float* sp = (const float*)(F.ws + WS_SSEG) + base + (size_t)seg * 4096 + v * 64 + 8 * kg;
            WG_BAR();
#pragma unroll
            for (int j = 0; j < 8; ++j) { Sm[v * 65 + 8 * kg + j] = s8[j]; Pm[v * 64 + 8 * kg + j] = pp[j]; }
            float o8[8];
#pragma unroll
            for (int j = 0; j < 8; ++j) o8[j] = sp[j];
            LDS_WAIT(); WG_BAR();
            for (int j = 0; j < 64; ++j) { const float sv = Sm[v * 65 + j]; const f32x4 p0 = *(const LAS f32x4*)(Pm + j * 64 + 8 * kg), p1 = *(const LAS f32x4*)(Pm + j * 64 + 8 * kg + 4);
                o8[0] += sv * p0[0]; o8[1] += sv * p0[1]; o8[2] += sv * p0[2]; o8[3] += sv * p0[3]; o8[4] += sv * p1[0]; o8[5] += sv * p1[1]; o8[6] += sv * p1[2]; o8[7] += sv * p1[3]; }
#pragma unroll
            for (int j = 0; j < 8; ++j) s8[j] = o8[j];
        }
        WG_BAR();
    }
}

DI void ld8(const bf16_t* p, float (&f)[8]) { unpack8(*(const u32x4*)p, f); }
constexpr int PBAND = GROWS < 32 ? GROWS : 32;
DI void phase_poolv(Frame& F, int start, int stride) {
    const bf16_t* U = (const bf16_t*)(F.ws + WS_U); bf16_t* VS = (bf16_t*)(F.ws + WS_VS);
    constexpr int NBAND = GROWS / PBAND;
    for (int i = start; i < NB * NBAND * GW * 128; i += stride) { const int ck = i & 127, x = (i >> 7) % GW, band = ((i >> 7) / GW) % NBAND, b = (i >> 7) / (GW * NBAND); const int half = 1 << (ck >> 5);
        const bf16_t* ub = U + ((size_t)b * SEQ + x) * INWP + OFF_POOL + 8 * ck; bf16_t* vb = VS + ((size_t)b * SEQ + x) * PWD + 8 * ck;
        const int y0 = band * PBAND; float s[8], f[8];
#pragma unroll
        for (int j = 0; j < 8; ++j) s[j] = 0.f;
        for (int yy = (y0 - half < 0 ? 0 : y0 - half); yy < (y0 + half > GROWS ? GROWS : y0 + half); ++yy) { ld8(ub + (size_t)yy * GW * INWP, f);
#pragma unroll
            for (int j = 0; j < 8; ++j) s[j] += f[j]; }
#pragma unroll 4
        for (int y = y0; y < y0 + PBAND; ++y) { *(u32x4*)(vb + (size_t)y * GW * PWD) = pack8(s);
            if (y + half < GROWS) { ld8(ub + (size_t)(y + half) * GW * INWP, f);
#pragma unroll
                for (int j = 0; j < 8; ++j) s[j] += f[j]; }
            if (y - half >= 0) { ld8(ub + (size_t)(y - half) * GW * INWP, f);
#pragma unroll
                for (int j = 0; j < 8; ++j) s[j] -= f[j]; } }
    }
}
constexpr int PCB = 4;
DI void phase_poolh(Frame& F, int start, int stride, const bool with_ctx) {
    const bf16_t* U = (const bf16_t*)(F.ws + WS_U); const bf16_t* VS = (const bf16_t*)(F.ws + WS_VS); bf16_t* PD = (bf16_t*)(F.ws + WS_MIX) + RW;
    constexpr int NLAT = NB * GROWS * 2 * 128, NCTXI = NB * (CTX / PCB) * 128;
    for (int i = start; i < NLAT + (with_ctx ? NCTXI : 0); i += stride) {
        float s[8], f[8], c8[8];
#pragma unroll
        for (int j = 0; j < 8; ++j) s[j] = 0.f;
        if (i < NLAT) { const int ck = i & 127, xh = (i >> 7) & 1, gy = (i >> 8) % GROWS, b = (i >> 8) / GROWS; const int half = 1 << (ck >> 5);
            const size_t rowb = (size_t)b * SEQ + (size_t)gy * GW; const bf16_t* vs = VS + rowb * PWD + 8 * ck; const bf16_t* uc = U + rowb * INWP + OFF_POOL + 8 * ck; bf16_t* pd = PD + rowb * D + 8 * ck;
            const int ylo = gy - half < 0 ? 0 : gy - half, yhi = gy + half > GROWS ? GROWS : gy + half; const float ny = (float)(yhi - ylo);
            const int x0 = xh * 32;
            for (int xx = (x0 - half < 0 ? 0 : x0 - half); xx < (x0 + half > GW ? GW : x0 + half); ++xx) { ld8(vs + (size_t)xx * PWD, f);
#pragma unroll
                for (int j = 0; j < 8; ++j) s[j] += f[j]; }
#pragma unroll 4
            for (int x = x0; x < x0 + 32; ++x) { const int xlo = x - half < 0 ? 0 : x - half, xhi = x + half > GW ? GW : x + half; const float ic = 1.0f / (ny * (float)(xhi - xlo));
                ld8(uc + (size_t)x * INWP, c8); float o[8];
#pragma unroll
                for (int j = 0; j < 8; ++j) o[j] = s[j] * ic - c8[j];
                *(u32x4*)(pd + (size_t)x * D) = pack8(o);
                if (x + half < GW) { ld8(vs + (size_t)(x + half) * PWD, f);
#pragma unroll
                    for (int j = 0; j < 8; ++j) s[j] += f[j]; }
                if (x - half >= 0) { ld8(vs + (size_t)(x - half) * PWD, f);
#pragma unroll
                    for (int j = 0; j < 8; ++j) s[j] -= f[j]; } }
        } else { const int i2 = i - NLAT; const int ck = i2 & 127, band = (i2 >> 7) % (CTX / PCB), b = (i2 >> 7) / (CTX / PCB); const int half = 1 << (ck >> 5);
            const size_t rowb = (size_t)ML + (size_t)b * CTX; const bf16_t* uc = U + rowb * INWP + OFF_POOL + 8 * ck; bf16_t* pd = PD + rowb * D + 8 * ck;
            const int t0 = band * PCB;
            for (int tt = (t0 - half < 0 ? 0 : t0 - half); tt < (t0 + half > CTX ? CTX : t0 + half); ++tt) { ld8(uc + (size_t)tt * INWP, f);
#pragma unroll
                for (int j = 0; j < 8; ++j) s[j] += f[j]; }
#pragma unroll 4
            for (int t = t0; t < t0 + PCB; ++t) { const int lo = t - half < 0 ? 0 : t - half, hi = t + half > CTX ? CTX : t + half; const float ic = 1.0f / (float)(hi - lo);
                ld8(uc + (size_t)t * INWP, c8); float o[8];
#pragma unroll
                for (int j = 0; j < 8; ++j) o[j] = s[j] * ic - c8[j];
                *(u32x4*)(pd + (size_t)t * D) = pack8(o);
                if (t + half < CTX) { ld8(uc + (size_t)(t + half) * INWP, f);
#pragma unroll
                    for (int j = 0; j < 8; ++j) s[j] += f[j]; }
                if (t - half >= 0) { ld8(uc + (size_t)(t - half) * INWP, f);
#pragma unroll
                    for (int j = 0; j < 8; ++j) s[j] -= f[j]; } }
        }
    }
}

template <int MT> DI void finish_item(Frame& F, const CAS Inputs& IN_, const int l, const int row0, const int h) {
    const bf16_t* U = (const bf16_t*)(F.ws + WS_U); const bf16_t* Gt = (const bf16_t*)(F.ws + WS_G); bf16_t* MIX = (bf16_t*)(F.ws + WS_MIX);
    const bf16_t* YL = (const bf16_t*)(F.ws + WS_YF); const bf16_t* MCb = (const bf16_t*)(F.ws + WS_XN);
    const float* BS0 = (const float*)(F.ws + WS_BS); const float* BS1 = BS0 + (size_t)MR * NH;
    const float* cw = IN_.conv_rkv + (size_t)l * 9 * RW + 2 * RW;
    const int lane = F.lane, q = lane >> 4, l15 = lane & 15;
    const bool lat = row0 < ML;
    f32x4 acc[MT][4];
#pragma unroll
    for (int mt = 0; mt < MT; ++mt)
#pragma unroll
        for (int j = 0; j < 2; ++j) { const size_t o = (size_t)(row0 + 16 * mt + l15) * RW + h * 64 + 32 * j + 8 * q; float a[8], b[8];
            unpack8(*(const u32x4*)(YL + o), a); unpack8(*(const u32x4*)(YL + (size_t)MR * RW + o), b);
            acc[mt][2 * j] = (f32x4){a[0] + b[0], a[1] + b[1], a[2] + b[2], a[3] + b[3]}; acc[mt][2 * j + 1] = (f32x4){a[4] + b[4], a[5] + b[5], a[6] + b[6], a[7] + b[7]}; }
    {
        const int r64 = row0 & ~63; const int bb = lat ? r64 / SEQ : (r64 - ML) / CTX, t0 = lat ? r64 % SEQ : (r64 - ML) % CTX;
#pragma unroll
        for (int dir = 0; dir < 2; ++dir) {
            const int gch = lat ? CTX / 64 + (dir ? (SEQ - 64 - t0) / 64 : t0 / 64) : (dir ? (CTX - 64 - t0) / 64 : t0 / 64);
            int seg = 0; for (int sx = 1; sx < NSEG; ++sx) seg = (seg_start(sx) <= gch) ? sx : seg;
            if (seg == 0) continue;
            const float* Hin = (const float*)(F.ws + WS_HIN) + (size_t)((((bb * NH + h) * 2 + dir) * NSEG) + seg) * 4096;
            const bf16_t* Mc = MCb + (size_t)dir * MR * RW + (size_t)row0 * RW + h * 64;
            bf16x8 hf[4][2];
#pragma unroll
            for (int vt = 0; vt < 4; ++vt)
#pragma unroll
                for (int ks = 0; ks < 2; ++ks) { const int v = 32 * (vt >> 1) + 8 * (l15 >> 2) + 4 * (vt & 1) + (l15 & 3);
                    const float* hp = Hin + (size_t)v * 64 + 32 * ks + 8 * q; const f32x4 x0 = *(const f32x4*)hp, x1 = *(const f32x4*)(hp + 4);
                    u32x4 w; w.x = pk2(x0[0], x0[1]); w.y = pk2(x0[2], x0[3]); w.z = pk2(x1[0], x1[1]); w.w = pk2(x1[2], x1[3]); hf[vt][ks] = __builtin_bit_cast(bf16x8, w); }
#pragma unroll
            for (int mt = 0; mt < MT; ++mt) { bf16x8 mf[2];
#pragma unroll
                for (int ks = 0; ks < 2; ++ks) mf[ks] = *(const bf16x8*)(Mc + (size_t)(16 * mt + l15) * RW + 32 * ks + 8 * q);
#pragma unroll
                for (int vt = 0; vt < 4; ++vt) { acc[mt][vt] = MFMA16(hf[vt][0], mf[0], acc[mt][vt]); acc[mt][vt] = MFMA16(hf[vt][1], mf[1], acc[mt][vt]); } }
        }
    }
#pragma unroll
    for (int mt = 0; mt < MT; ++mt) { const int row = row0 + 16 * mt + l15;
        int tau, len; if (row < ML) { tau = row % SEQ; len = SEQ; } else { tau = (row - ML) % CTX; len = CTX; }
        float sm = 0.f;
#pragma unroll
        for (int vt = 0; vt < 4; ++vt) sm += (acc[mt][vt][0] + acc[mt][vt][1]) + (acc[mt][vt][2] + acc[mt][vt][3]);
        sm += __shfl_xor(sm, 16); sm += __shfl_xor(sm, 32);
        const float mu = sm * (1.f / 64.f); float vq = 0.f;
#pragma unroll
        for (int vt = 0; vt < 4; ++vt)
#pragma unroll
            for (int e = 0; e < 4; ++e) { const float d = acc[mt][vt][e] - mu; acc[mt][vt][e] = d; vq += d * d; }
        vq += __shfl_xor(vq, 16); vq += __shfl_xor(vq, 32);
        const float rstd = frsq(vq * (1.f / 64.f) + GN_EPS);
        const float bsum = BS0[(size_t)row * NH + h] + BS1[(size_t)row * NH + h];
        const bool hasm = tau > 0, hasp = tau < len - 1;
#pragma unroll
        for (int j = 0; j < 2; ++j) { const int ch = h * 64 + 32 * j + 8 * q;
            const bf16_t* up = U + (size_t)row * INWP + OFF_V + ch; float cen[8], lo[8], hi[8], g8[8];
            unpack8(*(const u32x4*)up, cen); unpack8(*(const u32x4*)(up - INWP), lo); unpack8(*(const u32x4*)(up + INWP), hi);
            unpack8(*(const u32x4*)(Gt + (size_t)row * RW + ch), g8);
            float o[8];
#pragma unroll
            for (int hh = 0; hh < 2; ++hh) { const int c4 = ch + 4 * hh;
                const f32x4 w0 = *(const f32x4*)(cw + c4), w1 = *(const f32x4*)(cw + 3 * RW + c4), w2 = *(const f32x4*)(cw + 6 * RW + c4);
                const f32x4 gw4 = *(const f32x4*)(IN_.gn_w + (size_t)l * RW + c4), gb4 = *(const f32x4*)(IN_.gn_b + (size_t)l * RW + c4);
#pragma unroll
                for (int e = 0; e < 4; ++e) { const float v = (hasm ? lo[4 * hh + e] : 0.f) * w0[e] + cen[4 * hh + e] * w1[e] + (hasp ? hi[4 * hh + e] : 0.f) * w2[e];
                    o[4 * hh + e] = (acc[mt][2 * j + hh][e] * rstd * gw4[e] + gb4[e] + bsum * v) * g8[4 * hh + e]; } }
            *(u32x4*)(MIX + (size_t)row * D + ch) = pack8(o); }
    }
}
DI void phase_finish(Frame& F, const CAS Inputs& IN_, int l, int nrows) {
    const int gw = F.vcu * 8 + F.wave, NGW = F.G * 8;
    for (int itx = gw; itx < (ML / 64) * NH; itx += NGW) finish_item<4>(F, IN_, l, (itx / NH) * 64, itx % NH);
    for (int itx = gw; itx < ((nrows - ML) / 16) * NH; itx += NGW) finish_item<1>(F, IN_, l, ML + (itx / NH) * 16, itx % NH);
}

constexpr int PH_P0 = 0, PH_P0B = 1, PH_L0 = 2, PH_PER_LAYER = 11, PH_FINAL = PH_L0 + PH_PER_LAYER * DEPTH, NPHASES = PH_FINAL + 1;
#define IN(k) (lo <= (k) && (k) < hi)
#define REP(k) for (int rep_ = 0; rep_ < (((PROBE_MASK) >> (k)) & 1) + 1; ++rep_)
#define PHASE_BEGIN() const CAS Args* AP = kargs; OPAQUE_S(AP); do { F.ws = AP->ws; F.out = AP->out; F.wave = wave_id; OPAQUE_S(F.wave); F.lane = LANE_ID(); OPAQUE_V(F.lane); F.tid = F.wave * 64 + F.lane; } while (0)
#ifdef EMU
#define SEAM(k) do { if (IN(k) && IN((k) + 1)) xcd_barrier(bar); } while (0)
#else
#define SEAM(k) do { if (IN(k) && IN((k) + 1)) { XcdBarrier bb_ = bar; { const CAS Args* ap_ = kargs; OPAQUE_S(ap_); bb_.bar = (unsigned*)(ap_->ws + WS_CTL) + CW_BAR; } OPAQUE_S(bb_.bar); xcd_barrier(bb_, (lane_id_volatile() == 0) && (wave_id == 0)); } } while (0)
#endif
template <int l> DI void run_layer(Frame F, const CAS Args* const kargs, const int lo, const int hi, const XcdBarrier bar, const int wave_id) {

        const int pb = PH_L0 + PH_PER_LAYER * l; const bool last = (l == DEPTH - 1);
        const int npm = last ? NPM_L : NPM;
        if (IN(pb + 0)) REP(0) { PHASE_BEGIN(); phase_norm(F, AP->in, l, false, MR, l > 0 ? NPART_DN : 0, (const float*)(F.ws + WS_CTXH), mod_ptr(F, l > 0 ? l - 1 : 0, 2, 5)); }
        SEAM(pb + 0);
        if (IN(pb + 1)) REP(1) { PHASE_BEGIN(); const int nc = (l + 1 < DEPTH) ? conv_in(F.G) : 0; const int c = (int)blockIdx.x;
            if (c >= F.G - nc) { const int w = (c - (F.G - nc)) * 8 + F.wave, NW = nc * 8;
                p0_convert_span(F, AP->in, l + 1, 0, P0_I_WIN, w, NW); p0_convert_span(F, AP->in, l + 1, P0_R_WOUT1, P0_R_A1, w, NW); }
            else { pg8::Gemm g{(const bf16_t*)(F.ws + WS_XN), wl_ptr(F, l, WL_WIN), D, D, D, 0}; pg8::StaticOrder S; S.init(NPM, INWP / 256, F.G - nc, c);
                EpiU E{(bf16_t*)(F.ws + WS_U), INWP, 1}; pg8::gemm_phase<EpiU, pg8::StaticOrder, true, true>(F.lds, g, S, E, F.tid); } }
        SEAM(pb + 1);
        if (IN(pb + 2)) REP(2) { PHASE_BEGIN(); ScanItem it; for (int i = F.vcu; scan_item_of(i, it); i += F.G) scan_item(F, AP->in, l, it); }
        SEAM(pb + 2);
        if (IN(pb + 3)) REP(3) { PHASE_BEGIN(); constexpr int NCH = NB * NH * 2;
            if (F.G <= NCH) phase_chain(F);
            phase_poolv(F, F.vcu * 512 + F.tid, F.G * 512); }
        SEAM(pb + 3);
        if (IN(pb + 4)) REP(4) { PHASE_BEGIN(); phase_poolh(F, F.vcu * 512 + F.tid, F.G * 512, !last); }
        if (IN(pb + 5)) REP(5) { PHASE_BEGIN();
            { constexpr int NCH = NB * NH * 2; const bool split = F.G > NCH;
              if (split && F.vcu < NCH) { phase_chain(F); WG_BAR(); }
              else { pg8::Gemm g{(const bf16_t*)(F.ws + WS_U) + OFF_G, wl_ptr(F, l, WL_GUP), INWP, GL, GL, 0}; pg8::StaticOrder S; S.init(npm, RW / 256, split ? F.G - NCH : F.G, split ? F.vcu - NCH : (int)blockIdx.x);
                EpiU E{(bf16_t*)(F.ws + WS_G), RW, 0}; pg8::gemm_phase<EpiU, pg8::StaticOrder, false, false>(F.lds, g, S, E, F.tid); } }
        }
        SEAM(pb + 5);
        if (IN(pb + 6)) REP(6) { PHASE_BEGIN(); phase_finish(F, AP->in, l, npm * 256); }
        SEAM(pb + 6);
        if (IN(pb + 7)) { PHASE_BEGIN();
            if (!last) {
                pg8::Gemm g{(const bf16_t*)(F.ws + WS_MIX) + (size_t)ML * D, wl_ptr(F, l, WL_WOUT), D, D, KSPLIT, 0}; pg8::SplitKOrder S; S.init(MC / 256, D / 256, NPART_WO, F.G, (int)blockIdx.x);
                EpiPart E{(float*)(F.ws + WS_PART)};
                pg8::gemm_phase<EpiPart, pg8::SplitKOrder, true, true>(F.lds, g, S, E, F.tid); }
            { pg8::Gemm g{(const bf16_t*)(F.ws + WS_MIX), wl_ptr(F, l, WL_WOUT), D, D, D, 0}; pg8::StaticOrder S; S.init(NPM_L, D / 256, F.G, (int)blockIdx.x);
              EpiResB E{l == 0 ? (const void*)AP->in.x : (const void*)(F.ws + WS_XB), l == 0 ? 1 : 0, (bf16_t*)(F.ws + WS_XB), mod_ptr(F, l, 0, 2)};
              pg8::gemm_phase<EpiResB, pg8::StaticOrder, true, true>(F.lds, g, S, E, F.tid); }
        }
        SEAM(pb + 7);
        if (IN(pb + 8)) REP(8) { PHASE_BEGIN(); phase_norm(F, AP->in, l, true, npm * 256, last ? 0 : NPART_WO, l == 0 ? AP->in.ctx : (const float*)(F.ws + WS_CTXH), mod_ptr(F, l, 2, 2)); }
        SEAM(pb + 8);
        if (IN(pb + 9)) REP(9) { PHASE_BEGIN(); const int nc = (l + 1 < DEPTH) ? conv_up(F.G) : 0; const int c = (int)blockIdx.x; const int Gp = F.G - nc;
            const int nunits = npm * (2 * DFF / 256), nfull = (nunits / Gp) * Gp; const int lim = (nc > 0 && nunits - nfull <= 4 * nc) ? nfull : nunits;
            pg8::Gemm g{(const bf16_t*)(F.ws + WS_XN), wl_ptr(F, l, WL_WGU), D, D, D, 0}; EpiSwiglu E{(bf16_t*)(F.ws + WS_H)}; pg8::StaticOrder S;
            if (c >= Gp) { const int ci = c - Gp; const int w = ci * 8 + F.wave, NW = nc * 8;
                p0_convert_span(F, AP->in, l + 1, P0_R_A1, P0_I_T, w, NW); WG_BAR();
                S.init(npm, 2 * DFF / 256, nc, ci); S.range(lim, nunits); }
            else { S.init(npm, 2 * DFF / 256, Gp, c); S.range(0, lim); }
            pg8::gemm_phase<EpiSwiglu, pg8::StaticOrder, true, true>(F.lds, g, S, E, F.tid); }
        SEAM(pb + 9);
        if (IN(pb + 10)) { PHASE_BEGIN();
            if (!last) {
                pg8::Gemm g{(const bf16_t*)(F.ws + WS_H) + (size_t)ML * DFF, wl_ptr(F, l, WL_WDN), DFF, DFF, KSPLIT, 0}; pg8::SplitKOrder S; S.init(MC / 256, D / 256, NPART_DN, F.G, (int)blockIdx.x);
                EpiPart E{(float*)(F.ws + WS_PART)};
                pg8::gemm_phase<EpiPart, pg8::SplitKOrder, true, true>(F.lds, g, S, E, F.tid); }
            { pg8::Gemm g{(const bf16_t*)(F.ws + WS_H), wl_ptr(F, l, WL_WDN), DFF, DFF, DFF, 0}; pg8::StaticOrder S; S.init(NPM_L, D / 256, F.G, (int)blockIdx.x);
              EpiResB E{(const void*)(F.ws + WS_XB), 0, (bf16_t*)(F.ws + WS_XB), mod_ptr(F, l, 0, 5)};
              pg8::gemm_phase<EpiResB, pg8::StaticOrder, true, true>(F.lds, g, S, E, F.tid); }
        }
        SEAM(pb + 10);
    }
__global__ void __launch_bounds__(512, 2) fwd_kernel(Args args) {
#ifdef EMU
    unsigned char* lds = emu_blk->lds;
#else
    extern __shared__ __attribute__((aligned(16))) unsigned char lds[];
#endif
    Frame F;
    F.lds = (LAS unsigned char*)lds;
    F.tid = threadIdx.x; F.lane = F.tid & 63; F.wave = RFL(F.tid >> 6);
    const int wave_id = F.wave;
    F.G = gridDim.x; { const int bx = blockIdx.x; F.vcu = (F.G % 8 == 0) ? (bx % 8) * (F.G / 8) + bx / 8 : bx; }
#ifdef EMU
    const Args* const kargs = &args;
#else
    const CAS Args* const kargs = (const CAS Args*)__builtin_amdgcn_kernarg_segment_ptr();
#endif
    F.out = kargs->out; F.ws = kargs->ws;
    const int lo = args.ph_lo, hi = args.ph_hi;
#ifndef EMU
    volatile LAS unsigned* MISC = (volatile LAS unsigned*)(F.lds + MISC_OFF);
    if (F.tid < 128) MISC[F.tid] = 0u;
    __syncthreads();
    XcdBarrier bar; bar.bar = (unsigned*)(F.ws + WS_CTL) + CW_BAR; bar.x = 0; bar.st = nullptr;
    if (hi - lo > 1) bar = xcd_barrier_post((unsigned*)(F.ws + WS_CTL) + CW_BAR, MISC + 8);
#else
    XcdBarrier bar; bar.bar = nullptr;
#endif
    if (IN(PH_P0)) REP(11) { PHASE_BEGIN(); phase_p0(F, AP->in); }
    SEAM(PH_P0);
    if (IN(PH_P0B)) { PHASE_BEGIN(); phase_p0b(F, AP->in);
        { static_assert(WL_SIZE % (2 * PG) == 0, "layer stride"); WG_BAR();
          pg8::Gemm g{wl_ptr(F, 0, WL_WOUT) + RW, wl_ptr(F, 0, WL_POOL), D, PG, PG, 256}; pg8::FoldOrder S; S.init(DEPTH, (int)(WL_SIZE / (2 * PG)), F.G, (int)blockIdx.x);
          EpiFold E{wl_ptr(F, 0, WL_WOUT) + RW}; pg8::gemm_phase<EpiFold, pg8::FoldOrder, true, true>(F.lds, g, S, E, F.tid); } }
    SEAM(PH_P0B);
    run_layer<0>(F, kargs, lo, hi, bar, wave_id);
    if constexpr (DEPTH > 1) run_layer<1>(F, kargs, lo, hi, bar, wave_id);
    if constexpr (DEPTH > 2) run_layer<2>(F, kargs, lo, hi, bar, wave_id);
    if constexpr (DEPTH > 3) run_layer<3>(F, kargs, lo, hi, bar, wave_id);
    static_assert(DEPTH <= 4, "layers");
    if (IN(PH_FINAL)) { PHASE_BEGIN(); phase_final_norm(F, AP->in);
#if PROBE_T && !defined(EMU)
        __syncthreads(); if (blockIdx.x == 0 && F.tid == 0) { volatile LAS unsigned* M_ = (volatile LAS unsigned*)(F.lds + MISC_OFF); F.out[0] = (float)M_[32 + PROBE_TA] * (16.0f / 1000.0f); F.out[1] = (float)M_[32 + PROBE_TB] * (16.0f / 1000.0f); }
#endif
    }
#undef IN
#undef SEAM
}

extern "C" void kernel_launch(void* const* d_in, const int* in_sizes, int n_in, void* d_out, int out_size, void* d_ws, size_t ws_size, hipStream_t stream) {
    static int grid = 0;
    if (grid == 0) {
        if (n_in != 27 || in_sizes[0] != ML * D || out_size != ML * D || ws_size < WS_END) {
            fprintf(stderr, "kernel_launch: shape/workspace mismatch: n_in %d in0 %d out %d ws %zu (need %zu)\n", n_in, n_in > 0 ? in_sizes[0] : -1, out_size, ws_size, (size_t)WS_END); grid = -1; return; }
        int dev = 0, cus = 0, per_cu = 0;
        if (hipGetDevice(&dev) != hipSuccess || hipDeviceGetAttribute(&cus, hipDeviceAttributeMultiprocessorCount, dev) != hipSuccess) { grid = -1; return; }
        if (hipFuncSetAttribute((const void*)fwd_kernel, hipFuncAttributeMaxDynamicSharedMemorySize, LDS_BYTES) != hipSuccess) { fprintf(stderr, "kernel_launch: hipFuncSetAttribute failed\n"); grid = -1; return; }
        if (hipOccupancyMaxActiveBlocksPerMultiprocessor(&per_cu, (const void*)fwd_kernel, 512, LDS_BYTES) != hipSuccess || per_cu < 1) fprintf(stderr, "kernel_launch: occupancy query reports %d\n", per_cu);
        (void)hipGetLastError();
        grid = cus;
    }
    if (grid < 0) return;
    (void)hipMemsetAsync((char*)d_ws + WS_CTL, 0, CTL_BYTES, stream);
    Args a{};
    const float** ip = (const float**)&a.in;
    for (int i = 0; i < 27; ++i) ip[i] = (const float*)d_in[i];
    a.out = (float*)d_out; a.ws = (unsigned char*)d_ws;
#if MK_ONE_LAUNCH
    a.ph_lo = 0; a.ph_hi = NPHASES;
    hipLaunchKernelGGL(fwd_kernel, dim3(grid), dim3(512), LDS_BYTES, stream, a);
#else
    for (int ph = 0; ph < NPHASES; ++ph) {
#ifdef EMU
        extern int emu_stop_phase; if (emu_stop_phase >= 0 && ph >= emu_stop_phase) break; fprintf(stderr, "phase %d\n", ph);
#endif
        a.ph_lo = ph; a.ph_hi = ph + 1; hipLaunchKernelGGL(fwd_kernel, dim3(grid), dim3(512), LDS_BYTES, stream, a); }
#endif
}
```
